# Optimizing an MI355X kernel written in HIP

```python
import math
import jax, jax.numpy as jnp
from jax import lax
import numpy as np

D_MODEL = 1024
BATCH = 4
SEQ = 8192
DEPTH = 2

GROUP_WIDTH = 256
MIX_WIDTH = 4 * GROUP_WIDTH
NORM_EPS = 1e-6
SSM_HEADS = 4
SSM_HEAD_DIM = 64
SSM_GROUPS = 2
SSM_STATE = 64
SSM_CONV = 4
SSM_CHUNK = 128
SSM_XBC = SSM_HEADS * SSM_HEAD_DIM + 2 * SSM_GROUPS * SSM_STATE
SSM_IN = GROUP_WIDTH + SSM_XBC + SSM_HEADS
LRU_BLOCKS = 4
LRU_BLOCK_DIM = 64
LRU_CONV = 4
LRU_C = 8.0
LRU_IN = 2 * GROUP_WIDTH
RWKV_HEADS = 4
RWKV_HEAD_DIM = 64
RWKV_DECAY_LORA = 64
RWKV_ICLR_LORA = 64
RWKV_GATE_LORA = 128
RWKV_GN_EPS = 64e-5
RWKV_IN = 3 * GROUP_WIDTH + RWKV_DECAY_LORA + RWKV_ICLR_LORA + RWKV_GATE_LORA
NSA_HEADS = 4
NSA_HEAD_DIM = 64
NSA_CMP_STRIDE = 16
NSA_CMP_LEN = 2 * NSA_CMP_STRIDE
NSA_CMP_HIDDEN = 256
NSA_SEL_BLOCK = 64
NSA_SEL_TOPN = 16
NSA_WINDOW = 512
NSA_Q_BLOCK = 128
NSA_FORCE = 1e4
NSA_IN = NSA_HEADS * NSA_HEAD_DIM + 6 * NSA_HEAD_DIM + 3 * NSA_HEADS
N_IN = SSM_IN + LRU_IN + RWKV_IN + NSA_IN
PEER_HEADS = 8
PEER_NKEYS = 128
PEER_EXPERTS = PEER_NKEYS * PEER_NKEYS
PEER_KEY_DIM = 128
PEER_TOPK = 16
PEER_TOKEN_CHUNK = 128

kernel_name = "hymba_ssd_rglru_rwkv7_nsa_peer"


def rms_norm(x, g):
    xf = x.astype(jnp.float32)
    y = xf * lax.rsqrt(jnp.mean(xf * xf, axis=-1, keepdims=True) + NORM_EPS)
    return (y * g).astype(x.dtype)


def causal_dwconv(x, w, b):
    k, c = w.shape
    y = lax.conv_general_dilated(x, w[:, None, :].astype(x.dtype), window_strides=(1,),
                                 padding=[(k - 1, 0)], dimension_numbers=('NWC', 'WIO', 'NWC'),
                                 feature_group_count=c)
    return y + b


def shift_right(t):
    return jnp.pad(t, ((0, 0), (1, 0), (0, 0)))[:, :-1]


def masked_softmax(s, mask):
    s = jnp.where(mask, s.astype(jnp.float32), -jnp.inf)
    m = jnp.max(s, axis=-1, keepdims=True)
    m = jnp.where(jnp.isfinite(m), m, 0.0)
    e = jnp.where(mask, jnp.exp(s - m), 0.0)
    return e / jnp.maximum(jnp.sum(e, axis=-1, keepdims=True), 1e-30)


def alibi_slopes(n):
    return jnp.asarray(2.0 ** (-8.0 * (np.arange(n) + 1) / n), jnp.float32)


def segsum(a):
    t = a.shape[-1]
    ar = jnp.broadcast_to(a[..., :, None], a.shape + (t,))
    ar = jnp.where(jnp.tril(jnp.ones((t, t), bool), -1), ar, 0.0)
    ss = jnp.cumsum(ar, axis=-2)
    return jnp.where(jnp.tril(jnp.ones((t, t), bool), 0), ss, -jnp.inf)


def ssd_chunked(x, a_dt, bm, cm):
    b, s, h, p = x.shape
    n = bm.shape[-1]
    q = SSM_CHUNK
    c = s // q
    x = x.reshape(b, c, q, h, p)
    bm = bm.reshape(b, c, q, h, n)
    cm = cm.reshape(b, c, q, h, n)
    a = a_dt.reshape(b, c, q, h).transpose(0, 3, 1, 2)
    a_cs = jnp.cumsum(a, axis=-1)
    decay_in = jnp.exp(segsum(a))
    scores = jnp.einsum('bclhn,bcshn->bhcls', cm, bm) * decay_in
    y_diag = jnp.einsum('bhcls,bcshp->bclhp', scores, x)
    decay_to_end = jnp.exp(a_cs[..., -1:] - a_cs).transpose(0, 2, 3, 1)
    states = jnp.einsum('bclhn,bclhp->bchpn', bm * decay_to_end[..., None], x)
    states = jnp.concatenate([jnp.zeros_like(states[:, :1]), states], axis=1)
    chunk_decay = jnp.exp(segsum(jnp.pad(a_cs[..., -1], ((0, 0), (0, 0), (1, 0)))))
    states = jnp.einsum('bhzc,bchpn->bzhpn', chunk_decay, states)[:, :-1]
    decay_from_start = jnp.exp(a_cs).transpose(0, 2, 3, 1)
    y_off = jnp.einsum('bclhn,bchpn->bclhp', cm, states) * decay_from_start[..., None]
    return (y_diag + y_off).reshape(b, s, h, p)


def ssd_mixer(cols, conv_w, conv_b, dt_bias, a_log, d_skip, norm_w):
    b, s, _ = cols.shape
    di = SSM_HEADS * SSM_HEAD_DIM
    z, xbc, dt = jnp.split(cols, [di, di + SSM_XBC], axis=-1)
    xbc = jax.nn.silu(causal_dwconv(xbc, conv_w, conv_b)).astype(jnp.float32)
    xs, bm, cm = jnp.split(xbc, [di, di + SSM_GROUPS * SSM_STATE], axis=-1)
    rep = SSM_HEADS // SSM_GROUPS
    xs = xs.reshape(b, s, SSM_HEADS, SSM_HEAD_DIM)
    bm = jnp.repeat(bm.reshape(b, s, SSM_GROUPS, SSM_STATE), rep, axis=2)
    cm = jnp.repeat(cm.reshape(b, s, SSM_GROUPS, SSM_STATE), rep, axis=2)
    dt = jax.nn.softplus(dt.astype(jnp.float32) + dt_bias.astype(jnp.float32))
    a = -jnp.exp(a_log.astype(jnp.float32))
    y = ssd_chunked(xs * dt[..., None], dt * a, bm, cm)
    y = y + xs * d_skip.astype(jnp.float32)[:, None]
    y = y.reshape(b, s, di) * jax.nn.silu(z.astype(jnp.float32))
    yg = y.reshape(b, s, SSM_GROUPS, di // SSM_GROUPS)
    yg = yg * lax.rsqrt(jnp.mean(yg * yg, axis=-1, keepdims=True) + NORM_EPS)
    return (yg.reshape(b, s, di) * norm_w).astype(cols.dtype)


def linear_recurrence(a, u):
    def combine(l, r):
        return l[0] * r[0], r[0] * l[1] + r[1]
    _, h = lax.associative_scan(combine, (a, u), axis=1)
    return h


def rglru_mixer(cols, conv_w, conv_b, wa, ba, wi, bi, lam):
    b, s, _ = cols.shape
    gate, xr = jnp.split(cols, [GROUP_WIDTH], axis=-1)
    xr = causal_dwconv(xr, conv_w, conv_b).astype(jnp.float32)
    xb = xr.reshape(b, s, LRU_BLOCKS, LRU_BLOCK_DIM)
    r = jax.nn.sigmoid(jnp.einsum('bshi,hij->bshj', xb, wa.astype(jnp.float32)) + ba)
    i = jax.nn.sigmoid(jnp.einsum('bshi,hij->bshj', xb, wi.astype(jnp.float32)) + bi)
    log_sig_lam = -jax.nn.softplus(-lam.astype(jnp.float32).reshape(LRU_BLOCKS, LRU_BLOCK_DIM))
    log_a = LRU_C * r * log_sig_lam
    a = jnp.exp(log_a)
    u = jnp.sqrt(-jnp.expm1(2.0 * log_a)) * (i * xb)
    h = linear_recurrence(a, u)
    y = h.reshape(b, s, GROUP_WIDTH) * jax.nn.gelu(gate.astype(jnp.float32))
    return y.astype(cols.dtype)


def rwkv7_scan(r, w, k, v, kk, a):
    b, s, h, n = r.shape

    def step(state, inp):
        r_t, w_t, k_t, v_t, kk_t, a_t = inp
        sa = jnp.einsum('bhij,bhj->bhi', state, -kk_t)
        state = (state * w_t[:, :, None, :] + sa[..., None] * (kk_t * a_t)[:, :, None, :]
                 + v_t[..., None] * k_t[:, :, None, :])
        y_t = jnp.einsum('bhij,bhj->bhi', state, r_t)
        return state, y_t

    xs = tuple(jnp.moveaxis(t, 1, 0) for t in (r, w, k, v, kk, a))
    state0 = jnp.zeros((b, h, n, n), jnp.float32)
    _, y = lax.scan(step, state0, xs)
    return jnp.moveaxis(y, 0, 1)


def rwkv7_mixer(cols, mu, w0, w2, a0, a2, g2, k_k, k_a, r_k, ln_w, ln_b):
    b, s, _ = cols.shape
    c = cols.astype(jnp.float32)
    c = c + (shift_right(c) - c) * mu
    g_ = GROUP_WIDTH
    r, k, v, wd, ad, gd = jnp.split(
        c, [g_, 2 * g_, 3 * g_, 3 * g_ + RWKV_DECAY_LORA, 3 * g_ + RWKV_DECAY_LORA + RWKV_ICLR_LORA], axis=-1)
    w_log = -jax.nn.softplus(-(w0 + jnp.tanh(wd) @ w2)) - 0.5
    decay = jnp.exp(-jnp.exp(w_log))
    a = jax.nn.sigmoid(a0 + ad @ a2)
    g = jax.nn.sigmoid(gd) @ g2
    hs = lambda t: t.reshape(b, s, RWKV_HEADS, RWKV_HEAD_DIM)
    kk = hs(k * k_k)
    kk = kk / jnp.maximum(jnp.sqrt(jnp.sum(kk * kk, axis=-1, keepdims=True)), 1e-12)
    k = k * (1.0 + (a - 1.0) * k_a)
    r, decay, k, v, a = hs(r), hs(decay), hs(k), hs(v), hs(a)
    y = rwkv7_scan(r, decay, k, v, kk, a)
    mean = jnp.mean(y, axis=-1, keepdims=True)
    var = jnp.mean((y - mean) ** 2, axis=-1, keepdims=True)
    y = ((y - mean) * lax.rsqrt(var + RWKV_GN_EPS)).reshape(b, s, g_) * ln_w + ln_b
    y = y + (jnp.sum(r * k * r_k, axis=-1, keepdims=True) * v).reshape(b, s, g_)
    return (y * g).astype(cols.dtype)


def compress_blocks(t, pos_emb, w1, w2):
    b, s, d = t.shape
    ch = t.reshape(b, s // NSA_CMP_STRIDE, NSA_CMP_STRIDE, d)
    blocks = jnp.concatenate([ch[:, :-1], ch[:, 1:]], axis=2) + pos_emb
    hdn = jax.nn.gelu(blocks.reshape(b, blocks.shape[1], NSA_CMP_LEN * d) @ w1)
    return hdn @ w2


def nsa_overlap(s):
    nb = s // NSA_CMP_STRIDE - 1
    nsel = s // NSA_SEL_BLOCK
    cs = np.arange(nb) * NSA_CMP_STRIDE
    ss = np.arange(nsel) * NSA_SEL_BLOCK
    ov = np.minimum(cs[:, None] + NSA_CMP_LEN, ss[None, :] + NSA_SEL_BLOCK) - np.maximum(cs[:, None], ss[None, :])
    return jnp.asarray(np.clip(ov, 0, None) / NSA_CMP_LEN, jnp.float32)


def nsa_mixer(cols, cmp_pos, cmp_w1, cmp_w2, slopes):
    b, s, _ = cols.shape
    hd = NSA_HEAD_DIM
    qd = NSA_HEADS * hd
    q, kc, vc, ks, vs, kw, vw, gates = jnp.split(
        cols, [qd, qd + hd, qd + 2 * hd, qd + 3 * hd, qd + 4 * hd, qd + 5 * hd, qd + 6 * hd], axis=-1)
    q = q.reshape(b, s, NSA_HEADS, hd) * (hd ** -0.5)
    gates = jax.nn.sigmoid(gates.astype(jnp.float32).reshape(b, s, NSA_HEADS, 3))
    pos = jnp.arange(s)

    kcmp = compress_blocks(kc, cmp_pos[0], cmp_w1[0], cmp_w2[0])
    vcmp = compress_blocks(vc, cmp_pos[1], cmp_w1[1], cmp_w2[1])
    nb = kcmp.shape[1]
    blk_end = jnp.arange(nb) * NSA_CMP_STRIDE + NSA_CMP_LEN - 1
    dist = pos[:, None] - blk_end[None, :]
    sc = jnp.einsum('bshd,bnd->bhsn', q, kcmp).astype(jnp.float32) - slopes[:, None, None] * dist
    p_cmp = masked_softmax(sc, dist >= 0)
    o_cmp = jnp.einsum('bhsn,bnd->bshd', p_cmp.astype(vcmp.dtype), vcmp)

    nsel = s // NSA_SEL_BLOCK
    n_top = min(NSA_SEL_TOPN, nsel)
    imp = jnp.einsum('bhsn,nj->bsj', p_cmp, nsa_overlap(s))
    j = jnp.arange(nsel)
    cur = pos // NSA_SEL_BLOCK
    forced = (j[None, :] == 0) | (j[None, :] == cur[:, None]) | (j[None, :] == cur[:, None] - 1)
    imp = jnp.where(forced, NSA_FORCE, imp)
    imp = jnp.where(j[None, :] * NSA_SEL_BLOCK <= pos[:, None], imp, -jnp.inf)
    _, sel_idx = lax.top_k(imp, n_top)

    kw_pad = jnp.pad(kw, ((0, 0), (NSA_WINDOW, 0), (0, 0)))
    vw_pad = jnp.pad(vw, ((0, 0), (NSA_WINDOW, 0), (0, 0)))
    win_len = NSA_WINDOW + NSA_Q_BLOCK
    in_blk = jnp.arange(NSA_SEL_BLOCK)
    qb_len = NSA_Q_BLOCK

    def q_block(i):
        q0 = i * qb_len
        qb = lax.dynamic_slice_in_dim(q, q0, qb_len, axis=1)
        tq = q0 + jnp.arange(qb_len)
        idx = lax.dynamic_slice_in_dim(sel_idx, q0, qb_len, axis=1)
        tok = (idx[..., None] * NSA_SEL_BLOCK + in_blk).reshape(b, qb_len, n_top * NSA_SEL_BLOCK)
        kg = jax.vmap(lambda a_, i_: a_[i_])(ks, tok)
        vg = jax.vmap(lambda a_, i_: a_[i_])(vs, tok)
        d_sel = tq[None, :, None] - tok
        ssel = (jnp.einsum('bqhd,bqld->bhql', qb, kg).astype(jnp.float32)
                - slopes[None, :, None, None] * d_sel[:, None])
        p_sel = masked_softmax(ssel, (d_sel >= 0)[:, None])
        o_sel = jnp.einsum('bhql,bqld->bqhd', p_sel.astype(vg.dtype), vg)
        kwb = lax.dynamic_slice_in_dim(kw_pad, q0, win_len, axis=1)
        vwb = lax.dynamic_slice_in_dim(vw_pad, q0, win_len, axis=1)
        tk = q0 - NSA_WINDOW + jnp.arange(win_len)
        d_win = tq[:, None] - tk[None, :]
        m_win = (d_win >= 0) & (d_win < NSA_WINDOW) & (tk[None, :] >= 0)
        swin = jnp.einsum('bqhd,bkd->bhqk', qb, kwb).astype(jnp.float32) - slopes[:, None, None] * d_win
        p_win = masked_softmax(swin, m_win)
        o_win = jnp.einsum('bhqk,bkd->bqhd', p_win.astype(vwb.dtype), vwb)
        return o_sel, o_win

    o_sel, o_win = lax.map(q_block, jnp.arange(s // qb_len))
    o_sel = jnp.moveaxis(o_sel, 0, 1).reshape(b, s, NSA_HEADS, hd)
    o_win = jnp.moveaxis(o_win, 0, 1).reshape(b, s, NSA_HEADS, hd)
    out = gates[..., 0:1] * o_cmp + gates[..., 1:2] * o_sel + gates[..., 2:3] * o_win
    return out.reshape(b, s, qd).astype(cols.dtype)


def peer_ffn(x, wq, keys, u, v):
    b, s, d = x.shape
    t = b * s
    xt = x.reshape(t, d)
    q = (xt @ wq).reshape(t, PEER_HEADS, 2, PEER_KEY_DIM)
    sc = jnp.einsum('thcd,hcnd->thcn', q, keys).astype(jnp.float32)
    s1, i1 = lax.top_k(sc[:, :, 0], PEER_TOPK)
    s2, i2 = lax.top_k(sc[:, :, 1], PEER_TOPK)
    cand = (s1[..., :, None] + s2[..., None, :]).reshape(t, PEER_HEADS, PEER_TOPK * PEER_TOPK)
    cidx = (i1[..., :, None] * PEER_NKEYS + i2[..., None, :]).reshape(t, PEER_HEADS, PEER_TOPK * PEER_TOPK)
    top, pos = lax.top_k(cand, PEER_TOPK)
    eidx = jnp.take_along_axis(cidx, pos, axis=-1)
    gate = jax.nn.softmax(top, axis=-1)
    nc = t // PEER_TOKEN_CHUNK
    xc = xt.reshape(nc, PEER_TOKEN_CHUNK, d)
    ic = eidx.reshape(nc, PEER_TOKEN_CHUNK, PEER_HEADS * PEER_TOPK)
    gc = gate.reshape(nc, PEER_TOKEN_CHUNK, PEER_HEADS * PEER_TOPK).astype(x.dtype)

    def chunk(args):
        xb, ib, gb = args
        act = jax.nn.gelu(jnp.einsum('td,tkd->tk', xb, u[ib]))
        return jnp.einsum('tk,tkd->td', gb * act, v[ib])

    y = lax.map(chunk, (xc, ic, gc))
    return y.reshape(b, s, d)


def setup_inputs(seed: int = 0) -> dict:
    key = jax.random.key(seed)
    keys = jax.random.split(key, 48)
    counter = [0]

    def nk():
        counter[0] += 1
        return keys[counter[0] - 1]

    def nrm(shape, scale):
        return scale * jax.random.normal(nk(), shape, jnp.float32)

    def unif(shape, lo, hi):
        return jax.random.uniform(nk(), shape, jnp.float32, lo, hi)

    L = DEPTH
    x = nrm((BATCH, SEQ, D_MODEL), 1.0)
    mix_norm = 1.0 + nrm((L, D_MODEL), 0.02)
    w_in = nrm((L, D_MODEL, N_IN), D_MODEL ** -0.5)
    w_out = nrm((L, MIX_WIDTH, D_MODEL), 0.5 * MIX_WIDTH ** -0.5)
    ssm_conv_w = nrm((L, SSM_CONV, SSM_XBC), SSM_CONV ** -0.5)
    ssm_conv_b = nrm((L, SSM_XBC), 0.01)
    dt0 = jnp.exp(unif((L, SSM_HEADS), math.log(1e-3), math.log(1e-1)))
    ssm_dt_bias = dt0 + jnp.log(-jnp.expm1(-dt0))
    ssm_a_log = jnp.log(unif((L, SSM_HEADS), 1.0, 16.0))
    ssm_d = 1.0 + nrm((L, SSM_HEADS), 0.1)
    ssm_norm = 1.0 + nrm((L, GROUP_WIDTH), 0.02)
    lru_conv_w = nrm((L, LRU_CONV, GROUP_WIDTH), LRU_CONV ** -0.5)
    lru_conv_b = nrm((L, GROUP_WIDTH), 0.01)
    lru_wa = nrm((L, LRU_BLOCKS, LRU_BLOCK_DIM, LRU_BLOCK_DIM), LRU_BLOCK_DIM ** -0.5)
    lru_ba = nrm((L, LRU_BLOCKS, LRU_BLOCK_DIM), 0.01)
    lru_wi = nrm((L, LRU_BLOCKS, LRU_BLOCK_DIM, LRU_BLOCK_DIM), LRU_BLOCK_DIM ** -0.5)
    lru_bi = nrm((L, LRU_BLOCKS, LRU_BLOCK_DIM), 0.01)
    p_lam = unif((L, GROUP_WIDTH), 0.9, 0.999) ** (1.0 / LRU_C)
    lru_lambda = jnp.log(p_lam) - jnp.log1p(-p_lam)
    rwkv_mu = unif((L, RWKV_IN), 0.0, 1.0)
    rwkv_w0 = unif((L, GROUP_WIDTH), -5.0, -1.0)
    rwkv_w2 = nrm((L, RWKV_DECAY_LORA, GROUP_WIDTH), 0.5 * RWKV_DECAY_LORA ** -0.5)
    rwkv_a0 = nrm((L, GROUP_WIDTH), 0.1)
    rwkv_a2 = nrm((L, RWKV_ICLR_LORA, GROUP_WIDTH), 0.5 * RWKV_ICLR_LORA ** -0.5)
    rwkv_g2 = nrm((L, RWKV_GATE_LORA, GROUP_WIDTH), RWKV_GATE_LORA ** -0.5)
    rwkv_kk = 0.85 + nrm((L, GROUP_WIDTH), 0.05)
    rwkv_ka = 1.0 + nrm((L, GROUP_WIDTH), 0.05)
    rwkv_rk = nrm((L, RWKV_HEADS, RWKV_HEAD_DIM), 0.1)
    rwkv_ln_w = 1.0 + nrm((L, GROUP_WIDTH), 0.02)
    rwkv_ln_b = nrm((L, GROUP_WIDTH), 0.01)
    nsa_cmp_pos = nrm((L, 2, NSA_CMP_LEN, NSA_HEAD_DIM), 0.02)
    nsa_cmp_w1 = nrm((L, 2, NSA_CMP_LEN * NSA_HEAD_DIM, NSA_CMP_HIDDEN), (NSA_CMP_LEN * NSA_HEAD_DIM) ** -0.5)
    nsa_cmp_w2 = nrm((L, 2, NSA_CMP_HIDDEN, NSA_HEAD_DIM), NSA_CMP_HIDDEN ** -0.5)
    ffn_norm = 1.0 + nrm((L, D_MODEL), 0.02)
    peer_wq = nrm((L, D_MODEL, PEER_HEADS * 2 * PEER_KEY_DIM), D_MODEL ** -0.5)
    peer_keys = nrm((L, PEER_HEADS, 2, PEER_NKEYS, PEER_KEY_DIM), PEER_KEY_DIM ** -0.5)
    peer_u = nrm((L, PEER_EXPERTS, D_MODEL), D_MODEL ** -0.5)
    peer_v = nrm((L, PEER_EXPERTS, D_MODEL), (PEER_HEADS * PEER_TOPK) ** -0.5)
    final_norm = 1.0 + nrm((D_MODEL,), 0.02)
    return {"x": x, "mix_norm": mix_norm, "w_in": w_in, "w_out": w_out,
            "ssm_conv_w": ssm_conv_w, "ssm_conv_b": ssm_conv_b, "ssm_dt_bias": ssm_dt_bias,
            "ssm_a_log": ssm_a_log, "ssm_d": ssm_d, "ssm_norm": ssm_norm,
            "lru_conv_w": lru_conv_w, "lru_conv_b": lru_conv_b, "lru_wa": lru_wa, "lru_ba": lru_ba,
            "lru_wi": lru_wi, "lru_bi": lru_bi, "lru_lambda": lru_lambda,
            "rwkv_mu": rwkv_mu, "rwkv_w0": rwkv_w0, "rwkv_w2": rwkv_w2, "rwkv_a0": rwkv_a0,
            "rwkv_a2": rwkv_a2, "rwkv_g2": rwkv_g2, "rwkv_kk": rwkv_kk, "rwkv_ka": rwkv_ka,
            "rwkv_rk": rwkv_rk, "rwkv_ln_w": rwkv_ln_w, "rwkv_ln_b": rwkv_ln_b,
            "nsa_cmp_pos": nsa_cmp_pos, "nsa_cmp_w1": nsa_cmp_w1, "nsa_cmp_w2": nsa_cmp_w2,
            "ffn_norm": ffn_norm, "peer_wq": peer_wq, "peer_keys": peer_keys,
            "peer_u": peer_u, "peer_v": peer_v, "final_norm": final_norm}


def reference(x, mix_norm, w_in, w_out, ssm_conv_w, ssm_conv_b, ssm_dt_bias, ssm_a_log, ssm_d, ssm_norm,
              lru_conv_w, lru_conv_b, lru_wa, lru_ba, lru_wi, lru_bi, lru_lambda,
              rwkv_mu, rwkv_w0, rwkv_w2, rwkv_a0, rwkv_a2, rwkv_g2, rwkv_kk, rwkv_ka, rwkv_rk,
              rwkv_ln_w, rwkv_ln_b, nsa_cmp_pos, nsa_cmp_w1, nsa_cmp_w2,
              ffn_norm, peer_wq, peer_keys, peer_u, peer_v, final_norm):
    slopes = alibi_slopes(NSA_HEADS)
    splits = [SSM_IN, SSM_IN + LRU_IN, SSM_IN + LRU_IN + RWKV_IN]
    h = x
    for l in range(DEPTH):
        u = rms_norm(h, mix_norm[l])
        cols = u @ w_in[l]
        c_ssm, c_lru, c_rwkv, c_nsa = jnp.split(cols, splits, axis=-1)
        y_ssm = ssd_mixer(c_ssm, ssm_conv_w[l], ssm_conv_b[l], ssm_dt_bias[l], ssm_a_log[l], ssm_d[l], ssm_norm[l])
        y_lru = rglru_mixer(c_lru, lru_conv_w[l], lru_conv_b[l], lru_wa[l], lru_ba[l], lru_wi[l], lru_bi[l],
                            lru_lambda[l])
        y_rwkv = rwkv7_mixer(c_rwkv, rwkv_mu[l], rwkv_w0[l], rwkv_w2[l], rwkv_a0[l], rwkv_a2[l], rwkv_g2[l],
                             rwkv_kk[l], rwkv_ka[l], rwkv_rk[l], rwkv_ln_w[l], rwkv_ln_b[l])
        y_nsa = nsa_mixer(c_nsa, nsa_cmp_pos[l], nsa_cmp_w1[l], nsa_cmp_w2[l], slopes)
        mixed = jnp.concatenate([y_ssm, y_lru, y_rwkv, y_nsa], axis=-1)
        h = h + mixed @ w_out[l]
        h = h + peer_ffn(rms_norm(h, ffn_norm[l]), peer_wq[l], peer_keys[l], peer_u[l], peer_v[l])
    return rms_norm(h, final_norm)
```

```cpp
#include <hip/hip_runtime.h>
#include <hip/hip_bf16.h>
#include <hip/hip_cooperative_groups.h>
#include <cstdio>
namespace cg = cooperative_groups;

typedef unsigned short bfu;
using bf16x8 = __attribute__((ext_vector_type(8))) short;
using f32x4 = __attribute__((ext_vector_type(4))) float;

#define DEV __device__ __forceinline__

constexpr int Bsz = 4, S = 8192, T = Bsz * S, D = 1024, NIN = 2960, DEPTH = 2;
constexpr int C_SSM = 0, C_LRU = 772, C_RWKV = 1284, C_NSA = 2308;
constexpr int C_Z = 0, C_XBC = 256, C_DT = 768;
constexpr int C_LG = 772, C_LX = 1028;
constexpr int C_Q = 2308, C_KC = 2564, C_VC = 2628, C_KS = 2692, C_VS = 2756, C_KW = 2820, C_VW = 2884, C_GT = 2948;
constexpr int NCH = 128;
constexpr int NTHR = 256;
#ifndef R_GEMM
#define R_GEMM 1
#endif
#ifndef R_PREP
#define R_PREP 1
#endif
#ifndef R_SCAN
#define R_SCAN 1
#endif
#ifndef R_FIN
#define R_FIN 1
#endif
#ifndef R_TOPK
#define R_TOPK 1
#endif
#ifndef R_GATH
#define R_GATH 1
#endif
#ifndef R_CMPA
#define R_CMPA 1
#endif

constexpr size_t AL(size_t x) { return (x + 255) & ~(size_t)255; }
constexpr size_t O_ACT = 0;
constexpr size_t O_COLS = O_ACT + AL((size_t)T * 1024 * 2);
constexpr size_t O_SIDE = O_COLS + AL((size_t)T * NIN * 2);
constexpr size_t O_RIN = O_SIDE + AL((size_t)T * 16 * 4);
constexpr size_t O_RY = O_RIN + AL((size_t)16 * S * 896);
constexpr size_t O_RG = O_RY + AL((size_t)T * 256 * 4);
constexpr size_t O_SST = O_RG + AL((size_t)T * 256 * 2);
constexpr size_t O_SAT = O_SST + AL((size_t)16 * NCH * 4096 * 4);
constexpr size_t O_LA = O_SAT + AL((size_t)16 * NCH * 4);
constexpr size_t O_LH = O_LA + AL((size_t)4 * NCH * 256 * 4);
constexpr size_t O_KCMP = O_LH + AL((size_t)4 * NCH * 256 * 4);
constexpr size_t O_VCT = O_KCMP + AL((size_t)4 * 512 * 64 * 2);
constexpr size_t O_VWT = O_VCT + AL((size_t)4 * 512 * 64 * 2);
constexpr size_t O_VST = O_VWT + AL((size_t)4 * 64 * S * 2);
constexpr size_t O_OCMP = O_VST + AL((size_t)4 * 64 * S * 2);
constexpr size_t O_SEL = O_OCMP + AL((size_t)T * 256 * 2);
constexpr size_t O_SYNC = O_SEL + AL((size_t)T * 16);
constexpr size_t O_XB = O_SYNC + 256;
constexpr size_t O_W = O_XB + 16384;
constexpr size_t W_IN = 0;
constexpr size_t W_OUT = W_IN + AL((size_t)NIN * 1024 * 2);
constexpr size_t W_Q = W_OUT + AL((size_t)1024 * 1024 * 2);
constexpr size_t W_KEYS = W_Q + AL((size_t)2048 * 1024 * 2);
constexpr size_t W_C1 = W_KEYS + AL((size_t)16 * 128 * 128 * 2);
constexpr size_t W_C2 = W_C1 + AL((size_t)2 * 256 * 2048 * 2);
constexpr size_t W_LA = W_C2 + AL((size_t)2 * 64 * 256 * 2);
constexpr size_t W_LI = W_LA + AL((size_t)4 * 64 * 64 * 2);
constexpr size_t W_R2 = W_LI + AL((size_t)4 * 64 * 64 * 2);
constexpr size_t W_A2 = W_R2 + AL((size_t)256 * 64 * 2);
constexpr size_t W_G2 = W_A2 + AL((size_t)256 * 64 * 2);
constexpr size_t W_SZ = W_G2 + AL((size_t)256 * 128 * 2);
constexpr size_t O_END = O_W + 2 * W_SZ;
constexpr size_t O_PU = O_COLS;
constexpr size_t O_PV = O_PU + AL((size_t)16384 * 1024);
constexpr size_t O_PQ = O_PV + AL((size_t)16384 * 1024);
constexpr size_t O_PE = O_PQ + AL((size_t)T * 2048 * 2);
constexpr size_t O_PG = O_PE + AL((size_t)T * 128 * 4);
constexpr size_t O_PEND = O_PG + AL((size_t)T * 128 * 4);
static_assert(O_PEND <= O_RY, "peer scratch overlaps live buffers");
static_assert(O_END <= (size_t)536870912, "workspace too large");

struct Params {
  const float* x; const float* mix_norm; const float* w_in; const float* w_out;
  const float* ssm_conv_w; const float* ssm_conv_b; const float* ssm_dt_bias; const float* ssm_a_log; const float* ssm_d; const float* ssm_norm;
  const float* lru_conv_w; const float* lru_conv_b; const float* lru_wa; const float* lru_ba; const float* lru_wi; const float* lru_bi; const float* lru_lambda;
  const float* rwkv_mu; const float* rwkv_w0; const float* rwkv_w2; const float* rwkv_a0; const float* rwkv_a2; const float* rwkv_g2;
  const float* rwkv_kk; const float* rwkv_ka; const float* rwkv_rk; const float* rwkv_ln_w; const float* rwkv_ln_b;
  const float* nsa_cmp_pos; const float* nsa_cmp_w1; const float* nsa_cmp_w2;
  const float* ffn_norm; const float* peer_wq; const float* peer_keys; const float* peer_u; const float* peer_v; const float* final_norm;
  float* out; unsigned char* ws;
  int ph_lo, ph_hi;
};

DEV int tid_() { int t = threadIdx.x; asm volatile("" : "+v"(t)); return t; }
DEV int bid_() { int b = blockIdx.x; asm volatile("" : "+s"(b)); return b; }
DEV bfu f2bf(float f) { unsigned u = __float_as_uint(f); u += 0x7fffu + ((u >> 16) & 1u); return (bfu)(u >> 16); }
DEV float bf2f(bfu b) { return __uint_as_float(((unsigned)b) << 16); }
DEV unsigned pack2(float a, float b) { return (unsigned)f2bf(a) | ((unsigned)f2bf(b) << 16); }
DEV float lo2f(unsigned u) { return __uint_as_float(u << 16); }
DEV float hi2f(unsigned u) { return __uint_as_float(u & 0xffff0000u); }
DEV float sigmoidf_(float x) { return 1.f / (1.f + __expf(-x)); }
DEV float siluf_(float x) { return x / (1.f + __expf(-x)); }
DEV float softplusf_(float x) { return fmaxf(x, 0.f) + log1pf(__expf(-fabsf(x))); }
DEV float geluf_(float x) { float u = 0.7978845608028654f * (x + 0.044715f * x * x * x); return 0.5f * x * (1.f + tanhf(u)); }

template <int CTRL> DEV float dppf(float v) {
  return __int_as_float(__builtin_amdgcn_update_dpp(0, __float_as_int(v), CTRL, 0xf, 0xf, true));
}
DEV float row16_sum(float v) { v += dppf<0xB1>(v); v += dppf<0x4E>(v); v += dppf<0x141>(v); v += dppf<0x140>(v); return v; }
DEV float row16_max(float v) { v = fmaxf(v, dppf<0xB1>(v)); v = fmaxf(v, dppf<0x4E>(v)); v = fmaxf(v, dppf<0x141>(v)); v = fmaxf(v, dppf<0x140>(v)); return v; }
DEV float wave_sum(float v) { v = row16_sum(v); v += __shfl_xor(v, 16); v += __shfl_xor(v, 32); return v; }

DEV bf16x8 ld8(const bfu* p) { return *(const bf16x8*)p; }
DEV f32x4 mfma16(bf16x8 a, bf16x8 b, f32x4 c) { return __builtin_amdgcn_mfma_f32_16x16x32_bf16(a, b, c, 0, 0, 0); }

DEV void mfma16_acc(f32x4& c, bf16x8 a, bf16x8 b) { asm("v_mfma_f32_16x16x32_bf16 %0, %1, %2, %0" : "+a"(c) : "v"(a), "v"(b)); }
DEV void gld_async(bf16x8& v, const bfu* p) { asm volatile("global_load_dwordx4 %0, %1, off" : "=v"(v) : "v"(p) : "memory"); }
template <int N> DEV void gwait6(bf16x8& a0, bf16x8& a1, bf16x8& a2, bf16x8& a3, bf16x8& b0, bf16x8& b1) {
  asm volatile("s_waitcnt vmcnt(%6)" : "+v"(a0), "+v"(a1), "+v"(a2), "+v"(a3), "+v"(b0), "+v"(b1) : "n"(N) : "memory");
}
__shared__ __attribute__((aligned(16))) unsigned char smem[61440];
__shared__ int s_qitem;

DEV void transpose_tile(const float* src, bfu* dst, int R, int C, int tr, int tc) {
  float* tl = (float*)smem;
  int tid = tid_();
  __syncthreads();
  for (int i = tid; i < 4096; i += NTHR) {
    int r = i >> 6, c = i & 63;
    int gr = tr * 64 + r, gc = tc * 64 + c;
    tl[r * 65 + c] = (gr < R && gc < C) ? src[(size_t)gr * C + gc] : 0.f;
  }
  __syncthreads();
  for (int i = tid; i < 4096; i += NTHR) {
    int c = i >> 6, r = i & 63;
    int gr = tr * 64 + r, gc = tc * 64 + c;
    if (gr < R && gc < C) dst[(size_t)gc * R + gr] = f2bf(tl[r * 65 + c]);
  }
}
struct TJob { const float* src; bfu* dst; int R, C; };
DEV void phase_convert(const Params& p) {
  if (bid_() == 0) { if (tid_() < 64) ((unsigned*)(p.ws + O_SYNC))[tid_()] = 0u; for (int i = tid_(); i < 4096; i += NTHR) ((unsigned*)(p.ws + O_XB))[i] = 0u; }
  for (int l = 0; l < DEPTH; ++l) {
    unsigned char* wb = p.ws + O_W + (size_t)l * W_SZ;
    for (int j = 0; j < 20; ++j) {
      const float* src; bfu* dst; int R, C;
      if (j == 0) { src = p.w_in + (size_t)l * 1024 * NIN; dst = (bfu*)(wb + W_IN); R = 1024; C = NIN; }
      else if (j == 1) { src = p.w_out + (size_t)l * 1024 * 1024; dst = (bfu*)(wb + W_OUT); R = 1024; C = 1024; }
      else if (j == 2) { src = p.peer_wq + (size_t)l * 1024 * 2048; dst = (bfu*)(wb + W_Q); R = 1024; C = 2048; }
      else if (j < 5) { int k = j - 3; src = p.nsa_cmp_w1 + ((size_t)l * 2 + k) * 2048 * 256; dst = (bfu*)(wb + W_C1) + (size_t)k * 256 * 2048; R = 2048; C = 256; }
      else if (j < 7) { int k = j - 5; src = p.nsa_cmp_w2 + ((size_t)l * 2 + k) * 256 * 64; dst = (bfu*)(wb + W_C2) + (size_t)k * 64 * 256; R = 256; C = 64; }
      else if (j < 11) { int k = j - 7; src = p.lru_wa + ((size_t)l * 4 + k) * 4096; dst = (bfu*)(wb + W_LA) + k * 4096; R = 64; C = 64; }
      else if (j < 15) { int k = j - 11; src = p.lru_wi + ((size_t)l * 4 + k) * 4096; dst = (bfu*)(wb + W_LI) + k * 4096; R = 64; C = 64; }
      else if (j == 15) { src = p.rwkv_w2 + (size_t)l * 64 * 256; dst = (bfu*)(wb + W_R2); R = 64; C = 256; }
      else if (j == 16) { src = p.rwkv_a2 + (size_t)l * 64 * 256; dst = (bfu*)(wb + W_A2); R = 64; C = 256; }
      else if (j == 17) { src = p.rwkv_g2 + (size_t)l * 128 * 256; dst = (bfu*)(wb + W_G2); R = 128; C = 256; }
      else continue;
      int ntr = (R + 63) / 64, ntc = (C + 63) / 64;
      for (int t = bid_(); t < ntr * ntc; t += gridDim.x) transpose_tile(src, dst, R, C, t / ntc, t % ntc);
    }
    {
      const float* src = p.peer_keys + (size_t)l * 16 * 128 * 128; bfu* dst = (bfu*)(wb + W_KEYS);
      for (int i = bid_() * NTHR + tid_(); i < 16 * 128 * 128; i += gridDim.x * NTHR) dst[i] = f2bf(src[i]);
    }
  }
}
constexpr float PU_SCALE = 512.f, PV_SCALE = 128.f;
DEV unsigned pack_fp8x4(float a, float b, float c, float d, float sc) {
  a = fminf(fmaxf(a * sc, -448.f), 448.f); b = fminf(fmaxf(b * sc, -448.f), 448.f);
  c = fminf(fmaxf(c * sc, -448.f), 448.f); d = fminf(fmaxf(d * sc, -448.f), 448.f);
  int w = 0;
  w = __builtin_amdgcn_cvt_pk_fp8_f32(a, b, w, false);
  w = __builtin_amdgcn_cvt_pk_fp8_f32(c, d, w, true);
  return (unsigned)w;
}
DEV void convert_peer_uv(const Params& p, int l) {
  typedef float f4v __attribute__((ext_vector_type(4)));
  const f4v* su = (const f4v*)(p.peer_u + (size_t)l * 16384 * 1024);
  const f4v* sv = (const f4v*)(p.peer_v + (size_t)l * 16384 * 1024);
  unsigned* duv = (unsigned*)(p.ws + O_PU);
  const int n4 = 16384 * 1024 / 4;
  const int stride = gridDim.x * NTHR;
  for (int i0 = bid_() * NTHR + tid_(); i0 < n4; i0 += stride * 4) {
    f4v a[4], b[4];
#pragma unroll
    for (int k = 0; k < 4; ++k) {
      const int i = i0 + k * stride;
      if (i < n4) { a[k] = __builtin_nontemporal_load(su + i); b[k] = __builtin_nontemporal_load(sv + i); }
    }
#pragma unroll
    for (int k = 0; k < 4; ++k) {
      const int i = i0 + k * stride;
      if (i < n4) {
        const int e = i >> 8, c = i & 255;
        duv[e * 512 + c] = pack_fp8x4(a[k].x, a[k].y, a[k].z, a[k].w, PU_SCALE);
        duv[e * 512 + 256 + c] = pack_fp8x4(b[k].x, b[k].y, b[k].z, b[k].w, PV_SCALE);
      }
    }
  }
}

DEV void phase_norm(const float* h, const float* g, bfu* dst) {
  int lane = tid_() & 63, wv = tid_() >> 6;
  for (int t = bid_() * 4 + wv; t < T; t += gridDim.x * 4) {
    const float4* hp = (const float4*)(h + (size_t)t * D);
    float4 v[4]; float ss = 0.f;
#pragma unroll
    for (int i = 0; i < 4; ++i) { v[i] = hp[lane + i * 64]; ss += v[i].x * v[i].x + v[i].y * v[i].y + v[i].z * v[i].z + v[i].w * v[i].w; }
    ss = wave_sum(ss);
    float sc = rsqrtf(ss * (1.f / D) + 1e-6f);
#pragma unroll
    for (int i = 0; i < 4; ++i) {
      float4 gg = ((const float4*)g)[lane + i * 64];
      uint2 o = make_uint2(pack2(v[i].x * sc * gg.x, v[i].y * sc * gg.y), pack2(v[i].z * sc * gg.z, v[i].w * sc * gg.w));
      ((uint2*)(dst + (size_t)t * D))[lane + i * 64] = o;
    }
  }
}

template <int N> DEV void gwait4(bf16x8& a0, bf16x8& a1, bf16x8& b0, bf16x8& b1) {
  asm volatile("s_waitcnt vmcnt(%4)" : "+v"(a0), "+v"(a1), "+v"(b0), "+v"(b1) : "n"(N) : "memory");
}
template <int MODE>
DEV void gemm_phase(const bfu* __restrict__ A, const bfu* __restrict__ Bt, int N, int K,
                    bfu* __restrict__ Cb, int ldc, float* __restrict__ side, const float* __restrict__ hin, float* __restrict__ hout) {
  constexpr int STR = 32;
  constexpr int BUFE = 256 * STR;
  bfu* As = (bfu*)smem;
  bfu* Bs = As + 128 * STR;
  const int tid = tid_(), lane = tid & 63, wv = tid >> 6;
  const int wm = wv >> 1, wn = wv & 1;
  const int ntn = (N + 127) / 128, ntm = T / 128;
  const int lr = lane & 15, lq = lane >> 4;
  const int swz = (lq ^ ((0x1320 >> (((lr >> 2) & 3) * 4)) & 3)) * 8;
  const int bid = bid_();
  const bool xmap = (gridDim.x & 7) == 0;
  const int ns = (ntn >= 16) ? 2 : 1;
  const int xcd = bid & 7, nloc = xmap ? (int)(gridDim.x >> 3) : (int)gridDim.x;
  const int ntn_p = xmap ? ntn / ns : ntn, mstep = xmap ? 8 / ns : 1;
  const int xs = xmap ? xcd % ns : 0, xm = xmap ? xcd / ns : 0;
  const int ntile_x = xmap ? (ntm / mstep) * ntn_p : ntm * ntn;
  for (int u = xmap ? (bid >> 3) : bid; u < ntile_x; u += nloc) {
    const int tm = (u / ntn_p) * mstep + xm, tn = xs * ntn_p + (u % ntn_p);
    const int m0 = tm * 128, n0 = tn * 128;
    f32x4 acc[4][4];
#pragma unroll
    for (int i = 0; i < 4; ++i)
#pragma unroll
      for (int j = 0; j < 4; ++j) acc[i][j] = (f32x4){0.f, 0.f, 0.f, 0.f};
    const bfu* ap[2]; const bfu* bp[2]; int so[2];
#pragma unroll
    for (int i = 0; i < 2; ++i) {
      int c = tid + i * NTHR; int row = c >> 2, kc = c & 3;
      ap[i] = A + (size_t)(m0 + row) * K + kc * 8;
      so[i] = row * STR + ((kc ^ ((0x1320 >> (((row >> 2) & 3) * 4)) & 3)) * 8);
      int nr = n0 + row; if (nr > N - 1) nr = N - 1;
      bp[i] = Bt + (size_t)nr * K + kc * 8;
    }
    bf16x8 ra[2][2], rb[2][2];
    __syncthreads();
#pragma unroll
    for (int i = 0; i < 2; ++i) { *(bf16x8*)(As + so[i]) = ld8(ap[i]); *(bf16x8*)(Bs + so[i]) = ld8(bp[i]); }
#pragma unroll
    for (int q = 0; q < 2; ++q)
#pragma unroll
      for (int i = 0; i < 2; ++i) { gld_async(ra[q][i], ap[i] + (q + 1) * 32); gld_async(rb[q][i], bp[i] + (q + 1) * 32); }
    const int nst = K / 32;
    for (int st = 0; st < nst; st += 2) {
#pragma unroll
      for (int q = 0; q < 2; ++q) {
        const int sidx = st + q;
        const bfu* Ar = As + q * BUFE;
        const bfu* Br = Bs + q * BUFE;
        bfu* Aw = As + (q ^ 1) * BUFE;
        bfu* Bw = Bs + (q ^ 1) * BUFE;
        __syncthreads();
        bf16x8 af[4], bfr[4];
#pragma unroll
        for (int i = 0; i < 4; ++i) af[i] = *(const bf16x8*)(Ar + (wm * 64 + i * 16 + lr) * STR + swz);
#pragma unroll
        for (int j = 0; j < 4; ++j) bfr[j] = *(const bf16x8*)(Br + (wn * 64 + j * 16 + lr) * STR + swz);
        const int kn = (sidx + 3 < nst ? sidx + 3 : nst - 1) * 32;
        gwait4<4>(ra[q][0], ra[q][1], rb[q][0], rb[q][1]);
#pragma unroll
        for (int i = 0; i < 2; ++i) { *(bf16x8*)(Aw + so[i]) = ra[q][i]; *(bf16x8*)(Bw + so[i]) = rb[q][i]; }
#pragma unroll
        for (int i = 0; i < 2; ++i) { gld_async(ra[q][i], ap[i] + kn); gld_async(rb[q][i], bp[i] + kn); }
#pragma unroll
        for (int i = 0; i < 4; ++i)
#pragma unroll
          for (int j = 0; j < 4; ++j) mfma16_acc(acc[i][j], bfr[j], af[i]);
      }
    }
#pragma unroll
    for (int q = 0; q < 2; ++q) gwait4<0>(ra[q][0], ra[q][1], rb[q][0], rb[q][1]);
    asm volatile("s_nop 7\n\ts_nop 7\n\ts_nop 7" ::: "memory");
#pragma unroll
    for (int i = 0; i < 4; ++i) {
      const int row = m0 + wm * 64 + i * 16 + lr;
#pragma unroll
      for (int j = 0; j < 4; ++j) {
        const int col = n0 + wn * 64 + j * 16 + lq * 4;
        const f32x4 v = acc[i][j];
        if (MODE == 0) {
          if (col < N) {
            *(uint2*)(Cb + (size_t)row * ldc + col) = make_uint2(pack2(v[0], v[1]), pack2(v[2], v[3]));
            if (col == C_DT) *(float4*)(side + (size_t)row * 16) = make_float4(v[0], v[1], v[2], v[3]);
            if (col >= C_GT) *(float4*)(side + (size_t)row * 16 + 4 + (col - C_GT)) = make_float4(v[0], v[1], v[2], v[3]);
          }
        } else if (MODE == 1) {
          const size_t o = (size_t)row * D + col;
          const float4 h = *(const float4*)(hin + o);
          *(float4*)(hout + o) = make_float4(h.x + v[0], h.y + v[1], h.z + v[2], h.w + v[3]);
        } else {
          *(uint2*)(Cb + (size_t)row * ldc + col) = make_uint2(pack2(v[0], v[1]), pack2(v[2], v[3]));
        }
      }
    }
  }
}

template <int MODE>
DEV void ssd_item(const Params& p, int l, int item) {
  const int g = item & 1, c = (item >> 1) & 127, b = item >> 8;
  const int tid = tid_(), lane = tid & 63, wv = tid >> 6, lr = lane & 15, lq = lane >> 4;
  const bfu* COLS = (const bfu*)(p.ws + O_COLS);
  const float* SIDE = (const float*)(p.ws + O_SIDE);
  float* ST = (float*)(p.ws + O_SST);
  const int tb = b * S + c * 64;
  float* s_dt = (float*)smem;
  float* s_acs = s_dt + 128;
  bfu* XT = (bfu*)(smem + 1024);
  bfu* Bm = XT + 128 * 72;
  bfu* Cm = Bm + 64 * 72;
  bfu* Mw = Cm + 64 * 72 + wv * (16 * 72);
  __syncthreads();
  if (wv < 2) {
    int h = g * 2 + wv;
    float dtv = softplusf_(SIDE[(size_t)(tb + lane) * 16 + h] + p.ssm_dt_bias[l * 4 + h]);
    float s = -__expf(p.ssm_a_log[l * 4 + h]) * dtv;
    for (int o = 1; o < 64; o <<= 1) { float t = __shfl_up(s, o); if (lane >= o) s += t; }
    s_dt[wv * 64 + lane] = dtv; s_acs[wv * 64 + lane] = s;
  }
  __syncthreads();
  {
    const int cg8 = tid & 31, tg = tid >> 5;
    const int lc = cg8 * 8;
    const int xc = (lc < 128) ? (g * 128 + lc) : (lc < 192 ? 256 + g * 64 + (lc - 128) : 384 + g * 64 + (lc - 192));
    if (MODE == 1 || lc < 192) {
      float w[4][8], bias[8];
#pragma unroll
      for (int i = 0; i < 8; ++i) {
        bias[i] = p.ssm_conv_b[l * 512 + xc + i];
#pragma unroll
        for (int k = 0; k < 4; ++k) w[k][i] = p.ssm_conv_w[(l * 4 + k) * 512 + xc + i];
      }
      const int tl0 = tg * 8;
      float win[3][8];
      float outv[8][8];
#pragma unroll
      for (int rr = 0; rr < 11; ++rr) {
        int tl = tl0 - 3 + rr; int tpos = c * 64 + tl;
        float cur[8];
        if (tpos >= 0) {
          uint4 u = *(const uint4*)(COLS + (size_t)(b * S + tpos) * NIN + C_XBC + xc);
          cur[0] = lo2f(u.x); cur[1] = hi2f(u.x); cur[2] = lo2f(u.y); cur[3] = hi2f(u.y); cur[4] = lo2f(u.z); cur[5] = hi2f(u.z); cur[6] = lo2f(u.w); cur[7] = hi2f(u.w);
        } else {
#pragma unroll
          for (int i = 0; i < 8; ++i) cur[i] = 0.f;
        }
        if (rr >= 3) {
#pragma unroll
          for (int i = 0; i < 8; ++i) {
            float a = bias[i] + w[0][i] * win[0][i] + w[1][i] * win[1][i] + w[2][i] * win[2][i] + w[3][i] * cur[i];
            outv[rr - 3][i] = siluf_(a);
          }
        }
#pragma unroll
        for (int i = 0; i < 8; ++i) { win[0][i] = win[1][i]; win[1][i] = win[2][i]; win[2][i] = cur[i]; }
      }
      if (lc < 128) {
        const int hh = lc >> 6;
        float sc[8];
#pragma unroll
        for (int j = 0; j < 8; ++j) {
          float d = s_dt[hh * 64 + tl0 + j];
          if (MODE == 0) d *= __expf(s_acs[hh * 64 + 63] - s_acs[hh * 64 + tl0 + j]);
          sc[j] = d;
        }
#pragma unroll
        for (int i = 0; i < 8; ++i) {
          uint4 o = make_uint4(pack2(outv[0][i] * sc[0], outv[1][i] * sc[1]), pack2(outv[2][i] * sc[2], outv[3][i] * sc[3]),
                               pack2(outv[4][i] * sc[4], outv[5][i] * sc[5]), pack2(outv[6][i] * sc[6], outv[7][i] * sc[7]));
          *(uint4*)(XT + (lc + i) * 72 + tl0) = o;
        }
      } else if (lc < 192) {
        if (MODE == 0) {
#pragma unroll
          for (int i = 0; i < 8; ++i) {
            uint4 o = make_uint4(pack2(outv[0][i], outv[1][i]), pack2(outv[2][i], outv[3][i]), pack2(outv[4][i], outv[5][i]), pack2(outv[6][i], outv[7][i]));
            *(uint4*)(Bm + (lc - 128 + i) * 72 + tl0) = o;
          }
        } else {
#pragma unroll
          for (int j = 0; j < 8; ++j) {
            uint4 o = make_uint4(pack2(outv[j][0], outv[j][1]), pack2(outv[j][2], outv[j][3]), pack2(outv[j][4], outv[j][5]), pack2(outv[j][6], outv[j][7]));
            *(uint4*)(Bm + (tl0 + j) * 72 + (lc - 128)) = o;
          }
        }
      } else {
#pragma unroll
        for (int j = 0; j < 8; ++j) {
          uint4 o = make_uint4(pack2(outv[j][0], outv[j][1]), pack2(outv[j][2], outv[j][3]), pack2(outv[j][4], outv[j][5]), pack2(outv[j][6], outv[j][7]));
          *(uint4*)(Cm + (tl0 + j) * 72 + (lc - 192)) = o;
        }
      }
    }
  }
  __syncthreads();
  if (MODE == 0) {
    const int hh = wv >> 1, ph = wv & 1, h = g * 2 + hh;
    f32x4 acc[2][4];
#pragma unroll
    for (int i = 0; i < 2; ++i)
#pragma unroll
      for (int j = 0; j < 4; ++j) acc[i][j] = (f32x4){0.f, 0.f, 0.f, 0.f};
#pragma unroll
    for (int ks = 0; ks < 2; ++ks) {
      bf16x8 af[2], bfr[4];
#pragma unroll
      for (int i = 0; i < 2; ++i) af[i] = *(const bf16x8*)(XT + (hh * 64 + ph * 32 + i * 16 + lr) * 72 + ks * 32 + lq * 8);
#pragma unroll
      for (int j = 0; j < 4; ++j) bfr[j] = *(const bf16x8*)(Bm + (j * 16 + lr) * 72 + ks * 32 + lq * 8);
#pragma unroll
      for (int i = 0; i < 2; ++i)
#pragma unroll
        for (int j = 0; j < 4; ++j) acc[i][j] = mfma16(af[i], bfr[j], acc[i][j]);
    }
    float* dst = ST + ((size_t)((b * 4 + h) * NCH + c)) * 4096;
#pragma unroll
    for (int i = 0; i < 2; ++i)
#pragma unroll
      for (int j = 0; j < 4; ++j)
#pragma unroll
        for (int r = 0; r < 4; ++r) dst[(ph * 32 + i * 16 + lq * 4 + r) * 64 + j * 16 + lr] = acc[i][j][r];
    if (tid < 2) ((float*)(p.ws + O_SAT))[(b * 4 + g * 2 + tid) * NCH + c] = s_acs[tid * 64 + 63];
  } else {
    bf16x8 cf[2];
#pragma unroll
    for (int ks = 0; ks < 2; ++ks) cf[ks] = *(const bf16x8*)(Cm + (wv * 16 + lr) * 72 + ks * 32 + lq * 8);
    f32x4 G[4];
#pragma unroll
    for (int st = 0; st < 4; ++st) {
      G[st] = (f32x4){0.f, 0.f, 0.f, 0.f};
      if (st <= wv) {
#pragma unroll
        for (int ks = 0; ks < 2; ++ks) G[st] = mfma16(cf[ks], *(const bf16x8*)(Bm + (st * 16 + lr) * 72 + ks * 32 + lq * 8), G[st]);
      }
    }
    f32x4 Y[2][4];
#pragma unroll
    for (int hh = 0; hh < 2; ++hh) {
      const int h = g * 2 + hh;
      const float* Hs = ST + ((size_t)((b * 4 + h) * NCH + c)) * 4096;
      float al[4];
#pragma unroll
      for (int r = 0; r < 4; ++r) al[r] = s_acs[hh * 64 + wv * 16 + lq * 4 + r];
#pragma unroll
      for (int pt = 0; pt < 4; ++pt) {
        f32x4 y = {0.f, 0.f, 0.f, 0.f};
#pragma unroll
        for (int ks = 0; ks < 2; ++ks) {
          const float4* hp = (const float4*)(Hs + (pt * 16 + lr) * 64 + ks * 32 + lq * 8);
          float4 h0 = hp[0], h1 = hp[1];
          bf16x8 hb;
          unsigned u0 = pack2(h0.x, h0.y), u1 = pack2(h0.z, h0.w), u2 = pack2(h1.x, h1.y), u3 = pack2(h1.z, h1.w);
          hb[0] = (short)(u0 & 0xffff); hb[1] = (short)(u0 >> 16); hb[2] = (short)(u1 & 0xffff); hb[3] = (short)(u1 >> 16);
          hb[4] = (short)(u2 & 0xffff); hb[5] = (short)(u2 >> 16); hb[6] = (short)(u3 & 0xffff); hb[7] = (short)(u3 >> 16);
          y = mfma16(cf[ks], hb, y);
        }
#pragma unroll
        for (int r = 0; r < 4; ++r) y[r] *= __expf(al[r]);
        Y[hh][pt] = y;
      }
#pragma unroll
      for (int st = 0; st < 4; ++st) {
        float as = s_acs[hh * 64 + st * 16 + lr];
#pragma unroll
        for (int r = 0; r < 4; ++r) {
          int ll = wv * 16 + lq * 4 + r, ss = st * 16 + lr;
          float m = (ss <= ll) ? G[st][r] * __expf(al[r] - as) : 0.f;
          Mw[(lq * 4 + r) * 72 + st * 16 + lr] = f2bf(m);
        }
      }
      for (int ks = 0; ks <= (wv >> 1); ++ks) {
        bf16x8 ma = *(const bf16x8*)(Mw + lr * 72 + ks * 32 + lq * 8);
#pragma unroll
        for (int pt = 0; pt < 4; ++pt)
          Y[hh][pt] = mfma16(ma, *(const bf16x8*)(XT + (hh * 64 + pt * 16 + lr) * 72 + ks * 32 + lq * 8), Y[hh][pt]);
      }
    }
    float ssq[4] = {0.f, 0.f, 0.f, 0.f};
#pragma unroll
    for (int hh = 0; hh < 2; ++hh) {
      const int h = g * 2 + hh;
      const float dsk = p.ssm_d[l * 4 + h];
#pragma unroll
      for (int pt = 0; pt < 4; ++pt)
#pragma unroll
        for (int r = 0; r < 4; ++r) {
          int ll = wv * 16 + lq * 4 + r, pch = pt * 16 + lr;
          float xs = bf2f(XT[(hh * 64 + pch) * 72 + ll]) / s_dt[hh * 64 + ll];
          float z = bf2f(COLS[(size_t)(tb + ll) * NIN + C_Z + h * 64 + pch]);
          float y = (Y[hh][pt][r] + dsk * xs) * siluf_(z);
          Y[hh][pt][r] = y; ssq[r] += y * y;
        }
    }
    bfu* MIX = (bfu*)(p.ws + O_ACT);
#pragma unroll
    for (int r = 0; r < 4; ++r) {
      float sc = rsqrtf(row16_sum(ssq[r]) * (1.f / 128.f) + 1e-6f);
      int ll = wv * 16 + lq * 4 + r;
#pragma unroll
      for (int hh = 0; hh < 2; ++hh)
#pragma unroll
        for (int pt = 0; pt < 4; ++pt) {
          int ch = (g * 2 + hh) * 64 + pt * 16 + lr;
          MIX[(size_t)(tb + ll) * 1024 + ch] = f2bf(Y[hh][pt][r] * sc * p.ssm_norm[l * 256 + ch]);
        }
    }
  }
}
DEV void ssd_rec_item(const Params& p, int item) {
  const int bh = item >> 4, e = (item & 15) * 256 + tid_();
  float* ST = (float*)(p.ws + O_SST) + (size_t)bh * NCH * 4096 + e;
  const float* AT = (const float*)(p.ws + O_SAT) + bh * NCH;
  float H = 0.f;
  for (int c0 = 0; c0 < NCH; c0 += 8) {
    float s[8];
#pragma unroll
    for (int i = 0; i < 8; ++i) s[i] = ST[(size_t)(c0 + i) * 4096];
#pragma unroll
    for (int i = 0; i < 8; ++i) { ST[(size_t)(c0 + i) * 4096] = H; H = __expf(AT[c0 + i]) * H + s[i]; }
  }
}

template <int MODE>
DEV void lru_item(const Params& p, int l, int item) {
  const int hb = item & 3, c = (item >> 2) & 127, b = item >> 9;
  const int tid = tid_(), lane = tid & 63, wv = tid >> 6, lr = lane & 15, lq = lane >> 4;
  const bfu* COLS = (const bfu*)(p.ws + O_COLS);
  const int tb = b * S + c * 64;
  bfu* Xl = (bfu*)smem;
  float* Af = (float*)(smem + 9216);
  float* Uf = Af + 4096;
  __syncthreads();
  {
    const int cg8 = tid & 7, tg = tid >> 3;
    const int ch = hb * 64 + cg8 * 8;
    float w[4][8], bias[8];
#pragma unroll
    for (int i = 0; i < 8; ++i) {
      bias[i] = p.lru_conv_b[l * 256 + ch + i];
#pragma unroll
      for (int k = 0; k < 4; ++k) w[k][i] = p.lru_conv_w[(l * 4 + k) * 256 + ch + i];
    }
    float win[3][8];
#pragma unroll
    for (int rr = 0; rr < 5; ++rr) {
      int tl = tg * 2 - 3 + rr; int tpos = c * 64 + tl;
      float cur[8];
      if (tpos >= 0) {
        uint4 u = *(const uint4*)(COLS + (size_t)(b * S + tpos) * NIN + C_LX + ch);
        cur[0] = lo2f(u.x); cur[1] = hi2f(u.x); cur[2] = lo2f(u.y); cur[3] = hi2f(u.y); cur[4] = lo2f(u.z); cur[5] = hi2f(u.z); cur[6] = lo2f(u.w); cur[7] = hi2f(u.w);
      } else {
#pragma unroll
        for (int i = 0; i < 8; ++i) cur[i] = 0.f;
      }
      if (rr >= 3) {
        float o[8];
#pragma unroll
        for (int i = 0; i < 8; ++i) o[i] = bias[i] + w[0][i] * win[0][i] + w[1][i] * win[1][i] + w[2][i] * win[2][i] + w[3][i] * cur[i];
        *(uint4*)(Xl + tl * 72 + cg8 * 8) = make_uint4(pack2(o[0], o[1]), pack2(o[2], o[3]), pack2(o[4], o[5]), pack2(o[6], o[7]));
        *(float4*)(Uf + tl * 64 + cg8 * 8) = make_float4(o[0], o[1], o[2], o[3]);
        *(float4*)(Uf + tl * 64 + cg8 * 8 + 4) = make_float4(o[4], o[5], o[6], o[7]);
      }
#pragma unroll
      for (int i = 0; i < 8; ++i) { win[0][i] = win[1][i]; win[1][i] = win[2][i]; win[2][i] = cur[i]; }
    }
  }
  __syncthreads();
  {
    const bfu* waT = (const bfu*)(p.ws + O_W + (size_t)l * W_SZ + W_LA) + hb * 4096;
    const bfu* wiT = (const bfu*)(p.ws + O_W + (size_t)l * W_SZ + W_LI) + hb * 4096;
    bf16x8 xa[2];
#pragma unroll
    for (int ks = 0; ks < 2; ++ks) xa[ks] = *(const bf16x8*)(Xl + (wv * 16 + lr) * 72 + ks * 32 + lq * 8);
#pragma unroll
    for (int jt = 0; jt < 4; ++jt) {
      f32x4 R = {0.f, 0.f, 0.f, 0.f}, I = {0.f, 0.f, 0.f, 0.f};
#pragma unroll
      for (int ks = 0; ks < 2; ++ks) {
        R = mfma16(xa[ks], ld8(waT + (jt * 16 + lr) * 64 + ks * 32 + lq * 8), R);
        I = mfma16(xa[ks], ld8(wiT + (jt * 16 + lr) * 64 + ks * 32 + lq * 8), I);
      }
      const int j = jt * 16 + lr, ch = hb * 64 + j;
      const float ba = p.lru_ba[l * 256 + ch], bi = p.lru_bi[l * 256 + ch];
      const float lsl = -softplusf_(-p.lru_lambda[l * 256 + ch]);
#pragma unroll
      for (int r = 0; r < 4; ++r) {
        int ll = wv * 16 + lq * 4 + r;
        float rg = sigmoidf_(R[r] + ba), ig = sigmoidf_(I[r] + bi);
        float la = 8.f * rg * lsl;
        float a = __expf(la);
        float xb = Uf[ll * 64 + j];
        float u = sqrtf(-expm1f(2.f * la)) * ig * xb;
        Af[ll * 64 + j] = a; Uf[ll * 64 + j] = u;
      }
    }
  }
  __syncthreads();
  const size_t sidx = (size_t)(b * NCH + c) * 256 + hb * 64;
  if (wv == 0) {
    if (MODE == 0) {
      float A = 1.f, h = 0.f;
      for (int t = 0; t < 64; ++t) { float a = Af[t * 64 + lane]; h = a * h + Uf[t * 64 + lane]; A *= a; }
      ((float*)(p.ws + O_LA))[sidx + lane] = A; ((float*)(p.ws + O_LH))[sidx + lane] = h;
    } else {
      float h = ((const float*)(p.ws + O_LH))[sidx + lane];
      for (int t = 0; t < 64; ++t) { h = Af[t * 64 + lane] * h + Uf[t * 64 + lane]; Uf[t * 64 + lane] = h; }
    }
  }
  if (MODE == 1) {
    __syncthreads();
    const int ll = tid >> 2, jq = (tid & 3) * 16;
    bfu* MIX = (bfu*)(p.ws + O_ACT) + (size_t)(tb + ll) * 1024 + 256 + hb * 64 + jq;
    const bfu* gp = COLS + (size_t)(tb + ll) * NIN + C_LG + hb * 64 + jq;
    unsigned ov[8];
#pragma unroll
    for (int i = 0; i < 8; ++i) {
      unsigned gu = *(const unsigned*)(gp + i * 2);
      float y0 = Uf[ll * 64 + jq + i * 2] * geluf_(lo2f(gu)), y1 = Uf[ll * 64 + jq + i * 2 + 1] * geluf_(hi2f(gu));
      ov[i] = pack2(y0, y1);
    }
    *(uint4*)MIX = make_uint4(ov[0], ov[1], ov[2], ov[3]);
    *(uint4*)(MIX + 8) = make_uint4(ov[4], ov[5], ov[6], ov[7]);
  }
}
DEV void lru_carry_item(const Params& p, int item) {
  const int i = item * 256 + tid_();
  const int b = i >> 8, ch = i & 255;
  const float* LA = (const float*)(p.ws + O_LA) + (size_t)b * NCH * 256 + ch;
  float* LH = (float*)(p.ws + O_LH) + (size_t)b * NCH * 256 + ch;
  float H = 0.f;
  for (int c = 0; c < NCH; ++c) { float A = LA[c * 256], he = LH[c * 256]; LH[c * 256] = H; H = A * H + he; }
}
DEV void shifted8(const bfu* COLS, const float* mu, int t, int col, float* out) {
  uint4 u = *(const uint4*)(COLS + (size_t)t * NIN + C_RWKV + col);
  float c[8] = {lo2f(u.x), hi2f(u.x), lo2f(u.y), hi2f(u.y), lo2f(u.z), hi2f(u.z), lo2f(u.w), hi2f(u.w)};
  float pv[8] = {0.f, 0.f, 0.f, 0.f, 0.f, 0.f, 0.f, 0.f};
  if ((t & (S - 1)) != 0) {
    uint4 q = *(const uint4*)(COLS + (size_t)(t - 1) * NIN + C_RWKV + col);
    pv[0] = lo2f(q.x); pv[1] = hi2f(q.x); pv[2] = lo2f(q.y); pv[3] = hi2f(q.y); pv[4] = lo2f(q.z); pv[5] = hi2f(q.z); pv[6] = lo2f(q.w); pv[7] = hi2f(q.w);
  }
#pragma unroll
  for (int i = 0; i < 8; ++i) out[i] = c[i] + (pv[i] - c[i]) * mu[col + i];
}
DEV float shifted1(const bfu* COLS, const float* mu, int t, int col) {
  float c = bf2f(COLS[(size_t)t * NIN + C_RWKV + col]);
  float pv = ((t & (S - 1)) != 0) ? bf2f(COLS[(size_t)(t - 1) * NIN + C_RWKV + col]) : 0.f;
  return c + (pv - c) * mu[col];
}
DEV bf16x8 packf8(const float* v) {
  bf16x8 o;
#pragma unroll
  for (int i = 0; i < 8; ++i) o[i] = (short)f2bf(v[i]);
  return o;
}
DEV void rwkv_prep_item(const Params& p, int l, int item) {
  const int lane = tid_() & 63, wv = tid_() >> 6, lr = lane & 15, lq = lane >> 4;
  const bfu* COLS = (const bfu*)(p.ws + O_COLS);
  const float* mu = p.rwkv_mu + l * 1024;
  const int t0 = item * 64 + wv * 16;
  const unsigned char* wb = p.ws + O_W + (size_t)l * W_SZ;
  const bfu* w2T = (const bfu*)(wb + W_R2); const bfu* a2T = (const bfu*)(wb + W_A2); const bfu* g2T = (const bfu*)(wb + W_G2);
  bf16x8 wdA[2], adA[2], gdA[4];
  {
    float tmp[8];
#pragma unroll
    for (int ks = 0; ks < 2; ++ks) {
      shifted8(COLS, mu, t0 + lr, 768 + ks * 32 + lq * 8, tmp);
#pragma unroll
      for (int i = 0; i < 8; ++i) tmp[i] = tanhf(tmp[i]);
      wdA[ks] = packf8(tmp);
      shifted8(COLS, mu, t0 + lr, 832 + ks * 32 + lq * 8, tmp);
      adA[ks] = packf8(tmp);
    }
#pragma unroll
    for (int ks = 0; ks < 4; ++ks) {
      shifted8(COLS, mu, t0 + lr, 896 + ks * 32 + lq * 8, tmp);
#pragma unroll
      for (int i = 0; i < 8; ++i) tmp[i] = sigmoidf_(tmp[i]);
      gdA[ks] = packf8(tmp);
    }
  }
  const int b = t0 / S;
  bfu* RG = (bfu*)(p.ws + O_RG);
  for (int hd = 0; hd < 4; ++hd) {
    float kkv[4][4], av[4][4], k2v[4][4], rv[4][4], vv[4][4], wv_[4][4];
    float ss[4] = {0.f, 0.f, 0.f, 0.f};
#pragma unroll
    for (int q = 0; q < 4; ++q) {
      const int nt = hd * 4 + q, n = nt * 16 + lr;
      f32x4 W = {0.f, 0.f, 0.f, 0.f}, A = {0.f, 0.f, 0.f, 0.f}, G = {0.f, 0.f, 0.f, 0.f};
#pragma unroll
      for (int ks = 0; ks < 2; ++ks) {
        W = mfma16(wdA[ks], ld8(w2T + n * 64 + ks * 32 + lq * 8), W);
        A = mfma16(adA[ks], ld8(a2T + n * 64 + ks * 32 + lq * 8), A);
      }
#pragma unroll
      for (int ks = 0; ks < 4; ++ks) G = mfma16(gdA[ks], ld8(g2T + n * 128 + ks * 32 + lq * 8), G);
      const float w0 = p.rwkv_w0[l * 256 + n], a0 = p.rwkv_a0[l * 256 + n], kkw = p.rwkv_kk[l * 256 + n], kaw = p.rwkv_ka[l * 256 + n];
#pragma unroll
      for (int r = 0; r < 4; ++r) {
        const int t = t0 + lq * 4 + r;
        float wl = -softplusf_(-(w0 + W[r])) - 0.5f;
        wv_[q][r] = __expf(-__expf(wl));
        float a = sigmoidf_(a0 + A[r]);
        float r_ = shifted1(COLS, mu, t, n), k_ = shifted1(COLS, mu, t, 256 + n), v_ = shifted1(COLS, mu, t, 512 + n);
        float kk = k_ * kkw;
        kkv[q][r] = kk; ss[r] += kk * kk; av[q][r] = a;
        k2v[q][r] = k_ * (1.f + (a - 1.f) * kaw);
        rv[q][r] = r_; vv[q][r] = v_;
        RG[(size_t)t * 256 + n] = f2bf(G[r]);
      }
    }
#pragma unroll
    for (int r = 0; r < 4; ++r) {
      float nrm = fmaxf(sqrtf(row16_sum(ss[r])), 1e-12f);
      float inv = 1.f / nrm;
      const int t = t0 + lq * 4 + r;
      unsigned char* dst = p.ws + O_RIN + ((size_t)(b * 4 + hd) * S + (t & (S - 1))) * 896;
#pragma unroll
      for (int q = 0; q < 4; ++q) {
        const int j = q * 16 + lr;
        float kkn = kkv[q][r] * inv;
        ((float*)dst)[j] = wv_[q][r];
        ((bfu*)(dst + 256))[j] = f2bf(-kkn);
        ((bfu*)(dst + 384))[j] = f2bf(kkn * av[q][r]);
        ((bfu*)(dst + 512))[j] = f2bf(k2v[q][r]);
        ((bfu*)(dst + 640))[j] = f2bf(rv[q][r]);
        ((bfu*)(dst + 768))[j] = f2bf(vv[q][r]);
      }
    }
  }
}
typedef float f32x2s __attribute__((ext_vector_type(2)));
DEV void rwkv_stage_write(float* dstbuf, uint4 v, int off, bool isw) {
  if (isw) { *(uint4*)(dstbuf + off) = v; }
  else {
    *(float4*)(dstbuf + off) = make_float4(lo2f(v.x), hi2f(v.x), lo2f(v.y), hi2f(v.y));
    *(float4*)(dstbuf + off + 4) = make_float4(lo2f(v.z), hi2f(v.z), lo2f(v.w), hi2f(v.w));
  }
}
DEV void rwkv_scan_item(const Params& p, int item) {
  const int bh = item >> 2, qd = item & 3;
  const int tid = tid_(), lane = tid & 63, wv = tid >> 6, lr = lane & 15, lq = lane >> 4;
  const unsigned char* src = p.ws + O_RIN + (size_t)bh * S * 896;
  float* Y = (float*)(p.ws + O_RY) + (size_t)(bh >> 2) * S * 256 + (bh & 3) * 64;
  const int irow = qd * 16 + wv * 4 + lq;
  float* buf = (float*)smem;
  constexpr int CH = 16, CB = CH * 896, CF = CH * 384;
  int soff[4]; bool sw[4];
#pragma unroll
  for (int i = 0; i < 4; ++i) {
    int idx = tid + i * 256; int st = idx / 56, wi = idx - st * 56;
    sw[i] = wi < 16;
    soff[i] = st * 384 + (sw[i] ? wi * 4 : 64 + ((wi - 16) >> 3) * 64 + ((wi - 16) & 7) * 8);
  }
  const bool t3 = tid < 896 - 768;
  __syncthreads();
  uint4 st0, st1, st2, st3 = make_uint4(0, 0, 0, 0);
  st0 = ((const uint4*)src)[tid]; st1 = ((const uint4*)src)[tid + 256]; st2 = ((const uint4*)src)[tid + 512]; if (t3) st3 = ((const uint4*)src)[tid + 768];
  rwkv_stage_write(buf, st0, soff[0], sw[0]); rwkv_stage_write(buf, st1, soff[1], sw[1]); rwkv_stage_write(buf, st2, soff[2], sw[2]);
  if (t3) rwkv_stage_write(buf, st3, soff[3], sw[3]);
  __syncthreads();
  f32x2s s01 = {0.f, 0.f}, s23 = {0.f, 0.f};
  for (int ch = 0; ch < S / CH; ++ch) {
    if (ch + 1 < S / CH) {
      const uint4* nsrc = (const uint4*)(src + (size_t)(ch + 1) * CB);
      st0 = nsrc[tid]; st1 = nsrc[tid + 256]; st2 = nsrc[tid + 512]; if (t3) st3 = nsrc[tid + 768];
    }
    const float* cb = buf + (ch & 1) * CF;
    float ykeep = 0.f;
    float4 W = *(const float4*)(cb + lr * 4), NK = *(const float4*)(cb + 64 + lr * 4), KA = *(const float4*)(cb + 128 + lr * 4);
    float4 KK = *(const float4*)(cb + 192 + lr * 4), RR = *(const float4*)(cb + 256 + lr * 4);
    float v = cb[320 + irow];
#pragma unroll
    for (int s = 0; s < CH; ++s) {
      float4 W2, NK2, KA2, KK2, RR2; float v2;
      if (s + 1 < CH) {
        const float* nb2 = cb + (s + 1) * 384;
        W2 = *(const float4*)(nb2 + lr * 4); NK2 = *(const float4*)(nb2 + 64 + lr * 4); KA2 = *(const float4*)(nb2 + 128 + lr * 4);
        KK2 = *(const float4*)(nb2 + 192 + lr * 4); RR2 = *(const float4*)(nb2 + 256 + lr * 4); v2 = nb2[320 + irow];
      }
      f32x2s t = s01 * (f32x2s){NK.x, NK.y}; t = s23 * (f32x2s){NK.z, NK.w} + t;
      f32x2s vv = {v, v};
      f32x2s u01 = s01 * (f32x2s){W.x, W.y}; u01 = vv * (f32x2s){KK.x, KK.y} + u01;
      f32x2s u23 = s23 * (f32x2s){W.z, W.w}; u23 = vv * (f32x2s){KK.z, KK.w} + u23;
      const float sa = row16_sum(t.x + t.y);
      f32x2s sav = {sa, sa};
      s01 = sav * (f32x2s){KA.x, KA.y} + u01;
      s23 = sav * (f32x2s){KA.z, KA.w} + u23;
      f32x2s yy = s01 * (f32x2s){RR.x, RR.y}; yy = s23 * (f32x2s){RR.z, RR.w} + yy;
      const float y = row16_sum(yy.x + yy.y);
      ykeep = (lr == s) ? y : ykeep;
      if (s + 1 < CH) { W = W2; NK = NK2; KA = KA2; KK = KK2; RR = RR2; v = v2; }
    }
    Y[(size_t)(ch * CH + lr) * 256 + irow] = ykeep;
    if (ch + 1 < S / CH) {
      float* nb = buf + ((ch + 1) & 1) * CF;
      rwkv_stage_write(nb, st0, soff[0], sw[0]); rwkv_stage_write(nb, st1, soff[1], sw[1]); rwkv_stage_write(nb, st2, soff[2], sw[2]);
      if (t3) rwkv_stage_write(nb, st3, soff[3], sw[3]);
    }
    __syncthreads();
  }
}
DEV void rwkv_post_item(const Params& p, int l, int item) {
  const int lane = tid_() & 63, wv = tid_() >> 6;
  const float* RY = (const float*)(p.ws + O_RY);
  const bfu* RG = (const bfu*)(p.ws + O_RG);
  bfu* MIX = (bfu*)(p.ws + O_ACT);
  for (int k = 0; k < 64; ++k) {
    const int t = item * 64 + wv * 16 + (k >> 2), h = k & 3;
    const int b = t / S, tp = t & (S - 1);
    float y = RY[(size_t)t * 256 + h * 64 + lane];
    float mean = wave_sum(y) * (1.f / 64.f);
    float d = y - mean;
    float var = wave_sum(d * d) * (1.f / 64.f);
    const int ch = h * 64 + lane;
    float yn = d * rsqrtf(var + 64e-5f) * p.rwkv_ln_w[l * 256 + ch] + p.rwkv_ln_b[l * 256 + ch];
    const unsigned char* src = p.ws + O_RIN + ((size_t)(b * 4 + h) * S + tp) * 896;
    float k2 = bf2f(((const bfu*)(src + 512))[lane]), r_ = bf2f(((const bfu*)(src + 640))[lane]), v_ = bf2f(((const bfu*)(src + 768))[lane]);
    float bonus = wave_sum(r_ * k2 * p.rwkv_rk[l * 256 + ch]);
    float o = (yn + bonus * v_) * bf2f(RG[(size_t)t * 256 + ch]);
    MIX[(size_t)t * 1024 + 512 + ch] = f2bf(o);
  }
}
DEV void nsa_tr_item(const Params& p, int item) {
  const int which = item & 1, tt = (item >> 1) & 127, b = item >> 8;
  const int tid = tid_();
  const bfu* COLS = (const bfu*)(p.ws + O_COLS);
  bfu* dst = (bfu*)(p.ws + (which ? O_VWT : O_VST)) + (size_t)b * 64 * S;
  const int col0 = which ? C_VW : C_VS;
  bfu* tl = (bfu*)smem;
  __syncthreads();
  for (int i = tid; i < 64 * 32; i += NTHR) {
    int tok = i >> 5, dp = i & 31;
    unsigned u = *(const unsigned*)(COLS + (size_t)(b * S + tt * 64 + tok) * NIN + col0 + dp * 2);
    *(unsigned*)(tl + tok * 66 + dp * 2) = u;
  }
  __syncthreads();
  {
    const int d = tid >> 2, tq = (tid & 3) * 16;
    unsigned o[8];
#pragma unroll
    for (int i = 0; i < 8; ++i) o[i] = (unsigned)tl[(tq + i * 2) * 66 + d] | ((unsigned)tl[(tq + i * 2 + 1) * 66 + d] << 16);
    uint4* dp = (uint4*)(dst + (size_t)d * S + tt * 64 + tq);
    dp[0] = make_uint4(o[0], o[1], o[2], o[3]); dp[1] = make_uint4(o[4], o[5], o[6], o[7]);
  }
}
DEV void nsa_cmp_item(const Params& p, int l, int item) {
  const int mt = item & 31, b = (item >> 5) & 3, which = item >> 7;
  const int tid = tid_(), lane = tid & 63, wv = tid >> 6, lr = lane & 15, lq = lane >> 4;
  const bfu* COLS = (const bfu*)(p.ws + O_COLS);
  const unsigned char* wb = p.ws + O_W + (size_t)l * W_SZ;
  const bfu* w1T = (const bfu*)(wb + W_C1) + (size_t)which * 256 * 2048;
  const bfu* w2T = (const bfu*)(wb + W_C2) + (size_t)which * 64 * 256;
  const float* pos = p.nsa_cmp_pos + ((size_t)l * 2 + which) * 2048;
  const int col0 = which ? C_VC : C_KC;
  bfu* Hs = (bfu*)smem;
  int blk = mt * 16 + lr; if (blk > 510) blk = 510;
  const bfu* arow = COLS + (size_t)(b * S + blk * 16) * NIN + col0 + lq * 8;
  f32x4 acc[4];
#pragma unroll
  for (int j = 0; j < 4; ++j) acc[j] = (f32x4){0.f, 0.f, 0.f, 0.f};
  for (int ks = 0; ks < 64; ++ks) {
    uint4 u = *(const uint4*)(arow + (size_t)(ks >> 1) * NIN + (ks & 1) * 32);
    const float4* pp = (const float4*)(pos + ks * 32 + lq * 8);
    float4 p0 = pp[0], p1 = pp[1];
    float av[8] = {lo2f(u.x) + p0.x, hi2f(u.x) + p0.y, lo2f(u.y) + p0.z, hi2f(u.y) + p0.w, lo2f(u.z) + p1.x, hi2f(u.z) + p1.y, lo2f(u.w) + p1.z, hi2f(u.w) + p1.w};
    bf16x8 a = packf8(av);
#pragma unroll
    for (int j = 0; j < 4; ++j) acc[j] = mfma16(a, ld8(w1T + (size_t)(wv * 64 + j * 16 + lr) * 2048 + ks * 32 + lq * 8), acc[j]);
  }
  __syncthreads();
#pragma unroll
  for (int j = 0; j < 4; ++j)
#pragma unroll
    for (int r = 0; r < 4; ++r) Hs[(lq * 4 + r) * 264 + wv * 64 + j * 16 + lr] = f2bf(geluf_(acc[j][r]));
  __syncthreads();
  f32x4 o = {0.f, 0.f, 0.f, 0.f};
#pragma unroll
  for (int ks = 0; ks < 8; ++ks) o = mfma16(*(const bf16x8*)(Hs + lr * 264 + ks * 32 + lq * 8), ld8(w2T + (wv * 16 + lr) * 256 + ks * 32 + lq * 8), o);
#pragma unroll
  for (int r = 0; r < 4; ++r) {
    int bi = mt * 16 + lq * 4 + r, d = wv * 16 + lr;
    float v = (bi < 511) ? o[r] : 0.f;
    if (which == 0) ((bfu*)(p.ws + O_KCMP))[((size_t)b * 512 + bi) * 64 + d] = f2bf(v);
    else ((bfu*)(p.ws + O_VCT))[((size_t)b * 64 + d) * 512 + bi] = f2bf(v);
  }
}

struct AttnState { float m[4], l[4]; f32x4 O[4]; };
DEV void attn_init(AttnState& st) {
#pragma unroll
  for (int r = 0; r < 4; ++r) { st.m[r] = -1e30f; st.l[r] = 0.f; st.O[r] = (f32x4){0.f, 0.f, 0.f, 0.f}; }
}
struct KVF { bf16x8 k00, k01, k10, k11, v0, v1, v2, v3; };
DEV void attn_load(KVF& f, const bfu* kp0, const bfu* kp1, const bfu* vt, size_t vs16) {
  f.k00 = ld8(kp0); f.k01 = ld8(kp0 + 32); f.k10 = ld8(kp1); f.k11 = ld8(kp1 + 32);
  f.v0 = ld8(vt); f.v1 = ld8(vt + vs16); f.v2 = ld8(vt + 2 * vs16); f.v3 = ld8(vt + 3 * vs16);
}
DEV void attn_compute(AttnState& st, const bf16x8* q, const KVF& f, float dist0, bool val0, float dist1, bool val1, bfu* pbuf, int lr, int lq) {
  f32x4 s0 = {0.f, 0.f, 0.f, 0.f}, s1 = {0.f, 0.f, 0.f, 0.f};
  s0 = mfma16(q[0], f.k00, s0); s0 = mfma16(q[1], f.k01, s0);
  s1 = mfma16(q[0], f.k10, s1); s1 = mfma16(q[1], f.k11, s1);
#pragma unroll
  for (int r = 0; r < 4; ++r) {
    const float slope = (r == 0) ? 0.25f : (r == 1) ? 0.0625f : (r == 2) ? 0.015625f : 0.00390625f;
    float a0 = val0 ? s0[r] * 0.125f - slope * dist0 : -1e30f;
    float a1 = val1 ? s1[r] * 0.125f - slope * dist1 : -1e30f;
    float mn = fmaxf(st.m[r], row16_max(fmaxf(a0, a1)));
    float p0 = val0 ? __expf(a0 - mn) : 0.f, p1 = val1 ? __expf(a1 - mn) : 0.f;
    float corr = __expf(st.m[r] - mn);
    st.m[r] = mn;
    st.l[r] = st.l[r] * corr + row16_sum(p0 + p1);
#pragma unroll
    for (int dt = 0; dt < 4; ++dt) st.O[dt][r] *= corr;
    pbuf[(lq * 4 + r) * 40 + lr] = f2bf(p0); pbuf[(lq * 4 + r) * 40 + 16 + lr] = f2bf(p1);
  }
  bf16x8 pa = *(const bf16x8*)(pbuf + lr * 40 + lq * 8);
  st.O[0] = mfma16(pa, f.v0, st.O[0]); st.O[1] = mfma16(pa, f.v1, st.O[1]);
  st.O[2] = mfma16(pa, f.v2, st.O[2]); st.O[3] = mfma16(pa, f.v3, st.O[3]);
}
DEV float wave_maxf_u(float v) {
  v = row16_max(v);
  v = fmaxf(v, __int_as_float(__builtin_amdgcn_update_dpp(__float_as_int(-__builtin_inff()), __float_as_int(v), 0x142, 0xA, 0xF, false)));
  v = fmaxf(v, __int_as_float(__builtin_amdgcn_update_dpp(__float_as_int(-__builtin_inff()), __float_as_int(v), 0x143, 0xC, 0xF, false)));
  return __int_as_float(__builtin_amdgcn_readlane(__float_as_int(v), 63));
}
template <int CTRL> DEV int dppi(int v) { return __builtin_amdgcn_update_dpp(0, v, CTRL, 0xf, 0xf, true); }
DEV int wave_mini_u(int v) {
  v = min(v, dppi<0xB1>(v)); v = min(v, dppi<0x4E>(v)); v = min(v, dppi<0x141>(v)); v = min(v, dppi<0x140>(v));
  v = min(v, __builtin_amdgcn_update_dpp(0x7fffffff, v, 0x142, 0xA, 0xF, false));
  v = min(v, __builtin_amdgcn_update_dpp(0x7fffffff, v, 0x143, 0xC, 0xF, false));
  return __builtin_amdgcn_readlane(v, 63);
}

DEV void nsa_cmpattn_item(const Params& p, int item) {
  const int lane = tid_() & 63, wv = tid_() >> 6, lr = lane & 15, lq = lane >> 4;
  const bfu* COLS = (const bfu*)(p.ws + O_COLS);
  const int t0 = item * 16 + wv * 4;
  const int b = t0 / S, tp0 = t0 & (S - 1);
  const bfu* KC = (const bfu*)(p.ws + O_KCMP) + (size_t)b * 512 * 64;
  const bfu* VCT = (const bfu*)(p.ws + O_VCT) + (size_t)b * 64 * 512;
  bfu* pbuf = (bfu*)smem + wv * 640;
  float* ps = (float*)(smem + 5120) + wv * (4 * 516);
  bf16x8 q[2];
#pragma unroll
  for (int ks = 0; ks < 2; ++ks) q[ks] = ld8(COLS + (size_t)(t0 + (lr >> 2)) * NIN + C_Q + (lr & 3) * 64 + ks * 32 + lq * 8);
  const int pos = tp0 + lq;
  const int pmax = tp0 + 3;
  const int nvalid = (pmax >= 31) ? ((pmax - 31) >> 4) + 1 : 0;
  const int nkt = (nvalid + 31) >> 5;
  float m[4] = {-1e30f, -1e30f, -1e30f, -1e30f}, z[4] = {0.f, 0.f, 0.f, 0.f};
  for (int kt = 0; kt < nkt; ++kt) {
    const int n0 = kt * 32 + lr, n1 = n0 + 16;
    f32x4 s0 = {0.f, 0.f, 0.f, 0.f}, s1 = {0.f, 0.f, 0.f, 0.f};
    s0 = mfma16(q[0], ld8(KC + n0 * 64 + lq * 8), s0); s0 = mfma16(q[1], ld8(KC + n0 * 64 + 32 + lq * 8), s0);
    s1 = mfma16(q[0], ld8(KC + n1 * 64 + lq * 8), s1); s1 = mfma16(q[1], ld8(KC + n1 * 64 + 32 + lq * 8), s1);
    const int d0 = pos - (16 * n0 + 31), d1 = pos - (16 * n1 + 31);
#pragma unroll
    for (int r = 0; r < 4; ++r) {
      const float slope = (r == 0) ? 0.25f : (r == 1) ? 0.0625f : (r == 2) ? 0.015625f : 0.00390625f;
      float a0 = (d0 >= 0) ? s0[r] * 0.125f - slope * (float)d0 : -1e30f;
      float a1 = (d1 >= 0) ? s1[r] * 0.125f - slope * (float)d1 : -1e30f;
      float mn = fmaxf(m[r], row16_max(fmaxf(a0, a1)));
      float p0 = (d0 >= 0) ? __expf(a0 - mn) : 0.f, p1 = (d1 >= 0) ? __expf(a1 - mn) : 0.f;
      z[r] = z[r] * __expf(m[r] - mn) + row16_sum(p0 + p1);
      m[r] = mn;
    }
  }
  float iz[4];
#pragma unroll
  for (int r = 0; r < 4; ++r) iz[r] = 1.f / fmaxf(z[r], 1e-30f);
  f32x4 O[4];
#pragma unroll
  for (int dt = 0; dt < 4; ++dt) O[dt] = (f32x4){0.f, 0.f, 0.f, 0.f};
  for (int kt = 0; kt < nkt; ++kt) {
    const int n0 = kt * 32 + lr, n1 = n0 + 16;
    f32x4 s0 = {0.f, 0.f, 0.f, 0.f}, s1 = {0.f, 0.f, 0.f, 0.f};
    s0 = mfma16(q[0], ld8(KC + n0 * 64 + lq * 8), s0); s0 = mfma16(q[1], ld8(KC + n0 * 64 + 32 + lq * 8), s0);
    s1 = mfma16(q[0], ld8(KC + n1 * 64 + lq * 8), s1); s1 = mfma16(q[1], ld8(KC + n1 * 64 + 32 + lq * 8), s1);
    const int d0 = pos - (16 * n0 + 31), d1 = pos - (16 * n1 + 31);
    float ps0 = 0.f, ps1 = 0.f;
#pragma unroll
    for (int r = 0; r < 4; ++r) {
      const float slope = (r == 0) ? 0.25f : (r == 1) ? 0.0625f : (r == 2) ? 0.015625f : 0.00390625f;
      float p0 = (d0 >= 0) ? __expf(s0[r] * 0.125f - slope * (float)d0 - m[r]) * iz[r] : 0.f;
      float p1 = (d1 >= 0) ? __expf(s1[r] * 0.125f - slope * (float)d1 - m[r]) * iz[r] : 0.f;
      ps0 += p0; ps1 += p1;
      pbuf[(lq * 4 + r) * 40 + lr] = f2bf(p0); pbuf[(lq * 4 + r) * 40 + 16 + lr] = f2bf(p1);
    }
    ps[lq * 516 + n0] = ps0; ps[lq * 516 + n1] = ps1;
    bf16x8 pa = *(const bf16x8*)(pbuf + lr * 40 + lq * 8);
#pragma unroll
    for (int dt = 0; dt < 4; ++dt) O[dt] = mfma16(pa, ld8(VCT + (size_t)(dt * 16 + lr) * 512 + kt * 32 + lq * 8), O[dt]);
  }
  bfu* OC = (bfu*)(p.ws + O_OCMP);
#pragma unroll
  for (int dt = 0; dt < 4; ++dt)
#pragma unroll
    for (int r = 0; r < 4; ++r) OC[(size_t)(t0 + lq) * 256 + r * 64 + dt * 16 + lr] = f2bf(O[dt][r]);
  const int nproc = nkt * 32;
  unsigned long long* SEL = (unsigned long long*)(p.ws + O_SEL);
  for (int tk = 0; tk < 4; ++tk) {
    const int tpos = tp0 + tk, cur = tpos >> 6;
    const float* pr = ps + tk * 516;
    float iv[2];
#pragma unroll
    for (int hh = 0; hh < 2; ++hh) {
      const int j = lane + hh * 64;
      float v = -__builtin_inff();
      if (j <= cur) {
        if (j == 0 || j == cur || j == cur - 1) v = 1e4f;
        else {
          float a = 0.f;
#pragma unroll
          for (int e = -1; e < 4; ++e) {
            int n = 4 * j + e;
            float w = (e == -1 || e == 3) ? 0.5f : 1.f;
            if (n >= 0 && n <= 510 && n < nproc) a += w * pr[n];
          }
          v = a;
        }
      }
      iv[hh] = v;
    }
    bool sel0 = false, sel1 = false;
    const int nsel = (cur + 1 < 16) ? cur + 1 : 16;
    for (int rd = 0; rd < nsel; ++rd) {
      float c0 = sel0 ? -__builtin_inff() : iv[0], c1 = sel1 ? -__builtin_inff() : iv[1];
      const float gm = wave_maxf_u(fmaxf(c0, c1));
      const int bi = wave_mini_u((c0 == gm) ? lane : ((c1 == gm) ? lane + 64 : 0x7fffffff));
      if (bi == lane) sel0 = true;
      if (bi == lane + 64) sel1 = true;
    }
    unsigned long long mlo = __ballot(sel0), mhi = __ballot(sel1);
    if (lane == 0) { SEL[(size_t)(t0 + tk) * 2] = mlo; SEL[(size_t)(t0 + tk) * 2 + 1] = mhi; }
  }
}

DEV void nsa_finish_item(const Params& p, int item) {
  const int lane = tid_() & 63, wv = tid_() >> 6, lr = lane & 15, lq = lane >> 4;
  const bfu* COLS = (const bfu*)(p.ws + O_COLS);
  const float* SIDE = (const float*)(p.ws + O_SIDE);
  const int t0 = item * 16 + wv * 4;
  const int b = t0 / S, tp0 = t0 & (S - 1);
  bfu* pbuf = (bfu*)smem + wv * 640;
  bf16x8 q[2];
#pragma unroll
  for (int ks = 0; ks < 2; ++ks) q[ks] = ld8(COLS + (size_t)(t0 + (lr >> 2)) * NIN + C_Q + (lr & 3) * 64 + ks * 32 + lq * 8);
  const int pos = tp0 + lq;
  const bfu* rowb = COLS + (size_t)b * S * NIN;
  AttnState sw; attn_init(sw);
  KVF cur, nxt;
  {
    const bfu* VT = (const bfu*)(p.ws + O_VWT) + (size_t)b * 64 * S;
    int kb = tp0 - 511; if (kb < 0) kb = 0; kb &= ~31;
    const int last = tp0 + 3;
    attn_load(cur, rowb + (size_t)(kb + lr) * NIN + C_KW + lq * 8, rowb + (size_t)(kb + 16 + lr) * NIN + C_KW + lq * 8, VT + (size_t)lr * S + kb + lq * 8, (size_t)16 * S);
    for (; kb <= last; kb += 32) {
      const bool more = kb + 32 <= last;
      const int kn = kb + 32;
      if (more) attn_load(nxt, rowb + (size_t)(kn + lr) * NIN + C_KW + lq * 8, rowb + (size_t)(kn + 16 + lr) * NIN + C_KW + lq * 8, VT + (size_t)lr * S + kn + lq * 8, (size_t)16 * S);
      const int d0 = pos - (kb + lr), d1 = d0 - 16;
      attn_compute(sw, q, cur, (float)d0, d0 >= 0 && d0 < 512, (float)d1, d1 >= 0 && d1 < 512, pbuf, lr, lq);
      if (more) cur = nxt;
    }
  }
  AttnState ss; attn_init(ss);
  {
    const bfu* VT = (const bfu*)(p.ws + O_VST) + (size_t)b * 64 * S;
    const unsigned long long* SEL = (const unsigned long long*)(p.ws + O_SEL);
    const unsigned long long mylo = SEL[(size_t)(t0 + lq) * 2], myhi = SEL[(size_t)(t0 + lq) * 2 + 1];
    unsigned long long ulo = 0, uhi = 0;
#pragma unroll
    for (int k = 0; k < 4; ++k) { ulo |= SEL[(size_t)(t0 + k) * 2]; uhi |= SEL[(size_t)(t0 + k) * 2 + 1]; }
    unsigned ul0 = __builtin_amdgcn_readfirstlane((unsigned)ulo), ul1 = __builtin_amdgcn_readfirstlane((unsigned)(ulo >> 32));
    unsigned uh0 = __builtin_amdgcn_readfirstlane((unsigned)uhi), uh1 = __builtin_amdgcn_readfirstlane((unsigned)(uhi >> 32));
    int j = -1, hb = 1;
    auto adv = [&]() -> bool {
      if (hb == 0) { hb = 1; return true; }
      hb = 0;
      if (ul0) { j = __builtin_ctz(ul0); ul0 &= ul0 - 1; return true; }
      if (ul1) { j = 32 + __builtin_ctz(ul1); ul1 &= ul1 - 1; return true; }
      if (uh0) { j = 64 + __builtin_ctz(uh0); uh0 &= uh0 - 1; return true; }
      if (uh1) { j = 96 + __builtin_ctz(uh1); uh1 &= uh1 - 1; return true; }
      return false;
    };
    bool ok = adv();
    if (ok) { const int kb = j * 64 + hb * 32; attn_load(cur, rowb + (size_t)(kb + lr) * NIN + C_KS + lq * 8, rowb + (size_t)(kb + 16 + lr) * NIN + C_KS + lq * 8, VT + (size_t)lr * S + kb + lq * 8, (size_t)16 * S); }
    while (ok) {
      const int cj = j, kb = j * 64 + hb * 32;
      const bool nk = adv();
      if (nk) { const int kn = j * 64 + hb * 32; attn_load(nxt, rowb + (size_t)(kn + lr) * NIN + C_KS + lq * 8, rowb + (size_t)(kn + 16 + lr) * NIN + C_KS + lq * 8, VT + (size_t)lr * S + kn + lq * 8, (size_t)16 * S); }
      const bool has = (((cj < 64) ? (mylo >> cj) : (myhi >> (cj - 64))) & 1ull) != 0;
      const int d0 = pos - (kb + lr), d1 = d0 - 16;
      attn_compute(ss, q, cur, (float)d0, has && d0 >= 0, (float)d1, has && d1 >= 0, pbuf, lr, lq);
      if (nk) cur = nxt;
      ok = nk;
    }
  }
  const bfu* OC = (const bfu*)(p.ws + O_OCMP);
  bfu* MIX = (bfu*)(p.ws + O_ACT);
  const int t = t0 + lq;
#pragma unroll
  for (int r = 0; r < 4; ++r) {
    const float g0 = sigmoidf_(SIDE[(size_t)t * 16 + 4 + r * 3]), g1 = sigmoidf_(SIDE[(size_t)t * 16 + 5 + r * 3]), g2 = sigmoidf_(SIDE[(size_t)t * 16 + 6 + r * 3]);
    const float is = g1 / fmaxf(ss.l[r], 1e-30f), iw = g2 / fmaxf(sw.l[r], 1e-30f);
#pragma unroll
    for (int dt = 0; dt < 4; ++dt) {
      const int ch = r * 64 + dt * 16 + lr;
      float o = g0 * bf2f(OC[(size_t)t * 256 + ch]) + is * ss.O[dt][r] + iw * sw.O[dt][r];
      MIX[(size_t)t * 1024 + 768 + ch] = f2bf(o);
    }
  }
}

DEV void phase_rwkv_prep(const Params& p, int l) {
  for (int it = bid_(); it < 512; it += gridDim.x) rwkv_prep_item(p, l, it);
}
DEV void sub_arrive(unsigned* bar) {
  asm volatile("s_waitcnt vmcnt(0)" ::: "memory");
  __syncthreads();
  if (tid_() == 0) { __threadfence(); atomicAdd(bar, 1u); }
}
DEV void sub_wait(unsigned* bar, unsigned target) {
  if (tid_() == 0) { while (__hip_atomic_load(bar, __ATOMIC_RELAXED, __HIP_MEMORY_SCOPE_AGENT) < target) __builtin_amdgcn_s_sleep(2); __threadfence(); }
  __syncthreads();
}
DEV void phase_mix_scan_finish(const Params& p, int l) {
  unsigned* barA = (unsigned*)(p.ws + O_SYNC) + l * 4;
  unsigned* barB = barA + 1;
  unsigned* que = barA + 2;
  const unsigned nothers = gridDim.x - 64;
  if (bid_() < 64) {
    __builtin_amdgcn_s_setprio(3);
    for (int rep = 0; rep < R_SCAN; ++rep) rwkv_scan_item(p, bid_());
    __builtin_amdgcn_s_setprio(0);
  } else {
    constexpr int P0 = 1024, P1 = P0 + 2048, P2 = P1 + 1024, P3 = P2 + 256;
    for (int it = bid_() - 64; it < P3; it += gridDim.x - 64) {
      if (it < P0) ssd_item<0>(p, l, it);
      else if (it < P1) lru_item<0>(p, l, it - P0);
      else if (it < P2) nsa_tr_item(p, it - P1);
      else nsa_cmp_item(p, l, it - P2);
    }
    sub_arrive(barA);
    sub_wait(barA, nothers);
    constexpr int N0 = 2048, N1 = N0 + 256, N2 = N1 + 4;
    for (int it = bid_() - 64; it < N2; it += gridDim.x - 64) {
      if (it < N0) { for (int rep = 0; rep < R_CMPA; ++rep) { __syncthreads(); nsa_cmpattn_item(p, it); } }
      else if (it < N1) ssd_rec_item(p, it - N0);
      else lru_carry_item(p, it - N1);
    }
    sub_arrive(barB);
  }
  sub_wait(barB, nothers);
  constexpr int M0 = 2048, M1 = M0 + 1024, M2 = M1 + 2048;
  for (;;) {
    __syncthreads();
    if (tid_() == 0) s_qitem = (int)atomicAdd(que, 1u);
    __syncthreads();
    const int it = s_qitem;
    if (it >= M2) break;
    for (int rep = 0; rep < R_FIN; ++rep) {
    if (it < M0) { __syncthreads(); nsa_finish_item(p, it); }
    else if (it < M1) ssd_item<1>(p, l, it - M0);
    else lru_item<1>(p, l, it - M1);
    }
  }
}
DEV void phase_rwkv_post(const Params& p, int l) {
  for (int it = bid_(); it < 512; it += gridDim.x) rwkv_post_item(p, l, it);
}

template <int CTRL> DEV int dppi_(int v) { return __builtin_amdgcn_update_dpp(0, v, CTRL, 0xf, 0xf, true); }
DEV int row16_mini(int v) { v = min(v, dppi_<0xB1>(v)); v = min(v, dppi_<0x4E>(v)); v = min(v, dppi_<0x141>(v)); v = min(v, dppi_<0x140>(v)); return v; }
DEV void phase_peer_topk(const Params& p, int l) {
  const bfu* Q = (const bfu*)(p.ws + O_PQ);
  const bfu* keys = (const bfu*)(p.ws + O_W + (size_t)l * W_SZ + W_KEYS);
  int* PE = (int*)(p.ws + O_PE); float* PG = (float*)(p.ws + O_PG);
  const int lane = tid_() & 63, wv = tid_() >> 6, lr = lane & 15, lq = lane >> 4;
  float* ps = (float*)smem + wv * 1024;
  int* pi = (int*)ps + 512;
  const float NINF = -__builtin_inff();
  int ca[4], cb[4]; bool cok[4];
#pragma unroll
  for (int sl = 0; sl < 4; ++sl) {
    int k = sl * 16 + lr, a = 0; bool ok = false;
    for (int aa = 0; aa < 16; ++aa) { int cnt = 16 / (aa + 1); if (!ok) { if (k < cnt) { ok = true; a = aa; } else k -= cnt; } }
    ca[sl] = a; cb[sl] = ok ? k : 0; cok[sl] = ok;
  }
  for (int item = bid_(); item < (T / 64) * 8; item += gridDim.x) {
    const int tt = item >> 3, hd = item & 7;
    const int t0 = tt * 64 + wv * 16;
    for (int c = 0; c < 2; ++c) {
      bf16x8 qa[4];
#pragma unroll
      for (int ks = 0; ks < 4; ++ks) qa[ks] = ld8(Q + (size_t)(t0 + lr) * 2048 + hd * 256 + c * 128 + ks * 32 + lq * 8);
      const bfu* kb = keys + (size_t)(hd * 2 + c) * 128 * 128;
      float v[4][8];
#pragma unroll
      for (int nt = 0; nt < 8; ++nt) {
        f32x4 a = {0.f, 0.f, 0.f, 0.f};
#pragma unroll
        for (int ks = 0; ks < 4; ++ks) a = mfma16(qa[ks], ld8(kb + (size_t)(nt * 16 + lr) * 128 + ks * 32 + lq * 8), a);
#pragma unroll
        for (int r = 0; r < 4; ++r) v[r][nt] = a[r];
      }
      float mys[4] = {0.f, 0.f, 0.f, 0.f}; int myi[4] = {0, 0, 0, 0};
      for (int rd = 0; rd < 16; ++rd) {
#pragma unroll
        for (int r = 0; r < 4; ++r) {
          float lm = fmaxf(fmaxf(fmaxf(v[r][0], v[r][1]), fmaxf(v[r][2], v[r][3])), fmaxf(fmaxf(v[r][4], v[r][5]), fmaxf(v[r][6], v[r][7])));
          const float gm = row16_max(lm);
          int cand = 0x7fffffff;
#pragma unroll
          for (int nt = 7; nt >= 0; --nt) cand = (v[r][nt] == gm) ? nt * 16 + lr : cand;
          const int bi = row16_mini(cand);
#pragma unroll
          for (int nt = 0; nt < 8; ++nt) v[r][nt] = (bi == nt * 16 + lr) ? NINF : v[r][nt];
          if (lr == rd) { mys[r] = gm; myi[r] = bi; }
        }
      }
#pragma unroll
      for (int r = 0; r < 4; ++r) { ps[c * 256 + (lq * 4 + r) * 16 + lr] = mys[r]; pi[c * 256 + (lq * 4 + r) * 16 + lr] = myi[r]; }
    }
    float cv[4][4];
#pragma unroll
    for (int r = 0; r < 4; ++r)
#pragma unroll
      for (int sl = 0; sl < 4; ++sl) {
        float sv = ps[(lq * 4 + r) * 16 + ca[sl]] + ps[256 + (lq * 4 + r) * 16 + cb[sl]];
        cv[r][sl] = cok[sl] ? sv : NINF;
      }
    float tops[4] = {0.f, 0.f, 0.f, 0.f}; int topf[4] = {0, 0, 0, 0};
    for (int rd = 0; rd < 16; ++rd) {
#pragma unroll
      for (int r = 0; r < 4; ++r) {
        const float gm = row16_max(fmaxf(fmaxf(cv[r][0], cv[r][1]), fmaxf(cv[r][2], cv[r][3])));
        int cand = 0x7fffffff;
#pragma unroll
        for (int sl = 0; sl < 4; ++sl) { int fl = ca[sl] * 16 + cb[sl]; cand = (cv[r][sl] == gm && fl < cand) ? fl : cand; }
        const int bi = row16_mini(cand);
#pragma unroll
        for (int sl = 0; sl < 4; ++sl) cv[r][sl] = (bi == ca[sl] * 16 + cb[sl]) ? NINF : cv[r][sl];
        if (lr == rd) { tops[r] = gm; topf[r] = bi; }
      }
    }
#pragma unroll
    for (int r = 0; r < 4; ++r) {
      const int row = lq * 4 + r;
      const float mx = row16_max(tops[r]);
      const float e = __expf(tops[r] - mx);
      const float den = row16_sum(e);
      const int a = topf[r] >> 4, bb = topf[r] & 15;
      const size_t o = (size_t)(t0 + row) * 128 + hd * 16 + lr;
      PE[o] = pi[row * 16 + a] * 128 + pi[256 + row * 16 + bb];
      PG[o] = e / den;
    }
  }
}

typedef float f32x2 __attribute__((ext_vector_type(2)));
DEV float wave_total(float v) {
  v = row16_sum(v);
  v += __int_as_float(__builtin_amdgcn_update_dpp(0, __float_as_int(v), 0x142, 0xA, 0xF, false));
  v += __int_as_float(__builtin_amdgcn_update_dpp(0, __float_as_int(v), 0x143, 0xC, 0xF, false));
  return __int_as_float(__builtin_amdgcn_readlane(__float_as_int(v), 63));
}
DEV float dot_fp8(uint4 u, const f32x2* x) {
  f32x2 acc = __builtin_amdgcn_cvt_pk_f32_fp8((int)u.x, false) * x[0];
  acc = __builtin_amdgcn_cvt_pk_f32_fp8((int)u.x, true) * x[1] + acc;
  acc = __builtin_amdgcn_cvt_pk_f32_fp8((int)u.y, false) * x[2] + acc;
  acc = __builtin_amdgcn_cvt_pk_f32_fp8((int)u.y, true) * x[3] + acc;
  acc = __builtin_amdgcn_cvt_pk_f32_fp8((int)u.z, false) * x[4] + acc;
  acc = __builtin_amdgcn_cvt_pk_f32_fp8((int)u.z, true) * x[5] + acc;
  acc = __builtin_amdgcn_cvt_pk_f32_fp8((int)u.w, false) * x[6] + acc;
  acc = __builtin_amdgcn_cvt_pk_f32_fp8((int)u.w, true) * x[7] + acc;
  return acc.x + acc.y;
}
DEV void axpy_fp8(uint4 v, float c, f32x2* y) {
  f32x2 cc = {c, c};
  y[0] = __builtin_amdgcn_cvt_pk_f32_fp8((int)v.x, false) * cc + y[0];
  y[1] = __builtin_amdgcn_cvt_pk_f32_fp8((int)v.x, true) * cc + y[1];
  y[2] = __builtin_amdgcn_cvt_pk_f32_fp8((int)v.y, false) * cc + y[2];
  y[3] = __builtin_amdgcn_cvt_pk_f32_fp8((int)v.y, true) * cc + y[3];
  y[4] = __builtin_amdgcn_cvt_pk_f32_fp8((int)v.z, false) * cc + y[4];
  y[5] = __builtin_amdgcn_cvt_pk_f32_fp8((int)v.z, true) * cc + y[5];
  y[6] = __builtin_amdgcn_cvt_pk_f32_fp8((int)v.w, false) * cc + y[6];
  y[7] = __builtin_amdgcn_cvt_pk_f32_fp8((int)v.w, true) * cc + y[7];
}
struct PBatch { uint4 u[4], v[4]; };
DEV void peer_load(PBatch& pb, const unsigned char* PU, const unsigned char* PV, int me0, int me1, int e, int lane) {
#pragma unroll
  for (int k = 0; k < 4; ++k) {
    int ee = e + k;
    int idx = __builtin_amdgcn_readlane((ee < 64) ? me0 : me1, ee & 63);
    pb.u[k] = *(const uint4*)(PU + (size_t)idx * 2048 + lane * 16);
    pb.v[k] = *(const uint4*)(PU + (size_t)idx * 2048 + 1024 + lane * 16);
  }
}
DEV void peer_compute(const PBatch& pb, const f32x2* x, f32x2* y, float mg0, float mg1, int e) {
  float d[4];
#pragma unroll
  for (int k = 0; k < 4; ++k) d[k] = dot_fp8(pb.u[k], x);
#pragma unroll
  for (int k = 0; k < 4; ++k) {
    int ee = e + k;
    float g = __int_as_float(__builtin_amdgcn_readlane(__float_as_int((ee < 64) ? mg0 : mg1), ee & 63));
    float act = wave_total(d[k]) * (1.f / PU_SCALE);
    axpy_fp8(pb.v[k], g * geluf_(act), y);
  }
}
DEV void phase_peer_gather(const Params& p, const float* gnext, bool last) {
  const bfu* XN = (const bfu*)(p.ws + O_ACT);
  const unsigned char* PU = p.ws + O_PU; const unsigned char* PV = p.ws + O_PV;
  const int* PE = (const int*)(p.ws + O_PE); const float* PG = (const float*)(p.ws + O_PG);
  const int lane = tid_() & 63, wv = tid_() >> 6;
  for (int t = bid_() * 4 + wv; t < T; t += gridDim.x * 4) {
    f32x2 x[8], y[8];
    {
      uint4 a = *(const uint4*)(XN + (size_t)t * D + lane * 16);
      uint4 b = *(const uint4*)(XN + (size_t)t * D + lane * 16 + 8);
      x[0] = (f32x2){lo2f(a.x), hi2f(a.x)}; x[1] = (f32x2){lo2f(a.y), hi2f(a.y)}; x[2] = (f32x2){lo2f(a.z), hi2f(a.z)}; x[3] = (f32x2){lo2f(a.w), hi2f(a.w)};
      x[4] = (f32x2){lo2f(b.x), hi2f(b.x)}; x[5] = (f32x2){lo2f(b.y), hi2f(b.y)}; x[6] = (f32x2){lo2f(b.z), hi2f(b.z)}; x[7] = (f32x2){lo2f(b.w), hi2f(b.w)};
    }
#pragma unroll
    for (int i = 0; i < 8; ++i) y[i] = (f32x2){0.f, 0.f};
    const int me0 = PE[(size_t)t * 128 + lane], me1 = PE[(size_t)t * 128 + 64 + lane];
    const float mg0 = PG[(size_t)t * 128 + lane], mg1 = PG[(size_t)t * 128 + 64 + lane];
    PBatch A, B;
    for (int rep = 0; rep < R_GATH; ++rep) {
#pragma unroll
    for (int i = 0; i < 8; ++i) y[i] = (f32x2){0.f, 0.f};
    peer_load(A, PU, PV, me0, me1, 0, lane);
    for (int e = 0; e < 128; e += 8) {
      peer_load(B, PU, PV, me0, me1, e + 4, lane);
      peer_compute(A, x, y, mg0, mg1, e);
      if (e + 8 < 128) peer_load(A, PU, PV, me0, me1, e + 8, lane);
      peer_compute(B, x, y, mg0, mg1, e + 4);
    }
    }
    float* hp = p.out + (size_t)t * D + lane * 16;
    float4 h0 = *(const float4*)(hp), h1 = *(const float4*)(hp + 4), h2 = *(const float4*)(hp + 8), h3 = *(const float4*)(hp + 12);
    float hv[16] = {h0.x, h0.y, h0.z, h0.w, h1.x, h1.y, h1.z, h1.w, h2.x, h2.y, h2.z, h2.w, h3.x, h3.y, h3.z, h3.w};
    float ss = 0.f;
#pragma unroll
    for (int i = 0; i < 8; ++i) {
      hv[i * 2] += y[i].x * (1.f / PV_SCALE); hv[i * 2 + 1] += y[i].y * (1.f / PV_SCALE);
      ss += hv[i * 2] * hv[i * 2] + hv[i * 2 + 1] * hv[i * 2 + 1];
    }
    ss = wave_total(ss);
    const float scl = rsqrtf(ss * (1.f / D) + 1e-6f);
    float gv[16];
    {
      const float* gp = gnext + lane * 16;
      float4 g0 = *(const float4*)(gp), g1 = *(const float4*)(gp + 4), g2 = *(const float4*)(gp + 8), g3 = *(const float4*)(gp + 12);
      float gt[16] = {g0.x, g0.y, g0.z, g0.w, g1.x, g1.y, g1.z, g1.w, g2.x, g2.y, g2.z, g2.w, g3.x, g3.y, g3.z, g3.w};
#pragma unroll
      for (int i = 0; i < 16; ++i) gv[i] = hv[i] * scl * gt[i];
    }
    if (last) {
      *(float4*)(hp) = make_float4(gv[0], gv[1], gv[2], gv[3]); *(float4*)(hp + 4) = make_float4(gv[4], gv[5], gv[6], gv[7]);
      *(float4*)(hp + 8) = make_float4(gv[8], gv[9], gv[10], gv[11]); *(float4*)(hp + 12) = make_float4(gv[12], gv[13], gv[14], gv[15]);
    } else {
      *(float4*)(hp) = make_float4(hv[0], hv[1], hv[2], hv[3]); *(float4*)(hp + 4) = make_float4(hv[4], hv[5], hv[6], hv[7]);
      *(float4*)(hp + 8) = make_float4(hv[8], hv[9], hv[10], hv[11]); *(float4*)(hp + 12) = make_float4(hv[12], hv[13], hv[14], hv[15]);
      bfu* up = (bfu*)(p.ws + O_ACT) + (size_t)t * D + lane * 16;
      *(uint4*)(up) = make_uint4(pack2(gv[0], gv[1]), pack2(gv[2], gv[3]), pack2(gv[4], gv[5]), pack2(gv[6], gv[7]));
      *(uint4*)(up + 8) = make_uint4(pack2(gv[8], gv[9]), pack2(gv[10], gv[11]), pack2(gv[12], gv[13]), pack2(gv[14], gv[15]));
    }
  }
}

#include <cstdint>
#define XB_TMO      128
#define XB_XCNT(j)  (256  + 64 * (j))
#define XB_XSUB(j)  (1280 + 64 * (j))
#define XB_XGEN(j)  (2304 + 64 * (j))
#define XB_TOP      3328
#define XB_TOPGEN   3392
#define XCD_BAR_WORDS 3456
#define XB_SPIN_CAP (1u << 18)
#define LAS __attribute__((address_space(3)))

__device__ __forceinline__ unsigned xb_ld(unsigned* p)              { return __hip_atomic_load(p, __ATOMIC_RELAXED, __HIP_MEMORY_SCOPE_AGENT); }
__device__ __forceinline__ unsigned xb_add(unsigned* p, unsigned v) { return __hip_atomic_fetch_add(p, v, __ATOMIC_RELAXED, __HIP_MEMORY_SCOPE_AGENT); }
__device__ __forceinline__ unsigned xb_xcc_id() { return (unsigned)__builtin_amdgcn_s_getreg((3 << 11) | 20) & 0xFu; }
#define XB_SPIN(cond, bar) do { unsigned _sp = 0; while (cond) { __builtin_amdgcn_s_sleep(1); \
    if ((++_sp & 255u) == 0u) { if (xb_ld(&(bar)[XB_TMO])) break; if (_sp > XB_SPIN_CAP) { atomicAdd(&(bar)[XB_TMO], 1u); break; } } } } while (0)

struct XcdBarrier {
    unsigned* bar; unsigned x;
    volatile LAS unsigned* st;
};

__device__ __forceinline__ XcdBarrier xcd_barrier_post(unsigned* bar, volatile LAS unsigned* st) {
    XcdBarrier b; b.bar = bar; b.x = xb_xcc_id(); b.st = st;
    if (threadIdx.x == 0) (void)xb_add(&bar[XB_XCNT(b.x)], 1u);
    return b;
}
__device__ __forceinline__ void xcd_barrier_complete(unsigned* bar, unsigned x, unsigned& nloc, unsigned& nx) {
    const unsigned G = gridDim.x * gridDim.y * gridDim.z;
    unsigned sum, cnt, mine, sp = 0u;
    for (;;) {
        sum = 0u; cnt = 0u; mine = 0u;
#pragma unroll
        for (unsigned j = 0; j < 16; ++j) { const unsigned c = xb_ld(&bar[XB_XCNT(j)]); sum += c; cnt += (c > 0u) ? 1u : 0u; mine = (j == x) ? c : mine; }
        if (sum == G) break;
        __builtin_amdgcn_s_sleep(1);
        if ((++sp & 255u) == 0u) { if (xb_ld(&bar[XB_TMO])) break; if (sp > XB_SPIN_CAP) { atomicAdd(&bar[XB_TMO], 1u); break; } }
    }
    nloc = mine > 0u ? mine : 1u; nx = cnt > 0u ? cnt : 1u;
}

__device__ __forceinline__ void xcd_barrier(const XcdBarrier& b) {
    asm volatile("s_waitcnt vmcnt(0)" ::: "memory");
    __syncthreads();
    if (threadIdx.x == 0) {
        unsigned* bar = b.bar;
        __builtin_amdgcn_s_waitcnt(0);
        unsigned nloc = b.st[0], nx = b.st[1];
        if (nloc == 0u) { xcd_barrier_complete(bar, b.x, nloc, nx); b.st[0] = nloc; b.st[1] = nx; }
        const unsigned old = xb_add(&bar[XB_XSUB(b.x)], 1u);
        const unsigned gen = old / nloc;
        if (old + 1u == (gen + 1u) * nloc) {
            __builtin_amdgcn_fence(__ATOMIC_RELEASE, "agent");
            asm volatile("s_waitcnt vmcnt(0)" ::: "memory");
            const unsigned og = xb_add(&bar[XB_TOP], 1u);
            const unsigned tg = og / nx;
            if (og + 1u == (tg + 1u) * nx) xb_add(&bar[XB_TOPGEN], 1u);
            else XB_SPIN(xb_ld(&bar[XB_TOPGEN]) == tg, bar);
            __builtin_amdgcn_fence(__ATOMIC_ACQUIRE, "agent");
            xb_add(&bar[XB_XGEN(b.x)], 1u);
            asm volatile("s_waitcnt vmcnt(0)" ::: "memory");
        } else {
            XB_SPIN(xb_ld(&bar[XB_XGEN(b.x)]) == gen, bar);
            __builtin_amdgcn_fence(__ATOMIC_ACQUIRE, "agent");
            asm volatile("s_waitcnt vmcnt(0)" ::: "memory");
        }
    }
    __syncthreads();
}

__shared__ uint4 xb_words;
DEV void seam_barrier(unsigned char* ws) {
  XcdBarrier b; b.bar = (unsigned*)(ws + O_XB); b.x = xb_xcc_id(); b.st = (volatile LAS unsigned*)&xb_words;
  xcd_barrier(b);
}

DEV void launder_all(Params& q) {
  const float** pp = (const float**)&q;
#pragma unroll
  for (int i = 0; i < 39; ++i) { const float* t = pp[i]; asm volatile("" : "+s"(t)); pp[i] = t; }
}
__global__ void __launch_bounds__(NTHR, 2) fwd_megakernel(Params p0) {
  cg::grid_group grid = cg::this_grid();
  int ph = 0;
  if (threadIdx.x == 0) xb_words = make_uint4(0u, 0u, 0u, 0u);
  __syncthreads();
#define PHASE(body) { if (ph >= p0.ph_lo && ph < p0.ph_hi) { Params q_ = p0; launder_all(q_); { const Params& p = q_; body; } \
    if (ph + 1 < p0.ph_hi) { if (ph == 0) { grid.sync(); (void)xcd_barrier_post((unsigned*)(q_.ws + O_XB), (volatile LAS unsigned*)&xb_words); } else seam_barrier(q_.ws); } } ++ph; }
  PHASE(phase_convert(p); phase_norm(p.x, p.mix_norm, (bfu*)(p.ws + O_ACT)))
  for (int l = 0; l < DEPTH; ++l) {
#define wb (p.ws + O_W + (size_t)l * W_SZ)
    PHASE(for (int rep = 0; rep < R_GEMM; ++rep) gemm_phase<0>((const bfu*)(p.ws + O_ACT), (const bfu*)(wb + W_IN), NIN, 1024, (bfu*)(p.ws + O_COLS), NIN, (float*)(p.ws + O_SIDE), nullptr, nullptr))
    PHASE(for (int rep = 0; rep < R_PREP; ++rep) phase_rwkv_prep(p, l))
    PHASE(phase_mix_scan_finish(p, l))
    PHASE(phase_rwkv_post(p, l))
    PHASE(gemm_phase<1>((const bfu*)(p.ws + O_ACT), (const bfu*)(wb + W_OUT), 1024, 1024, nullptr, 0, nullptr, l == 0 ? p.x : p.out, p.out); convert_peer_uv(p, l))
    PHASE(phase_norm(p.out, p.ffn_norm + (size_t)l * D, (bfu*)(p.ws + O_ACT)))
    PHASE(for (int rep = 0; rep < R_GEMM; ++rep) gemm_phase<2>((const bfu*)(p.ws + O_ACT), (const bfu*)(wb + W_Q), 2048, 1024, (bfu*)(p.ws + O_PQ), 2048, nullptr, nullptr, nullptr))
    PHASE(for (int rep = 0; rep < R_TOPK; ++rep) phase_peer_topk(p, l))
    PHASE(phase_peer_gather(p, l + 1 < DEPTH ? p.mix_norm + (size_t)(l + 1) * D : p.final_norm, l + 1 == DEPTH))
  }
}

extern "C" void kernel_launch(void* const* d_in, const int* in_sizes, int n_in, void* d_out, int out_size, void* d_ws, size_t ws_size,
                              hipStream_t stream) {
  static int grid_blocks = 0;
  if (!grid_blocks) {
    int dev = 0, cus = 0, per_cu = 0;
    hipGetDevice(&dev);
    hipDeviceGetAttribute(&cus, hipDeviceAttributeMultiprocessorCount, dev);
    hipOccupancyMaxActiveBlocksPerMultiprocessor(&per_cu, fwd_megakernel, NTHR, 0);
    if (per_cu > 2) per_cu = 2;
    grid_blocks = cus * per_cu;
  }
  Params p{};
  const float** pp = (const float**)&p;
  for (int i = 0; i < 37; ++i) pp[i] = (const float*)d_in[i];
  p.out = (float*)d_out; p.ws = (unsigned char*)d_ws; p.ph_lo = 0; p.ph_hi = 1000;
  void* args[] = {&p};
  hipError_t e = hipLaunchCooperativeKernel((void*)fwd_megakernel, dim3(grid_blocks), dim3(NTHR), args, 0, stream);
  if (e != hipSuccess) fprintf(stderr, "cooperative launch failed: %s (grid %d)\n", hipGetErrorString(e), grid_blocks);
}
```

```cpp
#include <hip/hip_runtime.h>
#include <hip/hip_bf16.h>
#include <hip/hip_cooperative_groups.h>
#include <cstdio>
namespace cg = cooperative_groups;

typedef unsigned short bfu;
using bf16x8 = __attribute__((ext_vector_type(8))) short;
using f32x4 = __attribute__((ext_vector_type(4))) float;

#define DEV __device__ __forceinline__

constexpr int Bsz = 4, S = 8192, T = Bsz * S, D = 1024, NIN = 2960, DEPTH = 2;
constexpr int C_SSM = 0, C_LRU = 772, C_RWKV = 1284, C_NSA = 2308;
constexpr int C_Z = 0, C_XBC = 256, C_DT = 768;
constexpr int C_LG = 772, C_LX = 1028;
constexpr int C_Q = 2308, C_KC = 2564, C_VC = 2628, C_KS = 2692, C_VS = 2756, C_KW = 2820, C_VW = 2884, C_GT = 2948;
constexpr int NCH = 128;
constexpr int NTHR = 256;
#ifndef R_GEMM
#define R_GEMM 1
#endif
#ifndef R_PREP
#define R_PREP 1
#endif
#ifndef R_SCAN
#define R_SCAN 1
#endif
#ifndef R_FIN
#define R_FIN 1
#endif
#ifndef R_TOPK
#define R_TOPK 1
#endif
#ifndef R_GATH
#define R_GATH 1
#endif
#ifndef R_CMPA
#define R_CMPA 1
#endif

constexpr size_t AL(size_t x) { return (x + 255) & ~(size_t)255; }
constexpr size_t O_ACT = 0;
constexpr size_t O_COLS = O_ACT + AL((size_t)T * 1024 * 2);
constexpr size_t O_SIDE = O_COLS + AL((size_t)T * NIN * 2);
constexpr size_t O_RIN = O_SIDE + AL((size_t)T * 16 * 4);
constexpr size_t O_RY = O_RIN + AL((size_t)16 * S * 896);
constexpr size_t O_RG = O_RY + AL((size_t)T * 256 * 4);
constexpr size_t O_SST = O_RG + AL((size_t)T * 256 * 2);
constexpr size_t O_SAT = O_SST + AL((size_t)16 * NCH * 4096 * 4);
constexpr size_t O_LA = O_SAT + AL((size_t)16 * NCH * 4);
constexpr size_t O_LH = O_LA + AL((size_t)4 * NCH * 256 * 4);
constexpr size_t O_KCMP = O_LH + AL((size_t)4 * NCH * 256 * 4);
constexpr size_t O_VCT = O_KCMP + AL((size_t)4 * 512 * 64 * 2);
constexpr size_t O_VWT = O_VCT + AL((size_t)4 * 512 * 64 * 2);
constexpr size_t O_VST = O_VWT + AL((size_t)4 * 64 * S * 2);
constexpr size_t O_OCMP = O_VST + AL((size_t)4 * 64 * S * 2);
constexpr size_t O_SEL = O_OCMP + AL((size_t)T * 256 * 2);
constexpr size_t O_SYNC = O_SEL + AL((size_t)T * 16);
constexpr size_t O_XB = O_SYNC + 256;
constexpr size_t O_W = O_XB + 16384;
constexpr size_t W_IN = 0;
constexpr size_t W_OUT = W_IN + AL((size_t)NIN * 1024 * 2);
constexpr size_t W_Q = W_OUT + AL((size_t)1024 * 1024 * 2);
constexpr size_t W_KEYS = W_Q + AL((size_t)2048 * 1024 * 2);
constexpr size_t W_C1 = W_KEYS + AL((size_t)16 * 128 * 128 * 2);
constexpr size_t W_C2 = W_C1 + AL((size_t)2 * 256 * 2048 * 2);
constexpr size_t W_LA = W_C2 + AL((size_t)2 * 64 * 256 * 2);
constexpr size_t W_LI = W_LA + AL((size_t)4 * 64 * 64 * 2);
constexpr size_t W_R2 = W_LI + AL((size_t)4 * 64 * 64 * 2);
constexpr size_t W_A2 = W_R2 + AL((size_t)256 * 64 * 2);
constexpr size_t W_G2 = W_A2 + AL((size_t)256 * 64 * 2);
constexpr size_t W_SZ = W_G2 + AL((size_t)256 * 128 * 2);
constexpr size_t O_END = O_W + 2 * W_SZ;
constexpr size_t O_PU = O_COLS;
constexpr size_t O_PV = O_PU + AL((size_t)16384 * 1024);
constexpr size_t O_PQ = O_PV + AL((size_t)16384 * 1024);
constexpr size_t O_PE = O_PQ + AL((size_t)T * 2048 * 2);
constexpr size_t O_PG = O_PE + AL((size_t)T * 128 * 4);
constexpr size_t O_PEND = O_PG + AL((size_t)T * 128 * 4);
static_assert(O_PEND <= O_RY, "peer scratch overlaps live buffers");
static_assert(O_END <= (size_t)536870912, "workspace too large");

struct Params {
  const float* x; const float* mix_norm; const float* w_in; const float* w_out;
  const float* ssm_conv_w; const float* ssm_conv_b; const float* ssm_dt_bias; const float* ssm_a_log; const float* ssm_d; const float* ssm_norm;
  const float* lru_conv_w; const float* lru_conv_b; const float* lru_wa; const float* lru_ba; const float* lru_wi; const float* lru_bi; const float* lru_lambda;
  const float* rwkv_mu; const float* rwkv_w0; const float* rwkv_w2; const float* rwkv_a0; const float* rwkv_a2; const float* rwkv_g2;
  const float* rwkv_kk; const float* rwkv_ka; const float* rwkv_rk; const float* rwkv_ln_w; const float* rwkv_ln_b;
  const float* nsa_cmp_pos; const float* nsa_cmp_w1; const float* nsa_cmp_w2;
  const float* ffn_norm; const float* peer_wq; const float* peer_keys; const float* peer_u; const float* peer_v; const float* final_norm;
  float* out; unsigned char* ws;
  int ph_lo, ph_hi;
};

DEV int tid_() { int t = threadIdx.x; asm volatile("" : "+v"(t)); return t; }
DEV int bid_() { int b = blockIdx.x; asm volatile("" : "+s"(b)); return b; }
DEV bfu f2bf(float f) { unsigned u = __float_as_uint(f); u += 0x7fffu + ((u >> 16) & 1u); return (bfu)(u >> 16); }
DEV float bf2f(bfu b) { return __uint_as_float(((unsigned)b) << 16); }
DEV unsigned pack2(float a, float b) { return (unsigned)f2bf(a) | ((unsigned)f2bf(b) << 16); }
DEV float lo2f(unsigned u) { return __uint_as_float(u << 16); }
DEV float hi2f(unsigned u) { return __uint_as_float(u & 0xffff0000u); }
DEV float sigmoidf_(float x) { return 1.f / (1.f + __expf(-x)); }
DEV float siluf_(float x) { return x / (1.f + __expf(-x)); }
DEV float softplusf_(float x) { return fmaxf(x, 0.f) + log1pf(__expf(-fabsf(x))); }
DEV float geluf_(float x) { float u = 0.7978845608028654f * (x + 0.044715f * x * x * x); return 0.5f * x * (1.f + tanhf(u)); }

template <int CTRL> DEV float dppf(float v) {
  return __int_as_float(__builtin_amdgcn_update_dpp(0, __float_as_int(v), CTRL, 0xf, 0xf, true));
}
DEV float row16_sum(float v) { v += dppf<0xB1>(v); v += dppf<0x4E>(v); v += dppf<0x141>(v); v += dppf<0x140>(v); return v; }
DEV float row16_max(float v) { v = fmaxf(v, dppf<0xB1>(v)); v = fmaxf(v, dppf<0x4E>(v)); v = fmaxf(v, dppf<0x141>(v)); v = fmaxf(v, dppf<0x140>(v)); return v; }
DEV float wave_sum(float v) { v = row16_sum(v); v += __shfl_xor(v, 16); v += __shfl_xor(v, 32); return v; }

DEV bf16x8 ld8(const bfu* p) { return *(const bf16x8*)p; }
DEV f32x4 mfma16(bf16x8 a, bf16x8 b, f32x4 c) { return __builtin_amdgcn_mfma_f32_16x16x32_bf16(a, b, c, 0, 0, 0); }

DEV void mfma16_acc(f32x4& c, bf16x8 a, bf16x8 b) { asm("v_mfma_f32_16x16x32_bf16 %0, %1, %2, %0" : "+a"(c) : "v"(a), "v"(b)); }
DEV void gld_async(bf16x8& v, const bfu* p) { asm volatile("global_load_dwordx4 %0, %1, off" : "=v"(v) : "v"(p) : "memory"); }
template <int N> DEV void gwait6(bf16x8& a0, bf16x8& a1, bf16x8& a2, bf16x8& a3, bf16x8& b0, bf16x8& b1) {
  asm volatile("s_waitcnt vmcnt(%6)" : "+v"(a0), "+v"(a1), "+v"(a2), "+v"(a3), "+v"(b0), "+v"(b1) : "n"(N) : "memory");
}
__shared__ __attribute__((aligned(16))) unsigned char smem[61440];
__shared__ int s_qitem;

DEV void transpose_tile(const float* src, bfu* dst, int R, int C, int tr, int tc) {
  float* tl = (float*)smem;
  int tid = tid_();
  __syncthreads();
  for (int i = tid; i < 4096; i += NTHR) {
    int r = i >> 6, c = i & 63;
    int gr = tr * 64 + r, gc = tc * 64 + c;
    tl[r * 65 + c] = (gr < R && gc < C) ? src[(size_t)gr * C + gc] : 0.f;
  }
  __syncthreads();
  for (int i = tid; i < 4096; i += NTHR) {
    int c = i >> 6, r = i & 63;
    int gr = tr * 64 + r, gc = tc * 64 + c;
    if (gr < R && gc < C) dst[(size_t)gc * R + gr] = f2bf(tl[r * 65 + c]);
  }
}
struct TJob { const float* src; bfu* dst; int R, C; };
DEV void phase_convert(const Params& p) {
  if (bid_() == 0) { if (tid_() < 64) ((unsigned*)(p.ws + O_SYNC))[tid_()] = 0u; for (int i = tid_(); i < 4096; i += NTHR) ((unsigned*)(p.ws + O_XB))[i] = 0u; }
  for (int l = 0; l < DEPTH; ++l) {
    unsigned char* wb = p.ws + O_W + (size_t)l * W_SZ;
    for (int j = 0; j < 20; ++j) {
      const float* src; bfu* dst; int R, C;
      if (j == 0) { src = p.w_in + (size_t)l * 1024 * NIN; dst = (bfu*)(wb + W_IN); R = 1024; C = NIN; }
      else if (j == 1) { src = p.w_out + (size_t)l * 1024 * 1024; dst = (bfu*)(wb + W_OUT); R = 1024; C = 1024; }
      else if (j == 2) { src = p.peer_wq + (size_t)l * 1024 * 2048; dst = (bfu*)(wb + W_Q); R = 1024; C = 2048; }
      else if (j < 5) { int k = j - 3; src = p.nsa_cmp_w1 + ((size_t)l * 2 + k) * 2048 * 256; dst = (bfu*)(wb + W_C1) + (size_t)k * 256 * 2048; R = 2048; C = 256; }
      else if (j < 7) { int k = j - 5; src = p.nsa_cmp_w2 + ((size_t)l * 2 + k) * 256 * 64; dst = (bfu*)(wb + W_C2) + (size_t)k * 64 * 256; R = 256; C = 64; }
      else if (j < 11) { int k = j - 7; src = p.lru_wa + ((size_t)l * 4 + k) * 4096; dst = (bfu*)(wb + W_LA) + k * 4096; R = 64; C = 64; }
      else if (j < 15) { int k = j - 11; src = p.lru_wi + ((size_t)l * 4 + k) * 4096; dst = (bfu*)(wb + W_LI) + k * 4096; R = 64; C = 64; }
      else if (j == 15) { src = p.rwkv_w2 + (size_t)l * 64 * 256; dst = (bfu*)(wb + W_R2); R = 64; C = 256; }
      else if (j == 16) { src = p.rwkv_a2 + (size_t)l * 64 * 256; dst = (bfu*)(wb + W_A2); R = 64; C = 256; }
      else if (j == 17) { src = p.rwkv_g2 + (size_t)l * 128 * 256; dst = (bfu*)(wb + W_G2); R = 128; C = 256; }
      else continue;
      int ntr = (R + 63) / 64, ntc = (C + 63) / 64;
      for (int t = bid_(); t < ntr * ntc; t += gridDim.x) transpose_tile(src, dst, R, C, t / ntc, t % ntc);
    }
    {
      const float* src = p.peer_keys + (size_t)l * 16 * 128 * 128; bfu* dst = (bfu*)(wb + W_KEYS);
      for (int i = bid_() * NTHR + tid_(); i < 16 * 128 * 128; i += gridDim.x * NTHR) dst[i] = f2bf(src[i]);
    }
  }
}
constexpr float PU_SCALE = 512.f, PV_SCALE = 128.f;
DEV unsigned pack_fp8x4(float a, float b, float c, float d, float sc) {
  a = fminf(fmaxf(a * sc, -448.f), 448.f); b = fminf(fmaxf(b * sc, -448.f), 448.f);
  c = fminf(fmaxf(c * sc, -448.f), 448.f); d = fminf(fmaxf(d * sc, -448.f), 448.f);
  int w = 0;
  w = __builtin_amdgcn_cvt_pk_fp8_f32(a, b, w, false);
  w = __builtin_amdgcn_cvt_pk_fp8_f32(c, d, w, true);
  return (unsigned)w;
}
DEV void convert_peer_uv(const Params& p, int l) {
  typedef float f4v __attribute__((ext_vector_type(4)));
  const f4v* su = (const f4v*)(p.peer_u + (size_t)l * 16384 * 1024);
  const f4v* sv = (const f4v*)(p.peer_v + (size_t)l * 16384 * 1024);
  unsigned* duv = (unsigned*)(p.ws + O_PU);
  const int n4 = 16384 * 1024 / 4;
  const int stride = gridDim.x * NTHR;
  for (int i0 = bid_() * NTHR + tid_(); i0 < n4; i0 += stride * 4) {
    f4v a[4], b[4];
#pragma unroll
    for (int k = 0; k < 4; ++k) {
      const int i = i0 + k * stride;
      if (i < n4) { a[k] = __builtin_nontemporal_load(su + i); b[k] = __builtin_nontemporal_load(sv + i); }
    }
#pragma unroll
    for (int k = 0; k < 4; ++k) {
      const int i = i0 + k * stride;
      if (i < n4) {
        const int e = i >> 8, c = i & 255;
        duv[e * 512 + c] = pack_fp8x4(a[k].x, a[k].y, a[k].z, a[k].w, PU_SCALE);
        duv[e * 512 + 256 + c] = pack_fp8x4(b[k].x, b[k].y, b[k].z, b[k].w, PV_SCALE);
      }
    }
  }
}

DEV void phase_norm(const float* h, const float* g, bfu* dst) {
  int lane = tid_() & 63, wv = tid_() >> 6;
  for (int t = bid_() * 4 + wv; t < T; t += gridDim.x * 4) {
    const float4* hp = (const float4*)(h + (size_t)t * D);
    float4 v[4]; float ss = 0.f;
#pragma unroll
    for (int i = 0; i < 4; ++i) { v[i] = hp[lane + i * 64]; ss += v[i].x * v[i].x + v[i].y * v[i].y + v[i].z * v[i].z + v[i].w * v[i].w; }
    ss = wave_sum(ss);
    float sc = rsqrtf(ss * (1.f / D) + 1e-6f);
#pragma unroll
    for (int i = 0; i < 4; ++i) {
      float4 gg = ((const float4*)g)[lane + i * 64];
      uint2 o = make_uint2(pack2(v[i].x * sc * gg.x, v[i].y * sc * gg.y), pack2(v[i].z * sc * gg.z, v[i].w * sc * gg.w));
      ((uint2*)(dst + (size_t)t * D))[lane + i * 64] = o;
    }
  }
}

template <int N> DEV void gwait4(bf16x8& a0, bf16x8& a1, bf16x8& b0, bf16x8& b1) {
  asm volatile("s_waitcnt vmcnt(%4)" : "+v"(a0), "+v"(a1), "+v"(b0), "+v"(b1) : "n"(N) : "memory");
}
template <int MODE>
DEV void gemm_phase(const bfu* __restrict__ A, const bfu* __restrict__ Bt, int N, int K,
                    bfu* __restrict__ Cb, int ldc, float* __restrict__ side, const float* __restrict__ hin, float* __restrict__ hout) {
  constexpr int STR = 32;
  constexpr int BUFE = 256 * STR;
  bfu* As = (bfu*)smem;
  bfu* Bs = As + 128 * STR;
  const int tid = tid_(), lane = tid & 63, wv = tid >> 6;
  const int wm = wv >> 1, wn = wv & 1;
  const int ntn = (N + 127) / 128, ntm = T / 128;
  const int lr = lane & 15, lq = lane >> 4;
  const int swz = (lq ^ ((0x1320 >> (((lr >> 2) & 3) * 4)) & 3)) * 8;
  const int bid = bid_();
  const bool xmap = (gridDim.x & 7) == 0;
  const int ns = (ntn >= 16) ? 2 : 1;
  const int xcd = bid & 7, nloc = xmap ? (int)(gridDim.x >> 3) : (int)gridDim.x;
  const int ntn_p = xmap ? ntn / ns : ntn, mstep = xmap ? 8 / ns : 1;
  const int xs = xmap ? xcd % ns : 0, xm = xmap ? xcd / ns : 0;
  const int ntile_x = xmap ? (ntm / mstep) * ntn_p : ntm * ntn;
  for (int u = xmap ? (bid >> 3) : bid; u < ntile_x; u += nloc) {
    const int tm = (u / ntn_p) * mstep + xm, tn = xs * ntn_p + (u % ntn_p);
    const int m0 = tm * 128, n0 = tn * 128;
    f32x4 acc[4][4];
#pragma unroll
    for (int i = 0; i < 4; ++i)
#pragma unroll
      for (int j = 0; j < 4; ++j) acc[i][j] = (f32x4){0.f, 0.f, 0.f, 0.f};
    const bfu* ap[2]; const bfu* bp[2]; int so[2];
#pragma unroll
    for (int i = 0; i < 2; ++i) {
      int c = tid + i * NTHR; int row = c >> 2, kc = c & 3;
      ap[i] = A + (size_t)(m0 + row) * K + kc * 8;
      so[i] = row * STR + ((kc ^ ((0x1320 >> (((row >> 2) & 3) * 4)) & 3)) * 8);
      int nr = n0 + row; if (nr > N - 1) nr = N - 1;
      bp[i] = Bt + (size_t)nr * K + kc * 8;
    }
    bf16x8 ra[2][2], rb[2][2];
    __syncthreads();
#pragma unroll
    for (int i = 0; i < 2; ++i) { *(bf16x8*)(As + so[i]) = ld8(ap[i]); *(bf16x8*)(Bs + so[i]) = ld8(bp[i]); }
#pragma unroll
    for (int q = 0; q < 2; ++q)
#pragma unroll
      for (int i = 0; i < 2; ++i) { gld_async(ra[q][i], ap[i] + (q + 1) * 32); gld_async(rb[q][i], bp[i] + (q + 1) * 32); }
    const int nst = K / 32;
    for (int st = 0; st < nst; st += 2) {
#pragma unroll
      for (int q = 0; q < 2; ++q) {
        const int sidx = st + q;
        const bfu* Ar = As + q * BUFE;
        const bfu* Br = Bs + q * BUFE;
        bfu* Aw = As + (q ^ 1) * BUFE;
        bfu* Bw = Bs + (q ^ 1) * BUFE;
        __syncthreads();
        bf16x8 af[4], bfr[4];
#pragma unroll
        for (int i = 0; i < 4; ++i) af[i] = *(const bf16x8*)(Ar + (wm * 64 + i * 16 + lr) * STR + swz);
#pragma unroll
        for (int j = 0; j < 4; ++j) bfr[j] = *(const bf16x8*)(Br + (wn * 64 + j * 16 + lr) * STR + swz);
        const int kn = (sidx + 3 < nst ? sidx + 3 : nst - 1) * 32;
        gwait4<4>(ra[q][0], ra[q][1], rb[q][0], rb[q][1]);
#pragma unroll
        for (int i = 0; i < 2; ++i) { *(bf16x8*)(Aw + so[i]) = ra[q][i]; *(bf16x8*)(Bw + so[i]) = rb[q][i]; }
#pragma unroll
        for (int i = 0; i < 2; ++i) { gld_async(ra[q][i], ap[i] + kn); gld_async(rb[q][i], bp[i] + kn); }
#pragma unroll
        for (int i = 0; i < 4; ++i)
#pragma unroll
          for (int j = 0; j < 4; ++j) mfma16_acc(acc[i][j], bfr[j], af[i]);
      }
    }
#pragma unroll
    for (int q = 0; q < 2; ++q) gwait4<0>(ra[q][0], ra[q][1], rb[q][0], rb[q][1]);
    asm volatile("s_nop 7\n\ts_nop 7\n\ts_nop 7" ::: "memory");
#pragma unroll
    for (int i = 0; i < 4; ++i) {
      const int row = m0 + wm * 64 + i * 16 + lr;
#pragma unroll
      for (int j = 0; j < 4; ++j) {
        const int col = n0 + wn * 64 + j * 16 + lq * 4;
        const f32x4 v = acc[i][j];
        if (MODE == 0) {
          if (col < N) {
            *(uint2*)(Cb + (size_t)row * ldc + col) = make_uint2(pack2(v[0], v[1]), pack2(v[2], v[3]));
            if (col == C_DT) *(float4*)(side + (size_t)row * 16) = make_float4(v[0], v[1], v[2], v[3]);
            if (col >= C_GT) *(float4*)(side + (size_t)row * 16 + 4 + (col - C_GT)) = make_float4(v[0], v[1], v[2], v[3]);
          }
        } else if (MODE == 1) {
          const size_t o = (size_t)row * D + col;
          const float4 h = *(const float4*)(hin + o);
          *(float4*)(hout + o) = make_float4(h.x + v[0], h.y + v[1], h.z + v[2], h.w + v[3]);
        } else {
          *(uint2*)(Cb + (size_t)row * ldc + col) = make_uint2(pack2(v[0], v[1]), pack2(v[2], v[3]));
        }
      }
    }
  }
}

template <int MODE>
DEV void ssd_item(const Params& p, int l, int item) {
  const int g = item & 1, c = (item >> 1) & 127, b = item >> 8;
  const int tid = tid_(), lane = tid & 63, wv = tid >> 6, lr = lane & 15, lq = lane >> 4;
  const bfu* COLS = (const bfu*)(p.ws + O_COLS);
  const float* SIDE = (const float*)(p.ws + O_SIDE);
  float* ST = (float*)(p.ws + O_SST);
  const int tb = b * S + c * 64;
  float* s_dt = (float*)smem;
  float* s_acs = s_dt + 128;
  bfu* XT = (bfu*)(smem + 1024);
  bfu* Bm = XT + 128 * 72;
  bfu* Cm = Bm + 64 * 72;
  bfu* Mw = Cm + 64 * 72 + wv * (16 * 72);
  __syncthreads();
  if (wv < 2) {
    int h = g * 2 + wv;
    float dtv = softplusf_(SIDE[(size_t)(tb + lane) * 16 + h] + p.ssm_dt_bias[l * 4 + h]);
    float s = -__expf(p.ssm_a_log[l * 4 + h]) * dtv;
    for (int o = 1; o < 64; o <<= 1) { float t = __shfl_up(s, o); if (lane >= o) s += t; }
    s_dt[wv * 64 + lane] = dtv; s_acs[wv * 64 + lane] = s;
  }
  __syncthreads();
  {
    const int cg8 = tid & 31, tg = tid >> 5;
    const int lc = cg8 * 8;
    const int xc = (lc < 128) ? (g * 128 + lc) : (lc < 192 ? 256 + g * 64 + (lc - 128) : 384 + g * 64 + (lc - 192));
    if (MODE == 1 || lc < 192) {
      float w[4][8], bias[8];
#pragma unroll
      for (int i = 0; i < 8; ++i) {
        bias[i] = p.ssm_conv_b[l * 512 + xc + i];
#pragma unroll
        for (int k = 0; k < 4; ++k) w[k][i] = p.ssm_conv_w[(l * 4 + k) * 512 + xc + i];
      }
      const int tl0 = tg * 8;
      float win[3][8];
      float outv[8][8];
#pragma unroll
      for (int rr = 0; rr < 11; ++rr) {
        int tl = tl0 - 3 + rr; int tpos = c * 64 + tl;
        float cur[8];
        if (tpos >= 0) {
          uint4 u = *(const uint4*)(COLS + (size_t)(b * S + tpos) * NIN + C_XBC + xc);
          cur[0] = lo2f(u.x); cur[1] = hi2f(u.x); cur[2] = lo2f(u.y); cur[3] = hi2f(u.y); cur[4] = lo2f(u.z); cur[5] = hi2f(u.z); cur[6] = lo2f(u.w); cur[7] = hi2f(u.w);
        } else {
#pragma unroll
          for (int i = 0; i < 8; ++i) cur[i] = 0.f;
        }
        if (rr >= 3) {
#pragma unroll
          for (int i = 0; i < 8; ++i) {
            float a = bias[i] + w[0][i] * win[0][i] + w[1][i] * win[1][i] + w[2][i] * win[2][i] + w[3][i] * cur[i];
            outv[rr - 3][i] = siluf_(a);
          }
        }
#pragma unroll
        for (int i = 0; i < 8; ++i) { win[0][i] = win[1][i]; win[1][i] = win[2][i]; win[2][i] = cur[i]; }
      }
      if (lc < 128) {
        const int hh = lc >> 6;
        float sc[8];
#pragma unroll
        for (int j = 0; j < 8; ++j) {
          float d = s_dt[hh * 64 + tl0 + j];
          if (MODE == 0) d *= __expf(s_acs[hh * 64 + 63] - s_acs[hh * 64 + tl0 + j]);
          sc[j] = d;
        }
#pragma unroll
        for (int i = 0; i < 8; ++i) {
          uint4 o = make_uint4(pack2(outv[0][i] * sc[0], outv[1][i] * sc[1]), pack2(outv[2][i] * sc[2], outv[3][i] * sc[3]),
                               pack2(outv[4][i] * sc[4], outv[5][i] * sc[5]), pack2(outv[6][i] * sc[6], outv[7][i] * sc[7]));
          *(uint4*)(XT + (lc + i) * 72 + tl0) = o;
        }
      } else if (lc < 192) {
        if (MODE == 0) {
#pragma unroll
          for (int i = 0; i < 8; ++i) {
            uint4 o = make_uint4(pack2(outv[0][i], outv[1][i]), pack2(outv[2][i], outv[3][i]), pack2(outv[4][i], outv[5][i]), pack2(outv[6][i], outv[7][i]));
            *(uint4*)(Bm + (lc - 128 + i) * 72 + tl0) = o;
          }
        } else {
#pragma unroll
          for (int j = 0; j < 8; ++j) {
            uint4 o = make_uint4(pack2(outv[j][0], outv[j][1]), pack2(outv[j][2], outv[j][3]), pack2(outv[j][4], outv[j][5]), pack2(outv[j][6], outv[j][7]));
            *(uint4*)(Bm + (tl0 + j) * 72 + (lc - 128)) = o;
          }
        }
      } else {
#pragma unroll
        for (int j = 0; j < 8; ++j) {
          uint4 o = make_uint4(pack2(outv[j][0], outv[j][1]), pack2(outv[j][2], outv[j][3]), pack2(outv[j][4], outv[j][5]), pack2(outv[j][6], outv[j][7]));
          *(uint4*)(Cm + (tl0 + j) * 72 + (lc - 192)) = o;
        }
      }
    }
  }
  __syncthreads();
  if (MODE == 0) {
    const int hh = wv >> 1, ph = wv & 1, h = g * 2 + hh;
    f32x4 acc[2][4];
#pragma unroll
    for (int i = 0; i < 2; ++i)
#pragma unroll
      for (int j = 0; j < 4; ++j) acc[i][j] = (f32x4){0.f, 0.f, 0.f, 0.f};
#pragma unroll
    for (int ks = 0; ks < 2; ++ks) {
      bf16x8 af[2], bfr[4];
#pragma unroll
      for (int i = 0; i < 2; ++i) af[i] = *(const bf16x8*)(XT + (hh * 64 + ph * 32 + i * 16 + lr) * 72 + ks * 32 + lq * 8);
#pragma unroll
      for (int j = 0; j < 4; ++j) bfr[j] = *(const bf16x8*)(Bm + (j * 16 + lr) * 72 + ks * 32 + lq * 8);
#pragma unroll
      for (int i = 0; i < 2; ++i)
#pragma unroll
        for (int j = 0; j < 4; ++j) acc[i][j] = mfma16(af[i], bfr[j], acc[i][j]);
    }
    float* dst = ST + ((size_t)((b * 4 + h) * NCH + c)) * 4096;
#pragma unroll
    for (int i = 0; i < 2; ++i)
#pragma unroll
      for (int j = 0; j < 4; ++j)
#pragma unroll
        for (int r = 0; r < 4; ++r) dst[(ph * 32 + i * 16 + lq * 4 + r) * 64 + j * 16 + lr] = acc[i][j][r];
    if (tid < 2) ((float*)(p.ws + O_SAT))[(b * 4 + g * 2 + tid) * NCH + c] = s_acs[tid * 64 + 63];
  } else {
    bf16x8 cf[2];
#pragma unroll
    for (int ks = 0; ks < 2; ++ks) cf[ks] = *(const bf16x8*)(Cm + (wv * 16 + lr) * 72 + ks * 32 + lq * 8);
    f32x4 G[4];
#pragma unroll
    for (int st = 0; st < 4; ++st) {
      G[st] = (f32x4){0.f, 0.f, 0.f, 0.f};
      if (st <= wv) {
#pragma unroll
        for (int ks = 0; ks < 2; ++ks) G[st] = mfma16(cf[ks], *(const bf16x8*)(Bm + (st * 16 + lr) * 72 + ks * 32 + lq * 8), G[st]);
      }
    }
    f32x4 Y[2][4];
#pragma unroll
    for (int hh = 0; hh < 2; ++hh) {
      const int h = g * 2 + hh;
      const float* Hs = ST + ((size_t)((b * 4 + h) * NCH + c)) * 4096;
      float al[4];
#pragma unroll
      for (int r = 0; r < 4; ++r) al[r] = s_acs[hh * 64 + wv * 16 + lq * 4 + r];
#pragma unroll
      for (int pt = 0; pt < 4; ++pt) {
        f32x4 y = {0.f, 0.f, 0.f, 0.f};
#pragma unroll
        for (int ks = 0; ks < 2; ++ks) {
          const float4* hp = (const float4*)(Hs + (pt * 16 + lr) * 64 + ks * 32 + lq * 8);
          float4 h0 = hp[0], h1 = hp[1];
          bf16x8 hb;
          unsigned u0 = pack2(h0.x, h0.y), u1 = pack2(h0.z, h0.w), u2 = pack2(h1.x, h1.y), u3 = pack2(h1.z, h1.w);
          hb[0] = (short)(u0 & 0xffff); hb[1] = (short)(u0 >> 16); hb[2] = (short)(u1 & 0xffff); hb[3] = (short)(u1 >> 16);
          hb[4] = (short)(u2 & 0xffff); hb[5] = (short)(u2 >> 16); hb[6] = (short)(u3 & 0xffff); hb[7] = (short)(u3 >> 16);
          y = mfma16(cf[ks], hb, y);
        }
#pragma unroll
        for (int r = 0; r < 4; ++r) y[r] *= __expf(al[r]);
        Y[hh][pt] = y;
      }
#pragma unroll
      for (int st = 0; st < 4; ++st) {
        float as = s_acs[hh * 64 + st * 16 + lr];
#pragma unroll
        for (int r = 0; r < 4; ++r) {
          int ll = wv * 16 + lq * 4 + r, ss = st * 16 + lr;
          float m = (ss <= ll) ? G[st][r] * __expf(al[r] - as) : 0.f;
          Mw[(lq * 4 + r) * 72 + st * 16 + lr] = f2bf(m);
        }
      }
      for (int ks = 0; ks <= (wv >> 1); ++ks) {
        bf16x8 ma = *(const bf16x8*)(Mw + lr * 72 + ks * 32 + lq * 8);
#pragma unroll
        for (int pt = 0; pt < 4; ++pt)
          Y[hh][pt] = mfma16(ma, *(const bf16x8*)(XT + (hh * 64 + pt * 16 + lr) * 72 + ks * 32 + lq * 8), Y[hh][pt]);
      }
    }
    float ssq[4] = {0.f, 0.f, 0.f, 0.f};
#pragma unroll
    for (int hh = 0; hh < 2; ++hh) {
      const int h = g * 2 + hh;
      const float dsk = p.ssm_d[l * 4 + h];
#pragma unroll
      for (int pt = 0; pt < 4; ++pt)
#pragma unroll
        for (int r = 0; r < 4; ++r) {
          int ll = wv * 16 + lq * 4 + r, pch = pt * 16 + lr;
          float xs = bf2f(XT[(hh * 64 + pch) * 72 + ll]) / s_dt[hh * 64 + ll];
          float z = bf2f(COLS[(size_t)(tb + ll) * NIN + C_Z + h * 64 + pch]);
          float y = (Y[hh][pt][r] + dsk * xs) * siluf_(z);
          Y[hh][pt][r] = y; ssq[r] += y * y;
        }
    }
    bfu* MIX = (bfu*)(p.ws + O_ACT);
#pragma unroll
    for (int r = 0; r < 4; ++r) {
      float sc = rsqrtf(row16_sum(ssq[r]) * (1.f / 128.f) + 1e-6f);
      int ll = wv * 16 + lq * 4 + r;
#pragma unroll
      for (int hh = 0; hh < 2; ++hh)
#pragma unroll
        for (int pt = 0; pt < 4; ++pt) {
          int ch = (g * 2 + hh) * 64 + pt * 16 + lr;
          MIX[(size_t)(tb + ll) * 1024 + ch] = f2bf(Y[hh][pt][r] * sc * p.ssm_norm[l * 256 + ch]);
        }
    }
  }
}
DEV void ssd_rec_item(const Params& p, int item) {
  const int bh = item >> 4, e = (item & 15) * 256 + tid_();
  float* ST = (float*)(p.ws + O_SST) + (size_t)bh * NCH * 4096 + e;
  const float* AT = (const float*)(p.ws + O_SAT) + bh * NCH;
  float H = 0.f;
  for (int c0 = 0; c0 < NCH; c0 += 8) {
    float s[8];
#pragma unroll
    for (int i = 0; i < 8; ++i) s[i] = ST[(size_t)(c0 + i) * 4096];
#pragma unroll
    for (int i = 0; i < 8; ++i) { ST[(size_t)(c0 + i) * 4096] = H; H = __expf(AT[c0 + i]) * H + s[i]; }
  }
}

template <int MODE>
DEV void lru_item(const Params& p, int l, int item) {
  const int hb = item & 3, c = (item >> 2) & 127, b = item >> 9;
  const int tid = tid_(), lane = tid & 63, wv = tid >> 6, lr = lane & 15, lq = lane >> 4;
  const bfu* COLS = (const bfu*)(p.ws + O_COLS);
  const int tb = b * S + c * 64;
  bfu* Xl = (bfu*)smem;
  float* Af = (float*)(smem + 9216);
  float* Uf = Af + 4096;
  __syncthreads();
  {
    const int cg8 = tid & 7, tg = tid >> 3;
    const int ch = hb * 64 + cg8 * 8;
    float w[4][8], bias[8];
#pragma unroll
    for (int i = 0; i < 8; ++i) {
      bias[i] = p.lru_conv_b[l * 256 + ch + i];
#pragma unroll
      for (int k = 0; k < 4; ++k) w[k][i] = p.lru_conv_w[(l * 4 + k) * 256 + ch + i];
    }
    float win[3][8];
#pragma unroll
    for (int rr = 0; rr < 5; ++rr) {
      int tl = tg * 2 - 3 + rr; int tpos = c * 64 + tl;
      float cur[8];
      if (tpos >= 0) {
        uint4 u = *(const uint4*)(COLS + (size_t)(b * S + tpos) * NIN + C_LX + ch);
        cur[0] = lo2f(u.x); cur[1] = hi2f(u.x); cur[2] = lo2f(u.y); cur[3] = hi2f(u.y); cur[4] = lo2f(u.z); cur[5] = hi2f(u.z); cur[6] = lo2f(u.w); cur[7] = hi2f(u.w);
      } else {
#pragma unroll
        for (int i = 0; i < 8; ++i) cur[i] = 0.f;
      }
      if (rr >= 3) {
        float o[8];
#pragma unroll
        for (int i = 0; i < 8; ++i) o[i] = bias[i] + w[0][i] * win[0][i] + w[1][i] * win[1][i] + w[2][i] * win[2][i] + w[3][i] * cur[i];
        *(uint4*)(Xl + tl * 72 + cg8 * 8) = make_uint4(pack2(o[0], o[1]), pack2(o[2], o[3]), pack2(o[4], o[5]), pack2(o[6], o[7]));
        *(float4*)(Uf + tl * 64 + cg8 * 8) = make_float4(o[0], o[1], o[2], o[3]);
        *(float4*)(Uf + tl * 64 + cg8 * 8 + 4) = make_float4(o[4], o[5], o[6], o[7]);
      }
#pragma unroll
      for (int i = 0; i < 8; ++i) { win[0][i] = win[1][i]; win[1][i] = win[2][i]; win[2][i] = cur[i]; }
    }
  }
  __syncthreads();
  {
    const bfu* waT = (const bfu*)(p.ws + O_W + (size_t)l * W_SZ + W_LA) + hb * 4096;
    const bfu* wiT = (const bfu*)(p.ws + O_W + (size_t)l * W_SZ + W_LI) + hb * 4096;
    bf16x8 xa[2];
#pragma unroll
    for (int ks = 0; ks < 2; ++ks) xa[ks] = *(const bf16x8*)(Xl + (wv * 16 + lr) * 72 + ks * 32 + lq * 8);
#pragma unroll
    for (int jt = 0; jt < 4; ++jt) {
      f32x4 R = {0.f, 0.f, 0.f, 0.f}, I = {0.f, 0.f, 0.f, 0.f};
#pragma unroll
      for (int ks = 0; ks < 2; ++ks) {
        R = mfma16(xa[ks], ld8(waT + (jt * 16 + lr) * 64 + ks * 32 + lq * 8), R);
        I = mfma16(xa[ks], ld8(wiT + (jt * 16 + lr) * 64 + ks * 32 + lq * 8), I);
      }
      const int j = jt * 16 + lr, ch = hb * 64 + j;
      const float ba = p.lru_ba[l * 256 + ch], bi = p.lru_bi[l * 256 + ch];
      const float lsl = -softplusf_(-p.lru_lambda[l * 256 + ch]);
#pragma unroll
      for (int r = 0; r < 4; ++r) {
        int ll = wv * 16 + lq * 4 + r;
        float rg = sigmoidf_(R[r] + ba), ig = sigmoidf_(I[r] + bi);
        float la = 8.f * rg * lsl;
        float a = __expf(la);
        float xb = Uf[ll * 64 + j];
        float u = sqrtf(-expm1f(2.f * la)) * ig * xb;
        Af[ll * 64 + j] = a; Uf[ll * 64 + j] = u;
      }
    }
  }
  __syncthreads();
  const size_t sidx = (size_t)(b * NCH + c) * 256 + hb * 64;
  if (wv == 0) {
    if (MODE == 0) {
      float A = 1.f, h = 0.f;
      for (int t = 0; t < 64; ++t) { float a = Af[t * 64 + lane]; h = a * h + Uf[t * 64 + lane]; A *= a; }
      ((float*)(p.ws + O_LA))[sidx + lane] = A; ((float*)(p.ws + O_LH))[sidx + lane] = h;
    } else {
      float h = ((const float*)(p.ws + O_LH))[sidx + lane];
      for (int t = 0; t < 64; ++t) { h = Af[t * 64 + lane] * h + Uf[t * 64 + lane]; Uf[t * 64 + lane] = h; }
    }
  }
  if (MODE == 1) {
    __syncthreads();
    const int ll = tid >> 2, jq = (tid & 3) * 16;
    bfu* MIX = (bfu*)(p.ws + O_ACT) + (size_t)(tb + ll) * 1024 + 256 + hb * 64 + jq;
    const bfu* gp = COLS + (size_t)(tb + ll) * NIN + C_LG + hb * 64 + jq;
    unsigned ov[8];
#pragma unroll
    for (int i = 0; i < 8; ++i) {
      unsigned gu = *(const unsigned*)(gp + i * 2);
      float y0 = Uf[ll * 64 + jq + i * 2] * geluf_(lo2f(gu)), y1 = Uf[ll * 64 + jq + i * 2 + 1] * geluf_(hi2f(gu));
      ov[i] = pack2(y0, y1);
    }
    *(uint4*)MIX = make_uint4(ov[0], ov[1], ov[2], ov[3]);
    *(uint4*)(MIX + 8) = make_uint4(ov[4], ov[5], ov[6], ov[7]);
  }
}
DEV void lru_carry_item(const Params& p, int item) {
  const int i = item * 256 + tid_();
  const int b = i >> 8, ch = i & 255;
  const float* LA = (const float*)(p.ws + O_LA) + (size_t)b * NCH * 256 + ch;
  float* LH = (float*)(p.ws + O_LH) + (size_t)b * NCH * 256 + ch;
  float H = 0.f;
  for (int c = 0; c < NCH; ++c) { float A = LA[c * 256], he = LH[c * 256]; LH[c * 256] = H; H = A * H + he; }
}
DEV void shifted8(const bfu* COLS, const float* mu, int t, int col, float* out) {
  uint4 u = *(const uint4*)(COLS + (size_t)t * NIN + C_RWKV + col);
  float c[8] = {lo2f(u.x), hi2f(u.x), lo2f(u.y), hi2f(u.y), lo2f(u.z), hi2f(u.z), lo2f(u.w), hi2f(u.w)};
  float pv[8] = {0.f, 0.f, 0.f, 0.f, 0.f, 0.f, 0.f, 0.f};
  if ((t & (S - 1)) != 0) {
    uint4 q = *(const uint4*)(COLS + (size_t)(t - 1) * NIN + C_RWKV + col);
    pv[0] = lo2f(q.x); pv[1] = hi2f(q.x); pv[2] = lo2f(q.y); pv[3] = hi2f(q.y); pv[4] = lo2f(q.z); pv[5] = hi2f(q.z); pv[6] = lo2f(q.w); pv[7] = hi2f(q.w);
  }
#pragma unroll
  for (int i = 0; i < 8; ++i) out[i] = c[i] + (pv[i] - c[i]) * mu[col + i];
}
DEV float shifted1(const bfu* COLS, const float* mu, int t, int col) {
  float c = bf2f(COLS[(size_t)t * NIN + C_RWKV + col]);
  float pv = ((t & (S - 1)) != 0) ? bf2f(COLS[(size_t)(t - 1) * NIN + C_RWKV + col]) : 0.f;
  return c + (pv - c) * mu[col];
}
DEV bf16x8 packf8(const float* v) {
  bf16x8 o;
#pragma unroll
  for (int i = 0; i < 8; ++i) o[i] = (short)f2bf(v[i]);
  return o;
}
DEV void rwkv_prep_item(const Params& p, int l, int item) {
  const int lane = tid_() & 63, wv = tid_() >> 6, lr = lane & 15, lq = lane >> 4;
  const bfu* COLS = (const bfu*)(p.ws + O_COLS);
  const float* mu = p.rwkv_mu + l * 1024;
  const int t0 = item * 64 + wv * 16;
  const unsigned char* wb = p.ws + O_W + (size_t)l * W_SZ;
  const bfu* w2T = (const bfu*)(wb + W_R2); const bfu* a2T = (const bfu*)(wb + W_A2); const bfu* g2T = (const bfu*)(wb + W_G2);
  bf16x8 wdA[2], adA[2], gdA[4];
  {
    float tmp[8];
#pragma unroll
    for (int ks = 0; ks < 2; ++ks) {
      shifted8(COLS, mu, t0 + lr, 768 + ks * 32 + lq * 8, tmp);
#pragma unroll
      for (int i = 0; i < 8; ++i) tmp[i] = tanhf(tmp[i]);
      wdA[ks] = packf8(tmp);
      shifted8(COLS, mu, t0 + lr, 832 + ks * 32 + lq * 8, tmp);
      adA[ks] = packf8(tmp);
    }
#pragma unroll
    for (int ks = 0; ks < 4; ++ks) {
      shifted8(COLS, mu, t0 + lr, 896 + ks * 32 + lq * 8, tmp);
#pragma unroll
      for (int i = 0; i < 8; ++i) tmp[i] = sigmoidf_(tmp[i]);
      gdA[ks] = packf8(tmp);
    }
  }
  const int b = t0 / S;
  bfu* RG = (bfu*)(p.ws + O_RG);
  for (int hd = 0; hd < 4; ++hd) {
    float kkv[4][4], av[4][4], k2v[4][4], rv[4][4], vv[4][4], wv_[4][4];
    float ss[4] = {0.f, 0.f, 0.f, 0.f};
#pragma unroll
    for (int q = 0; q < 4; ++q) {
      const int nt = hd * 4 + q, n = nt * 16 + lr;
      f32x4 W = {0.f, 0.f, 0.f, 0.f}, A = {0.f, 0.f, 0.f, 0.f}, G = {0.f, 0.f, 0.f, 0.f};
#pragma unroll
      for (int ks = 0; ks < 2; ++ks) {
        W = mfma16(wdA[ks], ld8(w2T + n * 64 + ks * 32 + lq * 8), W);
        A = mfma16(adA[ks], ld8(a2T + n * 64 + ks * 32 + lq * 8), A);
      }
#pragma unroll
      for (int ks = 0; ks < 4; ++ks) G = mfma16(gdA[ks], ld8(g2T + n * 128 + ks * 32 + lq * 8), G);
      const float w0 = p.rwkv_w0[l * 256 + n], a0 = p.rwkv_a0[l * 256 + n], kkw = p.rwkv_kk[l * 256 + n], kaw = p.rwkv_ka[l * 256 + n];
#pragma unroll
      for (int r = 0; r < 4; ++r) {
        const int t = t0 + lq * 4 + r;
        float wl = -softplusf_(-(w0 + W[r])) - 0.5f;
        wv_[q][r] = __expf(-__expf(wl));
        float a = sigmoidf_(a0 + A[r]);
        float r_ = shifted1(COLS, mu, t, n), k_ = shifted1(COLS, mu, t, 256 + n), v_ = shifted1(COLS, mu, t, 512 + n);
        float kk = k_ * kkw;
        kkv[q][r] = kk; ss[r] += kk * kk; av[q][r] = a;
        k2v[q][r] = k_ * (1.f + (a - 1.f) * kaw);
        rv[q][r] = r_; vv[q][r] = v_;
        RG[(size_t)t * 256 + n] = f2bf(G[r]);
      }
    }
#pragma unroll
    for (int r = 0; r < 4; ++r) {
      float nrm = fmaxf(sqrtf(row16_sum(ss[r])), 1e-12f);
      float inv = 1.f / nrm;
      const int t = t0 + lq * 4 + r;
      unsigned char* dst = p.ws + O_RIN + ((size_t)(b * 4 + hd) * S + (t & (S - 1))) * 896;
#pragma unroll
      for (int q = 0; q < 4; ++q) {
        const int j = q * 16 + lr;
        float kkn = kkv[q][r] * inv;
        ((float*)dst)[j] = wv_[q][r];
        ((bfu*)(dst + 256))[j] = f2bf(-kkn);
        ((bfu*)(dst + 384))[j] = f2bf(kkn * av[q][r]);
        ((bfu*)(dst + 512))[j] = f2bf(k2v[q][r]);
        ((bfu*)(dst + 640))[j] = f2bf(rv[q][r]);
        ((bfu*)(dst + 768))[j] = f2bf(vv[q][r]);
      }
    }
  }
}
typedef float f32x2s __attribute__((ext_vector_type(2)));
DEV void rwkv_stage_write(float* dstbuf, uint4 v, int off, bool isw) {
  if (isw) { *(uint4*)(dstbuf + off) = v; }
  else {
    *(float4*)(dstbuf + off) = make_float4(lo2f(v.x), hi2f(v.x), lo2f(v.y), hi2f(v.y));
    *(float4*)(dstbuf + off + 4) = make_float4(lo2f(v.z), hi2f(v.z), lo2f(v.w), hi2f(v.w));
  }
}
DEV void rwkv_scan_item(const Params& p, int item) {
  const int bh = item >> 2, qd = item & 3;
  const int tid = tid_(), lane = tid & 63, wv = tid >> 6, lr = lane & 15, lq = lane >> 4;
  const unsigned char* src = p.ws + O_RIN + (size_t)bh * S * 896;
  float* Y = (float*)(p.ws + O_RY) + (size_t)(bh >> 2) * S * 256 + (bh & 3) * 64;
  const int irow = qd * 16 + wv * 4 + lq;
  float* buf = (float*)smem;
  constexpr int CH = 16, CB = CH * 896, CF = CH * 384;
  int soff[4]; bool sw[4];
#pragma unroll
  for (int i = 0; i < 4; ++i) {
    int idx = tid + i * 256; int st = idx / 56, wi = idx - st * 56;
    sw[i] = wi < 16;
    soff[i] = st * 384 + (sw[i] ? wi * 4 : 64 + ((wi - 16) >> 3) * 64 + ((wi - 16) & 7) * 8);
  }
  const bool t3 = tid < 896 - 768;
  __syncthreads();
  uint4 st0, st1, st2, st3 = make_uint4(0, 0, 0, 0);
  st0 = ((const uint4*)src)[tid]; st1 = ((const uint4*)src)[tid + 256]; st2 = ((const uint4*)src)[tid + 512]; if (t3) st3 = ((const uint4*)src)[tid + 768];
  rwkv_stage_write(buf, st0, soff[0], sw[0]); rwkv_stage_write(buf, st1, soff[1], sw[1]); rwkv_stage_write(buf, st2, soff[2], sw[2]);
  if (t3) rwkv_stage_write(buf, st3, soff[3], sw[3]);
  __syncthreads();
  f32x2s s01 = {0.f, 0.f}, s23 = {0.f, 0.f};
  for (int ch = 0; ch < S / CH; ++ch) {
    if (ch + 1 < S / CH) {
      const uint4* nsrc = (const uint4*)(src + (size_t)(ch + 1) * CB);
      st0 = nsrc[tid]; st1 = nsrc[tid + 256]; st2 = nsrc[tid + 512]; if (t3) st3 = nsrc[tid + 768];
    }
    const float* cb = buf + (ch & 1) * CF;
    float ykeep = 0.f;
    float4 W = *(const float4*)(cb + lr * 4), NK = *(const float4*)(cb + 64 + lr * 4), KA = *(const float4*)(cb + 128 + lr * 4);
    float4 KK = *(const float4*)(cb + 192 + lr * 4), RR = *(const float4*)(cb + 256 + lr * 4);
    float v = cb[320 + irow];
#pragma unroll
    for (int s = 0; s < CH; ++s) {
      float4 W2, NK2, KA2, KK2, RR2; float v2;
      if (s + 1 < CH) {
        const float* nb2 = cb + (s + 1) * 384;
        W2 = *(const float4*)(nb2 + lr * 4); NK2 = *(const float4*)(nb2 + 64 + lr * 4); KA2 = *(const float4*)(nb2 + 128 + lr * 4);
        KK2 = *(const float4*)(nb2 + 192 + lr * 4); RR2 = *(const float4*)(nb2 + 256 + lr * 4); v2 = nb2[320 + irow];
      }
      f32x2s t = s01 * (f32x2s){NK.x, NK.y}; t = s23 * (f32x2s){NK.z, NK.w} + t;
      f32x2s vv = {v, v};
      f32x2s u01 = s01 * (f32x2s){W.x, W.y}; u01 = vv * (f32x2s){KK.x, KK.y} + u01;
      f32x2s u23 = s23 * (f32x2s){W.z, W.w}; u23 = vv * (f32x2s){KK.z, KK.w} + u23;
      const float sa = row16_sum(t.x + t.y);
      f32x2s sav = {sa, sa};
      s01 = sav * (f32x2s){KA.x, KA.y} + u01;
      s23 = sav * (f32x2s){KA.z, KA.w} + u23;
      f32x2s yy = s01 * (f32x2s){RR.x, RR.y}; yy = s23 * (f32x2s){RR.z, RR.w} + yy;
      const float y = row16_sum(yy.x + yy.y);
      ykeep = (lr == s) ? y : ykeep;
      if (s + 1 < CH) { W = W2; NK = NK2; KA = KA2; KK = KK2; RR = RR2; v = v2; }
    }
    Y[(size_t)(ch * CH + lr) * 256 + irow] = ykeep;
    if (ch + 1 < S / CH) {
      float* nb = buf + ((ch + 1) & 1) * CF;
      rwkv_stage_write(nb, st0, soff[0], sw[0]); rwkv_stage_write(nb, st1, soff[1], sw[1]); rwkv_stage_write(nb, st2, soff[2], sw[2]);
      if (t3) rwkv_stage_write(nb, st3, soff[3], sw[3]);
    }
    __syncthreads();
  }
}
DEV void rwkv_post_item(const Params& p, int l, int item) {
  const int lane = tid_() & 63, wv = tid_() >> 6;
  const float* RY = (const float*)(p.ws + O_RY);
  const bfu* RG = (const bfu*)(p.ws + O_RG);
  bfu* MIX = (bfu*)(p.ws + O_ACT);
  for (int k = 0; k < 64; ++k) {
    const int t = item * 64 + wv * 16 + (k >> 2), h = k & 3;
    const int b = t / S, tp = t & (S - 1);
    float y = RY[(size_t)t * 256 + h * 64 + lane];
    float mean = wave_sum(y) * (1.f / 64.f);
    float d = y - mean;
    float var = wave_sum(d * d) * (1.f / 64.f);
    const int ch = h * 64 + lane;
    float yn = d * rsqrtf(var + 64e-5f) * p.rwkv_ln_w[l * 256 + ch] + p.rwkv_ln_b[l * 256 + ch];
    const unsigned char* src = p.ws + O_RIN + ((size_t)(b * 4 + h) * S + tp) * 896;
    float k2 = bf2f(((const bfu*)(src + 512))[lane]), r_ = bf2f(((const bfu*)(src + 640))[lane]), v_ = bf2f(((const bfu*)(src + 768))[lane]);
    float bonus = wave_sum(r_ * k2 * p.rwkv_rk[l * 256 + ch]);
    float o = (yn + bonus * v_) * bf2f(RG[(size_t)t * 256 + ch]);
    MIX[(size_t)t * 1024 + 512 + ch] = f2bf(o);
  }
}
DEV void nsa_tr_item(const Params& p, int item) {
  const int which = item & 1, tt = (item >> 1) & 127, b = item >> 8;
  const int tid = tid_();
  const bfu* COLS = (const bfu*)(p.ws + O_COLS);
  bfu* dst = (bfu*)(p.ws + (which ? O_VWT : O_VST)) + (size_t)b * 64 * S;
  const int col0 = which ? C_VW : C_VS;
  bfu* tl = (bfu*)smem;
  __syncthreads();
  for (int i = tid; i < 64 * 32; i += NTHR) {
    int tok = i >> 5, dp = i & 31;
    unsigned u = *(const unsigned*)(COLS + (size_t)(b * S + tt * 64 + tok) * NIN + col0 + dp * 2);
    *(unsigned*)(tl + tok * 66 + dp * 2) = u;
  }
  __syncthreads();
  {
    const int d = tid >> 2, tq = (tid & 3) * 16;
    unsigned o[8];
#pragma unroll
    for (int i = 0; i < 8; ++i) o[i] = (unsigned)tl[(tq + i * 2) * 66 + d] | ((unsigned)tl[(tq + i * 2 + 1) * 66 + d] << 16);
    uint4* dp = (uint4*)(dst + (size_t)d * S + tt * 64 + tq);
    dp[0] = make_uint4(o[0], o[1], o[2], o[3]); dp[1] = make_uint4(o[4], o[5], o[6], o[7]);
  }
}
DEV void nsa_cmp_item(const Params& p, int l, int item) {
  const int mt = item & 31, b = (item >> 5) & 3, which = item >> 7;
  const int tid = tid_(), lane = tid & 63, wv = tid >> 6, lr = lane & 15, lq = lane >> 4;
  const bfu* COLS = (const bfu*)(p.ws + O_COLS);
  const unsigned char* wb = p.ws + O_W + (size_t)l * W_SZ;
  const bfu* w1T = (const bfu*)(wb + W_C1) + (size_t)which * 256 * 2048;
  const bfu* w2T = (const bfu*)(wb + W_C2) + (size_t)which * 64 * 256;
  const float* pos = p.nsa_cmp_pos + ((size_t)l * 2 + which) * 2048;
  const int col0 = which ? C_VC : C_KC;
  bfu* Hs = (bfu*)smem;
  int blk = mt * 16 + lr; if (blk > 510) blk = 510;
  const bfu* arow = COLS + (size_t)(b * S + blk * 16) * NIN + col0 + lq * 8;
  f32x4 acc[4];
#pragma unroll
  for (int j = 0; j < 4; ++j) acc[j] = (f32x4){0.f, 0.f, 0.f, 0.f};
  for (int ks = 0; ks < 64; ++ks) {
    uint4 u = *(const uint4*)(arow + (size_t)(ks >> 1) * NIN + (ks & 1) * 32);
    const float4* pp = (const float4*)(pos + ks * 32 + lq * 8);
    float4 p0 = pp[0], p1 = pp[1];
    float av[8] = {lo2f(u.x) + p0.x, hi2f(u.x) + p0.y, lo2f(u.y) + p0.z, hi2f(u.y) + p0.w, lo2f(u.z) + p1.x, hi2f(u.z) + p1.y, lo2f(u.w) + p1.z, hi2f(u.w) + p1.w};
    bf16x8 a = packf8(av);
#pragma unroll
    for (int j = 0; j < 4; ++j) acc[j] = mfma16(a, ld8(w1T + (size_t)(wv * 64 + j * 16 + lr) * 2048 + ks * 32 + lq * 8), acc[j]);
  }
  __syncthreads();
#pragma unroll
  for (int j = 0; j < 4; ++j)
#pragma unroll
    for (int r = 0; r < 4; ++r) Hs[(lq * 4 + r) * 264 + wv * 64 + j * 16 + lr] = f2bf(geluf_(acc[j][r]));
  __syncthreads();
  f32x4 o = {0.f, 0.f, 0.f, 0.f};
#pragma unroll
  for (int ks = 0; ks < 8; ++ks) o = mfma16(*(const bf16x8*)(Hs + lr * 264 + ks * 32 + lq * 8), ld8(w2T + (wv * 16 + lr) * 256 + ks * 32 + lq * 8), o);
#pragma unroll
  for (int r = 0; r < 4; ++r) {
    int bi = mt * 16 + lq * 4 + r, d = wv * 16 + lr;
    float v = (bi < 511) ? o[r] : 0.f;
    if (which == 0) ((bfu*)(p.ws + O_KCMP))[((size_t)b * 512 + bi) * 64 + d] = f2bf(v);
    else ((bfu*)(p.ws + O_VCT))[((size_t)b * 64 + d) * 512 + bi] = f2bf(v);
  }
}

struct AttnState { float m[4], l[4]; f32x4 O[4]; };
DEV void attn_init(AttnState& st) {
#pragma unroll
  for (int r = 0; r < 4; ++r) { st.m[r] = -1e30f; st.l[r] = 0.f; st.O[r] = (f32x4){0.f, 0.f, 0.f, 0.f}; }
}
struct KVF { bf16x8 k00, k01, k10, k11, v0, v1, v2, v3; };
DEV void attn_load(KVF& f, const bfu* kp0, const bfu* kp1, const bfu* vt, size_t vs16) {
  f.k00 = ld8(kp0); f.k01 = ld8(kp0 + 32); f.k10 = ld8(kp1); f.k11 = ld8(kp1 + 32);
  f.v0 = ld8(vt); f.v1 = ld8(vt + vs16); f.v2 = ld8(vt + 2 * vs16); f.v3 = ld8(vt + 3 * vs16);
}
constexpr float MREF = 12.f;
DEV void attn_compute(AttnState& st, const bf16x8* q, const KVF& f, float dist0, bool val0, float dist1, bool val1, bfu* pbuf, int lr, int lq) {
  f32x4 s0 = {0.f, 0.f, 0.f, 0.f}, s1 = {0.f, 0.f, 0.f, 0.f};
  s0 = mfma16(q[0], f.k00, s0); s0 = mfma16(q[1], f.k01, s0);
  s1 = mfma16(q[0], f.k10, s1); s1 = mfma16(q[1], f.k11, s1);
#pragma unroll
  for (int r = 0; r < 4; ++r) {
    const float slope = (r == 0) ? 0.25f : (r == 1) ? 0.0625f : (r == 2) ? 0.015625f : 0.00390625f;
    const float p0 = val0 ? __expf(s0[r] * 0.125f - slope * dist0 - MREF) : 0.f;
    const float p1 = val1 ? __expf(s1[r] * 0.125f - slope * dist1 - MREF) : 0.f;
    st.l[r] += p0 + p1;
    pbuf[(lq * 4 + r) * 40 + lr] = f2bf(p0); pbuf[(lq * 4 + r) * 40 + 16 + lr] = f2bf(p1);
  }
  bf16x8 pa = *(const bf16x8*)(pbuf + lr * 40 + lq * 8);
  st.O[0] = mfma16(pa, f.v0, st.O[0]); st.O[1] = mfma16(pa, f.v1, st.O[1]);
  st.O[2] = mfma16(pa, f.v2, st.O[2]); st.O[3] = mfma16(pa, f.v3, st.O[3]);
}
DEV float wave_maxf_u(float v) {
  v = row16_max(v);
  v = fmaxf(v, __int_as_float(__builtin_amdgcn_update_dpp(__float_as_int(-__builtin_inff()), __float_as_int(v), 0x142, 0xA, 0xF, false)));
  v = fmaxf(v, __int_as_float(__builtin_amdgcn_update_dpp(__float_as_int(-__builtin_inff()), __float_as_int(v), 0x143, 0xC, 0xF, false)));
  return __int_as_float(__builtin_amdgcn_readlane(__float_as_int(v), 63));
}
template <int CTRL> DEV int dppi(int v) { return __builtin_amdgcn_update_dpp(0, v, CTRL, 0xf, 0xf, true); }
DEV int wave_mini_u(int v) {
  v = min(v, dppi<0xB1>(v)); v = min(v, dppi<0x4E>(v)); v = min(v, dppi<0x141>(v)); v = min(v, dppi<0x140>(v));
  v = min(v, __builtin_amdgcn_update_dpp(0x7fffffff, v, 0x142, 0xA, 0xF, false));
  v = min(v, __builtin_amdgcn_update_dpp(0x7fffffff, v, 0x143, 0xC, 0xF, false));
  return __builtin_amdgcn_readlane(v, 63);
}

DEV void nsa_cmpattn_item(const Params& p, int item) {
  const int lane = tid_() & 63, wv = tid_() >> 6, lr = lane & 15, lq = lane >> 4;
  const bfu* COLS = (const bfu*)(p.ws + O_COLS);
  const int t0 = item * 16 + wv * 4;
  const int b = t0 / S, tp0 = t0 & (S - 1);
  const bfu* KC = (const bfu*)(p.ws + O_KCMP) + (size_t)b * 512 * 64;
  const bfu* VCT = (const bfu*)(p.ws + O_VCT) + (size_t)b * 64 * 512;
  bfu* pbuf = (bfu*)smem + wv * 640;
  float* ps = (float*)(smem + 5120) + wv * (4 * 516);
  bf16x8 q[2];
#pragma unroll
  for (int ks = 0; ks < 2; ++ks) q[ks] = ld8(COLS + (size_t)(t0 + (lr >> 2)) * NIN + C_Q + (lr & 3) * 64 + ks * 32 + lq * 8);
  const int pos = tp0 + lq;
  const int pmax = tp0 + 3;
  const int nvalid = (pmax >= 31) ? ((pmax - 31) >> 4) + 1 : 0;
  const int nkt = (nvalid + 31) >> 5;
  float z[4] = {0.f, 0.f, 0.f, 0.f};
  for (int kt = 0; kt < nkt; ++kt) {
    const int n0 = kt * 32 + lr, n1 = n0 + 16;
    f32x4 s0 = {0.f, 0.f, 0.f, 0.f}, s1 = {0.f, 0.f, 0.f, 0.f};
    s0 = mfma16(q[0], ld8(KC + n0 * 64 + lq * 8), s0); s0 = mfma16(q[1], ld8(KC + n0 * 64 + 32 + lq * 8), s0);
    s1 = mfma16(q[0], ld8(KC + n1 * 64 + lq * 8), s1); s1 = mfma16(q[1], ld8(KC + n1 * 64 + 32 + lq * 8), s1);
    const int d0 = pos - (16 * n0 + 31), d1 = pos - (16 * n1 + 31);
#pragma unroll
    for (int r = 0; r < 4; ++r) {
      const float slope = (r == 0) ? 0.25f : (r == 1) ? 0.0625f : (r == 2) ? 0.015625f : 0.00390625f;
      const float p0 = (d0 >= 0) ? __expf(s0[r] * 0.125f - slope * (float)d0 - MREF) : 0.f;
      const float p1 = (d1 >= 0) ? __expf(s1[r] * 0.125f - slope * (float)d1 - MREF) : 0.f;
      z[r] += p0 + p1;
    }
  }
  float iz[4];
#pragma unroll
  for (int r = 0; r < 4; ++r) iz[r] = 1.f / fmaxf(row16_sum(z[r]), 1e-30f);
  f32x4 O[4];
#pragma unroll
  for (int dt = 0; dt < 4; ++dt) O[dt] = (f32x4){0.f, 0.f, 0.f, 0.f};
  for (int kt = 0; kt < nkt; ++kt) {
    const int n0 = kt * 32 + lr, n1 = n0 + 16;
    f32x4 s0 = {0.f, 0.f, 0.f, 0.f}, s1 = {0.f, 0.f, 0.f, 0.f};
    s0 = mfma16(q[0], ld8(KC + n0 * 64 + lq * 8), s0); s0 = mfma16(q[1], ld8(KC + n0 * 64 + 32 + lq * 8), s0);
    s1 = mfma16(q[0], ld8(KC + n1 * 64 + lq * 8), s1); s1 = mfma16(q[1], ld8(KC + n1 * 64 + 32 + lq * 8), s1);
    const int d0 = pos - (16 * n0 + 31), d1 = pos - (16 * n1 + 31);
    float ps0 = 0.f, ps1 = 0.f;
#pragma unroll
    for (int r = 0; r < 4; ++r) {
      const float slope = (r == 0) ? 0.25f : (r == 1) ? 0.0625f : (r == 2) ? 0.015625f : 0.00390625f;
      float p0 = (d0 >= 0) ? __expf(s0[r] * 0.125f - slope * (float)d0 - MREF) * iz[r] : 0.f;
      float p1 = (d1 >= 0) ? __expf(s1[r] * 0.125f - slope * (float)d1 - MREF) * iz[r] : 0.f;
      ps0 += p0; ps1 += p1;
      pbuf[(lq * 4 + r) * 40 + lr] = f2bf(p0); pbuf[(lq * 4 + r) * 40 + 16 + lr] = f2bf(p1);
    }
    ps[lq * 516 + n0] = ps0; ps[lq * 516 + n1] = ps1;
    bf16x8 pa = *(const bf16x8*)(pbuf + lr * 40 + lq * 8);
#pragma unroll
    for (int dt = 0; dt < 4; ++dt) O[dt] = mfma16(pa, ld8(VCT + (size_t)(dt * 16 + lr) * 512 + kt * 32 + lq * 8), O[dt]);
  }
  bfu* OC = (bfu*)(p.ws + O_OCMP);
#pragma unroll
  for (int dt = 0; dt < 4; ++dt)
#pragma unroll
    for (int r = 0; r < 4; ++r) OC[(size_t)(t0 + lq) * 256 + r * 64 + dt * 16 + lr] = f2bf(O[dt][r]);
  const int nproc = nkt * 32;
  unsigned long long* SEL = (unsigned long long*)(p.ws + O_SEL);
  for (int tk = 0; tk < 4; ++tk) {
    const int tpos = tp0 + tk, cur = tpos >> 6;
    const float* pr = ps + tk * 516;
    float iv[2];
#pragma unroll
    for (int hh = 0; hh < 2; ++hh) {
      const int j = lane + hh * 64;
      float v = -__builtin_inff();
      if (j <= cur) {
        if (j == 0 || j == cur || j == cur - 1) v = 1e4f;
        else {
          float a = 0.f;
#pragma unroll
          for (int e = -1; e < 4; ++e) {
            int n = 4 * j + e;
            float w = (e == -1 || e == 3) ? 0.5f : 1.f;
            if (n >= 0 && n <= 510 && n < nproc) a += w * pr[n];
          }
          v = a;
        }
      }
      iv[hh] = v;
    }
    bool sel0 = false, sel1 = false;
    const int nsel = (cur + 1 < 16) ? cur + 1 : 16;
    for (int rd = 0; rd < nsel; ++rd) {
      float c0 = sel0 ? -__builtin_inff() : iv[0], c1 = sel1 ? -__builtin_inff() : iv[1];
      const float gm = wave_maxf_u(fmaxf(c0, c1));
      const int bi = wave_mini_u((c0 == gm) ? lane : ((c1 == gm) ? lane + 64 : 0x7fffffff));
      if (bi == lane) sel0 = true;
      if (bi == lane + 64) sel1 = true;
    }
    unsigned long long mlo = __ballot(sel0), mhi = __ballot(sel1);
    if (lane == 0) { SEL[(size_t)(t0 + tk) * 2] = mlo; SEL[(size_t)(t0 + tk) * 2 + 1] = mhi; }
  }
}

DEV void nsa_finish_item(const Params& p, int item) {
  const int lane = tid_() & 63, wv = tid_() >> 6, lr = lane & 15, lq = lane >> 4;
  const bfu* COLS = (const bfu*)(p.ws + O_COLS);
  const float* SIDE = (const float*)(p.ws + O_SIDE);
  const int t0 = item * 16 + wv * 4;
  const int b = t0 / S, tp0 = t0 & (S - 1);
  bfu* pbuf = (bfu*)smem + wv * 640;
  bf16x8 q[2];
#pragma unroll
  for (int ks = 0; ks < 2; ++ks) q[ks] = ld8(COLS + (size_t)(t0 + (lr >> 2)) * NIN + C_Q + (lr & 3) * 64 + ks * 32 + lq * 8);
  const int pos = tp0 + lq;
  const bfu* rowb = COLS + (size_t)b * S * NIN;
  AttnState sw; attn_init(sw);
  KVF cur, nxt;
  {
    const bfu* VT = (const bfu*)(p.ws + O_VWT) + (size_t)b * 64 * S;
    int kb = tp0 - 511; if (kb < 0) kb = 0; kb &= ~31;
    const int last = tp0 + 3;
    attn_load(cur, rowb + (size_t)(kb + lr) * NIN + C_KW + lq * 8, rowb + (size_t)(kb + 16 + lr) * NIN + C_KW + lq * 8, VT + (size_t)lr * S + kb + lq * 8, (size_t)16 * S);
    for (; kb <= last; kb += 32) {
      const bool more = kb + 32 <= last;
      const int kn = kb + 32;
      if (more) attn_load(nxt, rowb + (size_t)(kn + lr) * NIN + C_KW + lq * 8, rowb + (size_t)(kn + 16 + lr) * NIN + C_KW + lq * 8, VT + (size_t)lr * S + kn + lq * 8, (size_t)16 * S);
      const int d0 = pos - (kb + lr), d1 = d0 - 16;
      attn_compute(sw, q, cur, (float)d0, d0 >= 0 && d0 < 512, (float)d1, d1 >= 0 && d1 < 512, pbuf, lr, lq);
      if (more) cur = nxt;
    }
  }
  AttnState ss; attn_init(ss);
  {
    const bfu* VT = (const bfu*)(p.ws + O_VST) + (size_t)b * 64 * S;
    const unsigned long long* SEL = (const unsigned long long*)(p.ws + O_SEL);
    const unsigned long long mylo = SEL[(size_t)(t0 + lq) * 2], myhi = SEL[(size_t)(t0 + lq) * 2 + 1];
    unsigned long long ulo = 0, uhi = 0;
#pragma unroll
    for (int k = 0; k < 4; ++k) { ulo |= SEL[(size_t)(t0 + k) * 2]; uhi |= SEL[(size_t)(t0 + k) * 2 + 1]; }
    unsigned ul0 = __builtin_amdgcn_readfirstlane((unsigned)ulo), ul1 = __builtin_amdgcn_readfirstlane((unsigned)(ulo >> 32));
    unsigned uh0 = __builtin_amdgcn_readfirstlane((unsigned)uhi), uh1 = __builtin_amdgcn_readfirstlane((unsigned)(uhi >> 32));
    int j = -1, hb = 1;
    auto adv = [&]() -> bool {
      if (hb == 0) { hb = 1; return true; }
      hb = 0;
      if (ul0) { j = __builtin_ctz(ul0); ul0 &= ul0 - 1; return true; }
      if (ul1) { j = 32 + __builtin_ctz(ul1); ul1 &= ul1 - 1; return true; }
      if (uh0) { j = 64 + __builtin_ctz(uh0); uh0 &= uh0 - 1; return true; }
      if (uh1) { j = 96 + __builtin_ctz(uh1); uh1 &= uh1 - 1; return true; }
      return false;
    };
    bool ok = adv();
    if (ok) { const int kb = j * 64 + hb * 32; attn_load(cur, rowb + (size_t)(kb + lr) * NIN + C_KS + lq * 8, rowb + (size_t)(kb + 16 + lr) * NIN + C_KS + lq * 8, VT + (size_t)lr * S + kb + lq * 8, (size_t)16 * S); }
    while (ok) {
      const int cj = j, kb = j * 64 + hb * 32;
      const bool nk = adv();
      if (nk) { const int kn = j * 64 + hb * 32; attn_load(nxt, rowb + (size_t)(kn + lr) * NIN + C_KS + lq * 8, rowb + (size_t)(kn + 16 + lr) * NIN + C_KS + lq * 8, VT + (size_t)lr * S + kn + lq * 8, (size_t)16 * S); }
      const bool has = (((cj < 64) ? (mylo >> cj) : (myhi >> (cj - 64))) & 1ull) != 0;
      const int d0 = pos - (kb + lr), d1 = d0 - 16;
      attn_compute(ss, q, cur, (float)d0, has && d0 >= 0, (float)d1, has && d1 >= 0, pbuf, lr, lq);
      if (nk) cur = nxt;
      ok = nk;
    }
  }
  const bfu* OC = (const bfu*)(p.ws + O_OCMP);
  bfu* MIX = (bfu*)(p.ws + O_ACT);
  const int t = t0 + lq;
#pragma unroll
  for (int r = 0; r < 4; ++r) {
    const float g0 = sigmoidf_(SIDE[(size_t)t * 16 + 4 + r * 3]), g1 = sigmoidf_(SIDE[(size_t)t * 16 + 5 + r * 3]), g2 = sigmoidf_(SIDE[(size_t)t * 16 + 6 + r * 3]);
    const float is = g1 / fmaxf(row16_sum(ss.l[r]), 1e-30f), iw = g2 / fmaxf(row16_sum(sw.l[r]), 1e-30f);
#pragma unroll
    for (int dt = 0; dt < 4; ++dt) {
      const int ch = r * 64 + dt * 16 + lr;
      float o = g0 * bf2f(OC[(size_t)t * 256 + ch]) + is * ss.O[dt][r] + iw * sw.O[dt][r];
      MIX[(size_t)t * 1024 + 768 + ch] = f2bf(o);
    }
  }
}

DEV void phase_rwkv_prep(const Params& p, int l) {
  for (int it = bid_(); it < 512; it += gridDim.x) rwkv_prep_item(p, l, it);
}
DEV void sub_arrive(unsigned* bar) {
  asm volatile("s_waitcnt vmcnt(0)" ::: "memory");
  __syncthreads();
  if (tid_() == 0) { __threadfence(); atomicAdd(bar, 1u); }
}
DEV void sub_wait(unsigned* bar, unsigned target) {
  if (tid_() == 0) { while (__hip_atomic_load(bar, __ATOMIC_RELAXED, __HIP_MEMORY_SCOPE_AGENT) < target) __builtin_amdgcn_s_sleep(2); __threadfence(); }
  __syncthreads();
}
DEV void phase_mix_scan_finish(const Params& p, int l) {
  unsigned* barA = (unsigned*)(p.ws + O_SYNC) + l * 4;
  unsigned* barB = barA + 1;
  unsigned* que = barA + 2;
  const unsigned nothers = gridDim.x - 64;
  if (bid_() < 64) {
    __builtin_amdgcn_s_setprio(3);
    for (int rep = 0; rep < R_SCAN; ++rep) rwkv_scan_item(p, bid_());
    __builtin_amdgcn_s_setprio(0);
  } else {
    constexpr int P0 = 256, P1 = P0 + 1024, P2 = P1 + 2048, P3 = P2 + 1024;
    for (int it = bid_() - 64; it < P3; it += gridDim.x - 64) {
      if (it < P0) nsa_cmp_item(p, l, it);
      else if (it < P1) ssd_item<0>(p, l, it - P0);
      else if (it < P2) lru_item<0>(p, l, it - P1);
      else nsa_tr_item(p, it - P2);
    }
    sub_arrive(barA);
    sub_wait(barA, nothers);
    constexpr int N0 = 2048, N1 = N0 + 256, N2 = N1 + 4;
    for (int it = bid_() - 64; it < N2; it += gridDim.x - 64) {
      if (it < N0) { for (int rep = 0; rep < R_CMPA; ++rep) { __syncthreads(); nsa_cmpattn_item(p, it); } }
      else if (it < N1) ssd_rec_item(p, it - N0);
      else lru_carry_item(p, it - N1);
    }
    sub_arrive(barB);
  }
  sub_wait(barB, nothers);
  constexpr int M0 = 2048, M1 = M0 + 1024, M2 = M1 + 2048;
  for (;;) {
    __syncthreads();
    if (tid_() == 0) s_qitem = (int)atomicAdd(que, 1u);
    __syncthreads();
    const int it = s_qitem;
    if (it >= M2) break;
    for (int rep = 0; rep < R_FIN; ++rep) {
    if (it < M0) { __syncthreads(); nsa_finish_item(p, it); }
    else if (it < M1) ssd_item<1>(p, l, it - M0);
    else lru_item<1>(p, l, it - M1);
    }
  }
}
DEV void phase_rwkv_post(const Params& p, int l) {
  for (int it = bid_(); it < 512; it += gridDim.x) rwkv_post_item(p, l, it);
}

template <int CTRL> DEV int dppi_(int v) { return __builtin_amdgcn_update_dpp(0, v, CTRL, 0xf, 0xf, true); }
DEV int row16_mini(int v) { v = min(v, dppi_<0xB1>(v)); v = min(v, dppi_<0x4E>(v)); v = min(v, dppi_<0x141>(v)); v = min(v, dppi_<0x140>(v)); return v; }
DEV void phase_peer_topk(const Params& p, int l) {
  const bfu* Q = (const bfu*)(p.ws + O_PQ);
  const bfu* keys = (const bfu*)(p.ws + O_W + (size_t)l * W_SZ + W_KEYS);
  int* PE = (int*)(p.ws + O_PE); float* PG = (float*)(p.ws + O_PG);
  const int lane = tid_() & 63, wv = tid_() >> 6, lr = lane & 15, lq = lane >> 4;
  float* ps = (float*)smem + wv * 1024;
  int* pi = (int*)ps + 512;
  const float NINF = -__builtin_inff();
  int ca[4], cb[4]; bool cok[4];
#pragma unroll
  for (int sl = 0; sl < 4; ++sl) {
    int k = sl * 16 + lr, a = 0; bool ok = false;
    for (int aa = 0; aa < 16; ++aa) { int cnt = 16 / (aa + 1); if (!ok) { if (k < cnt) { ok = true; a = aa; } else k -= cnt; } }
    ca[sl] = a; cb[sl] = ok ? k : 0; cok[sl] = ok;
  }
  for (int item = bid_(); item < (T / 64) * 8; item += gridDim.x) {
    const int tt = item >> 3, hd = item & 7;
    const int t0 = tt * 64 + wv * 16;
    for (int c = 0; c < 2; ++c) {
      bf16x8 qa[4];
#pragma unroll
      for (int ks = 0; ks < 4; ++ks) qa[ks] = ld8(Q + (size_t)(t0 + lr) * 2048 + hd * 256 + c * 128 + ks * 32 + lq * 8);
      const bfu* kb = keys + (size_t)(hd * 2 + c) * 128 * 128;
      float v[4][8];
#pragma unroll
      for (int nt = 0; nt < 8; ++nt) {
        f32x4 a = {0.f, 0.f, 0.f, 0.f};
#pragma unroll
        for (int ks = 0; ks < 4; ++ks) a = mfma16(qa[ks], ld8(kb + (size_t)(nt * 16 + lr) * 128 + ks * 32 + lq * 8), a);
#pragma unroll
        for (int r = 0; r < 4; ++r) v[r][nt] = a[r];
      }
      float mys[4] = {0.f, 0.f, 0.f, 0.f}; int myi[4] = {0, 0, 0, 0};
      for (int rd = 0; rd < 16; ++rd) {
#pragma unroll
        for (int r = 0; r < 4; ++r) {
          float lm = fmaxf(fmaxf(fmaxf(v[r][0], v[r][1]), fmaxf(v[r][2], v[r][3])), fmaxf(fmaxf(v[r][4], v[r][5]), fmaxf(v[r][6], v[r][7])));
          const float gm = row16_max(lm);
          int cand = 0x7fffffff;
#pragma unroll
          for (int nt = 7; nt >= 0; --nt) cand = (v[r][nt] == gm) ? nt * 16 + lr : cand;
          const int bi = row16_mini(cand);
#pragma unroll
          for (int nt = 0; nt < 8; ++nt) v[r][nt] = (bi == nt * 16 + lr) ? NINF : v[r][nt];
          if (lr == rd) { mys[r] = gm; myi[r] = bi; }
        }
      }
#pragma unroll
      for (int r = 0; r < 4; ++r) { ps[c * 256 + (lq * 4 + r) * 16 + lr] = mys[r]; pi[c * 256 + (lq * 4 + r) * 16 + lr] = myi[r]; }
    }
    float cv[4][4];
#pragma unroll
    for (int r = 0; r < 4; ++r)
#pragma unroll
      for (int sl = 0; sl < 4; ++sl) {
        float sv = ps[(lq * 4 + r) * 16 + ca[sl]] + ps[256 + (lq * 4 + r) * 16 + cb[sl]];
        cv[r][sl] = cok[sl] ? sv : NINF;
      }
    float tops[4] = {0.f, 0.f, 0.f, 0.f}; int topf[4] = {0, 0, 0, 0};
    for (int rd = 0; rd < 16; ++rd) {
#pragma unroll
      for (int r = 0; r < 4; ++r) {
        const float gm = row16_max(fmaxf(fmaxf(cv[r][0], cv[r][1]), fmaxf(cv[r][2], cv[r][3])));
        int cand = 0x7fffffff;
#pragma unroll
        for (int sl = 0; sl < 4; ++sl) { int fl = ca[sl] * 16 + cb[sl]; cand = (cv[r][sl] == gm && fl < cand) ? fl : cand; }
        const int bi = row16_mini(cand);
#pragma unroll
        for (int sl = 0; sl < 4; ++sl) cv[r][sl] = (bi == ca[sl] * 16 + cb[sl]) ? NINF : cv[r][sl];
        if (lr == rd) { tops[r] = gm; topf[r] = bi; }
      }
    }
#pragma unroll
    for (int r = 0; r < 4; ++r) {
      const int row = lq * 4 + r;
      const float mx = row16_max(tops[r]);
      const float e = __expf(tops[r] - mx);
      const float den = row16_sum(e);
      const int a = topf[r] >> 4, bb = topf[r] & 15;
      const size_t o = (size_t)(t0 + row) * 128 + hd * 16 + lr;
      PE[o] = pi[row * 16 + a] * 128 + pi[256 + row * 16 + bb];
      PG[o] = e / den;
    }
  }
}

typedef float f32x2 __attribute__((ext_vector_type(2)));
DEV float wave_total(float v) {
  v = row16_sum(v);
  v += __int_as_float(__builtin_amdgcn_update_dpp(0, __float_as_int(v), 0x142, 0xA, 0xF, false));
  v += __int_as_float(__builtin_amdgcn_update_dpp(0, __float_as_int(v), 0x143, 0xC, 0xF, false));
  return __int_as_float(__builtin_amdgcn_readlane(__float_as_int(v), 63));
}
DEV float dot_fp8(uint4 u, const f32x2* x) {
  f32x2 acc = __builtin_amdgcn_cvt_pk_f32_fp8((int)u.x, false) * x[0];
  acc = __builtin_amdgcn_cvt_pk_f32_fp8((int)u.x, true) * x[1] + acc;
  acc = __builtin_amdgcn_cvt_pk_f32_fp8((int)u.y, false) * x[2] + acc;
  acc = __builtin_amdgcn_cvt_pk_f32_fp8((int)u.y, true) * x[3] + acc;
  acc = __builtin_amdgcn_cvt_pk_f32_fp8((int)u.z, false) * x[4] + acc;
  acc = __builtin_amdgcn_cvt_pk_f32_fp8((int)u.z, true) * x[5] + acc;
  acc = __builtin_amdgcn_cvt_pk_f32_fp8((int)u.w, false) * x[6] + acc;
  acc = __builtin_amdgcn_cvt_pk_f32_fp8((int)u.w, true) * x[7] + acc;
  return acc.x + acc.y;
}
DEV void axpy_fp8(uint4 v, float c, f32x2* y) {
  f32x2 cc = {c, c};
  y[0] = __builtin_amdgcn_cvt_pk_f32_fp8((int)v.x, false) * cc + y[0];
  y[1] = __builtin_amdgcn_cvt_pk_f32_fp8((int)v.x, true) * cc + y[1];
  y[2] = __builtin_amdgcn_cvt_pk_f32_fp8((int)v.y, false) * cc + y[2];
  y[3] = __builtin_amdgcn_cvt_pk_f32_fp8((int)v.y, true) * cc + y[3];
  y[4] = __builtin_amdgcn_cvt_pk_f32_fp8((int)v.z, false) * cc + y[4];
  y[5] = __builtin_amdgcn_cvt_pk_f32_fp8((int)v.z, true) * cc + y[5];
  y[6] = __builtin_amdgcn_cvt_pk_f32_fp8((int)v.w, false) * cc + y[6];
  y[7] = __builtin_amdgcn_cvt_pk_f32_fp8((int)v.w, true) * cc + y[7];
}
struct PBatch { uint4 u[4], v[4]; };
DEV void peer_load(PBatch& pb, const unsigned char* PU, const unsigned char* PV, int me0, int me1, int e, int lane) {
#pragma unroll
  for (int k = 0; k < 4; ++k) {
    int ee = e + k;
    int idx = __builtin_amdgcn_readlane((ee < 64) ? me0 : me1, ee & 63);
    pb.u[k] = *(const uint4*)(PU + (size_t)idx * 2048 + lane * 16);
    pb.v[k] = *(const uint4*)(PU + (size_t)idx * 2048 + 1024 + lane * 16);
  }
}
DEV void peer_compute(const PBatch& pb, const f32x2* x, f32x2* y, float mg0, float mg1, int e) {
  float d[4];
#pragma unroll
  for (int k = 0; k < 4; ++k) d[k] = dot_fp8(pb.u[k], x);
#pragma unroll
  for (int k = 0; k < 4; ++k) {
    int ee = e + k;
    float g = __int_as_float(__builtin_amdgcn_readlane(__float_as_int((ee < 64) ? mg0 : mg1), ee & 63));
    float act = wave_total(d[k]) * (1.f / PU_SCALE);
    axpy_fp8(pb.v[k], g * geluf_(act), y);
  }
}
DEV void phase_peer_gather(const Params& p, const float* gnext, bool last) {
  const bfu* XN = (const bfu*)(p.ws + O_ACT);
  const unsigned char* PU = p.ws + O_PU; const unsigned char* PV = p.ws + O_PV;
  const int* PE = (const int*)(p.ws + O_PE); const float* PG = (const float*)(p.ws + O_PG);
  const int lane = tid_() & 63, wv = tid_() >> 6;
  for (int t = bid_() * 4 + wv; t < T; t += gridDim.x * 4) {
    f32x2 x[8], y[8];
    {
      uint4 a = *(const uint4*)(XN + (size_t)t * D + lane * 16);
      uint4 b = *(const uint4*)(XN + (size_t)t * D + lane * 16 + 8);
      x[0] = (f32x2){lo2f(a.x), hi2f(a.x)}; x[1] = (f32x2){lo2f(a.y), hi2f(a.y)}; x[2] = (f32x2){lo2f(a.z), hi2f(a.z)}; x[3] = (f32x2){lo2f(a.w), hi2f(a.w)};
      x[4] = (f32x2){lo2f(b.x), hi2f(b.x)}; x[5] = (f32x2){lo2f(b.y), hi2f(b.y)}; x[6] = (f32x2){lo2f(b.z), hi2f(b.z)}; x[7] = (f32x2){lo2f(b.w), hi2f(b.w)};
    }
#pragma unroll
    for (int i = 0; i < 8; ++i) y[i] = (f32x2){0.f, 0.f};
    const int me0 = PE[(size_t)t * 128 + lane], me1 = PE[(size_t)t * 128 + 64 + lane];
    const float mg0 = PG[(size_t)t * 128 + lane], mg1 = PG[(size_t)t * 128 + 64 + lane];
    PBatch A, B;
    for (int rep = 0; rep < R_GATH; ++rep) {
#pragma unroll
    for (int i = 0; i < 8; ++i) y[i] = (f32x2){0.f, 0.f};
    peer_load(A, PU, PV, me0, me1, 0, lane);
    for (int e = 0; e < 128; e += 8) {
      peer_load(B, PU, PV, me0, me1, e + 4, lane);
      peer_compute(A, x, y, mg0, mg1, e);
      if (e + 8 < 128) peer_load(A, PU, PV, me0, me1, e + 8, lane);
      peer_compute(B, x, y, mg0, mg1, e + 4);
    }
    }
    float* hp = p.out + (size_t)t * D + lane * 16;
    float4 h0 = *(const float4*)(hp), h1 = *(const float4*)(hp + 4), h2 = *(const float4*)(hp + 8), h3 = *(const float4*)(hp + 12);
    float hv[16] = {h0.x, h0.y, h0.z, h0.w, h1.x, h1.y, h1.z, h1.w, h2.x, h2.y, h2.z, h2.w, h3.x, h3.y, h3.z, h3.w};
    float ss = 0.f;
#pragma unroll
    for (int i = 0; i < 8; ++i) {
      hv[i * 2] += y[i].x * (1.f / PV_SCALE); hv[i * 2 + 1] += y[i].y * (1.f / PV_SCALE);
      ss += hv[i * 2] * hv[i * 2] + hv[i * 2 + 1] * hv[i * 2 + 1];
    }
    ss = wave_total(ss);
    const float scl = rsqrtf(ss * (1.f / D) + 1e-6f);
    float gv[16];
    {
      const float* gp = gnext + lane * 16;
      float4 g0 = *(const float4*)(gp), g1 = *(const float4*)(gp + 4), g2 = *(const float4*)(gp + 8), g3 = *(const float4*)(gp + 12);
      float gt[16] = {g0.x, g0.y, g0.z, g0.w, g1.x, g1.y, g1.z, g1.w, g2.x, g2.y, g2.z, g2.w, g3.x, g3.y, g3.z, g3.w};
#pragma unroll
      for (int i = 0; i < 16; ++i) gv[i] = hv[i] * scl * gt[i];
    }
    if (last) {
      *(float4*)(hp) = make_float4(gv[0], gv[1], gv[2], gv[3]); *(float4*)(hp + 4) = make_float4(gv[4], gv[5], gv[6], gv[7]);
      *(float4*)(hp + 8) = make_float4(gv[8], gv[9], gv[10], gv[11]); *(float4*)(hp + 12) = make_float4(gv[12], gv[13], gv[14], gv[15]);
    } else {
      *(float4*)(hp) = make_float4(hv[0], hv[1], hv[2], hv[3]); *(float4*)(hp + 4) = make_float4(hv[4], hv[5], hv[6], hv[7]);
      *(float4*)(hp + 8) = make_float4(hv[8], hv[9], hv[10], hv[11]); *(float4*)(hp + 12) = make_float4(hv[12], hv[13], hv[14], hv[15]);
      bfu* up = (bfu*)(p.ws + O_ACT) + (size_t)t * D + lane * 16;
      *(uint4*)(up) = make_uint4(pack2(gv[0], gv[1]), pack2(gv[2], gv[3]), pack2(gv[4], gv[5]), pack2(gv[6], gv[7]));
      *(uint4*)(up + 8) = make_uint4(pack2(gv[8], gv[9]), pack2(gv[10], gv[11]), pack2(gv[12], gv[13]), pack2(gv[14], gv[15]));
    }
  }
}

#include <cstdint>
#define XB_TMO      128
#define XB_XCNT(j)  (256  + 64 * (j))
#define XB_XSUB(j)  (1280 + 64 * (j))
#define XB_XGEN(j)  (2304 + 64 * (j))
#define XB_TOP      3328
#define XB_TOPGEN   3392
#define XCD_BAR_WORDS 3456
#define XB_SPIN_CAP (1u << 18)
#define LAS __attribute__((address_space(3)))

__device__ __forceinline__ unsigned xb_ld(unsigned* p)              { return __hip_atomic_load(p, __ATOMIC_RELAXED, __HIP_MEMORY_SCOPE_AGENT); }
__device__ __forceinline__ unsigned xb_add(unsigned* p, unsigned v) { return __hip_atomic_fetch_add(p, v, __ATOMIC_RELAXED, __HIP_MEMORY_SCOPE_AGENT); }
__device__ __forceinline__ unsigned xb_xcc_id() { return (unsigned)__builtin_amdgcn_s_getreg((3 << 11) | 20) & 0xFu; }
#define XB_SPIN(cond, bar) do { unsigned _sp = 0; while (cond) { __builtin_amdgcn_s_sleep(1); \
    if ((++_sp & 255u) == 0u) { if (xb_ld(&(bar)[XB_TMO])) break; if (_sp > XB_SPIN_CAP) { atomicAdd(&(bar)[XB_TMO], 1u); break; } } } } while (0)

struct XcdBarrier {
    unsigned* bar; unsigned x;
    volatile LAS unsigned* st;
};

__device__ __forceinline__ XcdBarrier xcd_barrier_post(unsigned* bar, volatile LAS unsigned* st) {
    XcdBarrier b; b.bar = bar; b.x = xb_xcc_id(); b.st = st;
    if (threadIdx.x == 0) (void)xb_add(&bar[XB_XCNT(b.x)], 1u);
    return b;
}
__device__ __forceinline__ void xcd_barrier_complete(unsigned* bar, unsigned x, unsigned& nloc, unsigned& nx) {
    const unsigned G = gridDim.x * gridDim.y * gridDim.z;
    unsigned sum, cnt, mine, sp = 0u;
    for (;;) {
        sum = 0u; cnt = 0u; mine = 0u;
#pragma unroll
        for (unsigned j = 0; j < 16; ++j) { const unsigned c = xb_ld(&bar[XB_XCNT(j)]); sum += c; cnt += (c > 0u) ? 1u : 0u; mine = (j == x) ? c : mine; }
        if (sum == G) break;
        __builtin_amdgcn_s_sleep(1);
        if ((++sp & 255u) == 0u) { if (xb_ld(&bar[XB_TMO])) break; if (sp > XB_SPIN_CAP) { atomicAdd(&bar[XB_TMO], 1u); break; } }
    }
    nloc = mine > 0u ? mine : 1u; nx = cnt > 0u ? cnt : 1u;
}

__device__ __forceinline__ void xcd_barrier(const XcdBarrier& b) {
    asm volatile("s_waitcnt vmcnt(0)" ::: "memory");
    __syncthreads();
    if (threadIdx.x == 0) {
        unsigned* bar = b.bar;
        __builtin_amdgcn_s_waitcnt(0);
        unsigned nloc = b.st[0], nx = b.st[1];
        if (nloc == 0u) { xcd_barrier_complete(bar, b.x, nloc, nx); b.st[0] = nloc; b.st[1] = nx; }
        const unsigned old = xb_add(&bar[XB_XSUB(b.x)], 1u);
        const unsigned gen = old / nloc;
        if (old + 1u == (gen + 1u) * nloc) {
            __builtin_amdgcn_fence(__ATOMIC_RELEASE, "agent");
            asm volatile("s_waitcnt vmcnt(0)" ::: "memory");
            const unsigned og = xb_add(&bar[XB_TOP], 1u);
            const unsigned tg = og / nx;
            if (og + 1u == (tg + 1u) * nx) xb_add(&bar[XB_TOPGEN], 1u);
            else XB_SPIN(xb_ld(&bar[XB_TOPGEN]) == tg, bar);
            __builtin_amdgcn_fence(__ATOMIC_ACQUIRE, "agent");
            xb_add(&bar[XB_XGEN(b.x)], 1u);
            asm volatile("s_waitcnt vmcnt(0)" ::: "memory");
        } else {
            XB_SPIN(xb_ld(&bar[XB_XGEN(b.x)]) == gen, bar);
            __builtin_amdgcn_fence(__ATOMIC_ACQUIRE, "agent");
            asm volatile("s_waitcnt vmcnt(0)" ::: "memory");
        }
    }
    __syncthreads();
}

__shared__ uint4 xb_words;
DEV void seam_barrier(unsigned char* ws) {
  XcdBarrier b; b.bar = (unsigned*)(ws + O_XB); b.x = xb_xcc_id(); b.st = (volatile LAS unsigned*)&xb_words;
  xcd_barrier(b);
}

DEV void launder_all(Params& q) {
  const float** pp = (const float**)&q;
#pragma unroll
  for (int i = 0; i < 39; ++i) { const float* t = pp[i]; asm volatile("" : "+s"(t)); pp[i] = t; }
}
__global__ void __launch_bounds__(NTHR, 2) fwd_megakernel(Params p0) {
  cg::grid_group grid = cg::this_grid();
  int ph = 0;
  if (threadIdx.x == 0) xb_words = make_uint4(0u, 0u, 0u, 0u);
  __syncthreads();
#define PHASE(body) { if (ph >= p0.ph_lo && ph < p0.ph_hi) { Params q_ = p0; launder_all(q_); { const Params& p = q_; body; } \
    if (ph + 1 < p0.ph_hi) { if (ph == 0) { grid.sync(); (void)xcd_barrier_post((unsigned*)(q_.ws + O_XB), (volatile LAS unsigned*)&xb_words); } else seam_barrier(q_.ws); } } ++ph; }
  PHASE(phase_convert(p); phase_norm(p.x, p.mix_norm, (bfu*)(p.ws + O_ACT)))
  for (int l = 0; l < DEPTH; ++l) {
#define wb (p.ws + O_W + (size_t)l * W_SZ)
    PHASE(for (int rep = 0; rep < R_GEMM; ++rep) gemm_phase<0>((const bfu*)(p.ws + O_ACT), (const bfu*)(wb + W_IN), NIN, 1024, (bfu*)(p.ws + O_COLS), NIN, (float*)(p.ws + O_SIDE), nullptr, nullptr))
    PHASE(for (int rep = 0; rep < R_PREP; ++rep) phase_rwkv_prep(p, l))
    PHASE(phase_mix_scan_finish(p, l))
    PHASE(phase_rwkv_post(p, l))
    PHASE(gemm_phase<1>((const bfu*)(p.ws + O_ACT), (const bfu*)(wb + W_OUT), 1024, 1024, nullptr, 0, nullptr, l == 0 ? p.x : p.out, p.out); convert_peer_uv(p, l))
    PHASE(phase_norm(p.out, p.ffn_norm + (size_t)l * D, (bfu*)(p.ws + O_ACT)))
    PHASE(for (int rep = 0; rep < R_GEMM; ++rep) gemm_phase<2>((const bfu*)(p.ws + O_ACT), (const bfu*)(wb + W_Q), 2048, 1024, (bfu*)(p.ws + O_PQ), 2048, nullptr, nullptr, nullptr))
    PHASE(for (int rep = 0; rep < R_TOPK; ++rep) phase_peer_topk(p, l))
    PHASE(phase_peer_gather(p, l + 1 < DEPTH ? p.mix_norm + (size_t)(l + 1) * D : p.final_norm, l + 1 == DEPTH))
  }
}

extern "C" void kernel_launch(void* const* d_in, const int* in_sizes, int n_in, void* d_out, int out_size, void* d_ws, size_t ws_size,
                              hipStream_t stream) {
  static int grid_blocks = 0;
  if (!grid_blocks) {
    int dev = 0, cus = 0, per_cu = 0;
    hipGetDevice(&dev);
    hipDeviceGetAttribute(&cus, hipDeviceAttributeMultiprocessorCount, dev);
    hipOccupancyMaxActiveBlocksPerMultiprocessor(&per_cu, fwd_megakernel, NTHR, 0);
    if (per_cu > 2) per_cu = 2;
    grid_blocks = cus * per_cu;
  }
  Params p{};
  const float** pp = (const float**)&p;
  for (int i = 0; i < 37; ++i) pp[i] = (const float*)d_in[i];
  p.out = (float*)d_out; p.ws = (unsigned char*)d_ws; p.ph_lo = 0; p.ph_hi = 1000;
  void* args[] = {&p};
  hipError_t e = hipLaunchCooperativeKernel((void*)fwd_megakernel, dim3(grid_blocks), dim3(NTHR), args, 0, stream);
  if (e != hipSuccess) fprintf(stderr, "cooperative launch failed: %s (grid %d)\n", hipGetErrorString(e), grid_blocks);
}
```

```cpp
#include <hip/hip_runtime.h>
#include <hip/hip_bf16.h>
#include <hip/hip_cooperative_groups.h>
#include <cstdio>
namespace cg = cooperative_groups;

typedef unsigned short bfu;
using bf16x8 = __attribute__((ext_vector_type(8))) short;
using f32x4 = __attribute__((ext_vector_type(4))) float;

#define DEV __device__ __forceinline__

constexpr int Bsz = 4, S = 8192, T = Bsz * S, D = 1024, NIN = 2960, DEPTH = 2;
constexpr int C_SSM = 0, C_LRU = 772, C_RWKV = 1284, C_NSA = 2308;
constexpr int C_Z = 0, C_XBC = 256, C_DT = 768;
constexpr int C_LG = 772, C_LX = 1028;
constexpr int C_Q = 2308, C_KC = 2564, C_VC = 2628, C_KS = 2692, C_VS = 2756, C_KW = 2820, C_VW = 2884, C_GT = 2948;
constexpr int NCH = 128;
constexpr int NTHR = 256;
#ifndef R_GEMM
#define R_GEMM 1
#endif
#ifndef R_PREP
#define R_PREP 1
#endif
#ifndef R_SCAN
#define R_SCAN 1
#endif
#ifndef R_FIN
#define R_FIN 1
#endif
#ifndef R_TOPK
#define R_TOPK 1
#endif
#ifndef R_GATH
#define R_GATH 1
#endif
#ifndef R_CMPA
#define R_CMPA 1
#endif

constexpr size_t AL(size_t x) { return (x + 255) & ~(size_t)255; }
constexpr size_t O_ACT = 0;
constexpr size_t O_COLS = O_ACT + AL((size_t)T * 1024 * 2);
constexpr size_t O_SIDE = O_COLS + AL((size_t)T * NIN * 2);
constexpr size_t O_RIN = O_SIDE + AL((size_t)T * 16 * 4);
constexpr size_t O_RY = O_RIN + AL((size_t)16 * S * 896);
constexpr size_t O_RG = O_RY + AL((size_t)T * 256 * 4);
constexpr size_t O_SST = O_RG + AL((size_t)T * 256 * 2);
constexpr size_t O_SAT = O_SST + AL((size_t)16 * NCH * 4096 * 4);
constexpr size_t O_LA = O_SAT + AL((size_t)16 * NCH * 4);
constexpr size_t O_LH = O_LA + AL((size_t)4 * NCH * 256 * 4);
constexpr size_t O_KCMP = O_LH + AL((size_t)4 * NCH * 256 * 4);
constexpr size_t O_VCT = O_KCMP + AL((size_t)4 * 512 * 64 * 2);
constexpr size_t O_VWT = O_VCT + AL((size_t)4 * 512 * 64 * 2);
constexpr size_t O_VST = O_VWT + AL((size_t)4 * 64 * S * 2);
constexpr size_t O_OCMP = O_VST + AL((size_t)4 * 64 * S * 2);
constexpr size_t O_SEL = O_OCMP + AL((size_t)T * 256 * 2);
constexpr size_t O_SYNC = O_SEL + AL((size_t)T * 16);
constexpr size_t O_XB = O_SYNC + 256;
constexpr size_t O_W = O_XB + 16384;
constexpr size_t W_IN = 0;
constexpr size_t W_OUT = W_IN + AL((size_t)NIN * 1024 * 2);
constexpr size_t W_Q = W_OUT + AL((size_t)1024 * 1024 * 2);
constexpr size_t W_KEYS = W_Q + AL((size_t)2048 * 1024 * 2);
constexpr size_t W_C1 = W_KEYS + AL((size_t)16 * 128 * 128 * 2);
constexpr size_t W_C2 = W_C1 + AL((size_t)2 * 256 * 2048 * 2);
constexpr size_t W_LA = W_C2 + AL((size_t)2 * 64 * 256 * 2);
constexpr size_t W_LI = W_LA + AL((size_t)4 * 64 * 64 * 2);
constexpr size_t W_R2 = W_LI + AL((size_t)4 * 64 * 64 * 2);
constexpr size_t W_A2 = W_R2 + AL((size_t)256 * 64 * 2);
constexpr size_t W_G2 = W_A2 + AL((size_t)256 * 64 * 2);
constexpr size_t W_SZ = W_G2 + AL((size_t)256 * 128 * 2);
constexpr size_t O_END = O_W + 2 * W_SZ;
constexpr size_t O_PU = O_COLS;
constexpr size_t O_PV = O_PU + AL((size_t)16384 * 1024);
constexpr size_t O_PQ = O_PV + AL((size_t)16384 * 1024);
constexpr size_t O_PE = O_PQ + AL((size_t)T * 2048 * 2);
constexpr size_t O_PG = O_PE + AL((size_t)T * 128 * 4);
constexpr size_t O_PEND = O_PG + AL((size_t)T * 128 * 4);
static_assert(O_PEND <= O_RY, "peer scratch overlaps live buffers");
static_assert(O_END <= (size_t)536870912, "workspace too large");

struct Params {
  const float* x; const float* mix_norm; const float* w_in; const float* w_out;
  const float* ssm_conv_w; const float* ssm_conv_b; const float* ssm_dt_bias; const float* ssm_a_log; const float* ssm_d; const float* ssm_norm;
  const float* lru_conv_w; const float* lru_conv_b; const float* lru_wa; const float* lru_ba; const float* lru_wi; const float* lru_bi; const float* lru_lambda;
  const float* rwkv_mu; const float* rwkv_w0; const float* rwkv_w2; const float* rwkv_a0; const float* rwkv_a2; const float* rwkv_g2;
  const float* rwkv_kk; const float* rwkv_ka; const float* rwkv_rk; const float* rwkv_ln_w; const float* rwkv_ln_b;
  const float* nsa_cmp_pos; const float* nsa_cmp_w1; const float* nsa_cmp_w2;
  const float* ffn_norm; const float* peer_wq; const float* peer_keys; const float* peer_u; const float* peer_v; const float* final_norm;
  float* out; unsigned char* ws;
  int ph_lo, ph_hi;
};

DEV int tid_() { int t = threadIdx.x; asm volatile("" : "+v"(t)); return t; }
DEV int bid_() { int b = blockIdx.x; asm volatile("" : "+s"(b)); return b; }
DEV bfu f2bf(float f) { unsigned u = __float_as_uint(f); u += 0x7fffu + ((u >> 16) & 1u); return (bfu)(u >> 16); }
DEV float bf2f(bfu b) { return __uint_as_float(((unsigned)b) << 16); }
DEV unsigned pack2(float a, float b) { return (unsigned)f2bf(a) | ((unsigned)f2bf(b) << 16); }
DEV float lo2f(unsigned u) { return __uint_as_float(u << 16); }
DEV float hi2f(unsigned u) { return __uint_as_float(u & 0xffff0000u); }
DEV float sigmoidf_(float x) { return 1.f / (1.f + __expf(-x)); }
DEV float siluf_(float x) { return x / (1.f + __expf(-x)); }
DEV float softplusf_(float x) { return fmaxf(x, 0.f) + log1pf(__expf(-fabsf(x))); }
DEV float geluf_(float x) { float u = 0.7978845608028654f * (x + 0.044715f * x * x * x); return 0.5f * x * (1.f + tanhf(u)); }

template <int CTRL> DEV float dppf(float v) {
  return __int_as_float(__builtin_amdgcn_update_dpp(0, __float_as_int(v), CTRL, 0xf, 0xf, true));
}
DEV float row16_sum(float v) { v += dppf<0xB1>(v); v += dppf<0x4E>(v); v += dppf<0x141>(v); v += dppf<0x140>(v); return v; }
DEV float row16_max(float v) { v = fmaxf(v, dppf<0xB1>(v)); v = fmaxf(v, dppf<0x4E>(v)); v = fmaxf(v, dppf<0x141>(v)); v = fmaxf(v, dppf<0x140>(v)); return v; }
DEV float wave_sum(float v) { v = row16_sum(v); v += __shfl_xor(v, 16); v += __shfl_xor(v, 32); return v; }

DEV bf16x8 ld8(const bfu* p) { return *(const bf16x8*)p; }
DEV f32x4 mfma16(bf16x8 a, bf16x8 b, f32x4 c) { return __builtin_amdgcn_mfma_f32_16x16x32_bf16(a, b, c, 0, 0, 0); }

DEV void mfma16_acc(f32x4& c, bf16x8 a, bf16x8 b) { asm("v_mfma_f32_16x16x32_bf16 %0, %1, %2, %0" : "+a"(c) : "v"(a), "v"(b)); }
DEV void gld_async(bf16x8& v, const bfu* p) { asm volatile("global_load_dwordx4 %0, %1, off" : "=v"(v) : "v"(p) : "memory"); }
template <int N> DEV void gwait6(bf16x8& a0, bf16x8& a1, bf16x8& a2, bf16x8& a3, bf16x8& b0, bf16x8& b1) {
  asm volatile("s_waitcnt vmcnt(%6)" : "+v"(a0), "+v"(a1), "+v"(a2), "+v"(a3), "+v"(b0), "+v"(b1) : "n"(N) : "memory");
}
__shared__ __attribute__((aligned(16))) unsigned char smem[61440];
__shared__ int s_qitem;

DEV void transpose_tile(const float* src, bfu* dst, int R, int C, int tr, int tc) {
  float* tl = (float*)smem;
  int tid = tid_();
  __syncthreads();
  for (int i = tid; i < 4096; i += NTHR) {
    int r = i >> 6, c = i & 63;
    int gr = tr * 64 + r, gc = tc * 64 + c;
    tl[r * 65 + c] = (gr < R && gc < C) ? src[(size_t)gr * C + gc] : 0.f;
  }
  __syncthreads();
  for (int i = tid; i < 4096; i += NTHR) {
    int c = i >> 6, r = i & 63;
    int gr = tr * 64 + r, gc = tc * 64 + c;
    if (gr < R && gc < C) dst[(size_t)gc * R + gr] = f2bf(tl[r * 65 + c]);
  }
}
struct TJob { const float* src; bfu* dst; int R, C; };
DEV void phase_convert(const Params& p) {
  if (bid_() == 0) { if (tid_() < 64) ((unsigned*)(p.ws + O_SYNC))[tid_()] = 0u; for (int i = tid_(); i < 4096; i += NTHR) ((unsigned*)(p.ws + O_XB))[i] = 0u; }
  for (int l = 0; l < DEPTH; ++l) {
    unsigned char* wb = p.ws + O_W + (size_t)l * W_SZ;
    for (int j = 0; j < 20; ++j) {
      const float* src; bfu* dst; int R, C;
      if (j == 0) { src = p.w_in + (size_t)l * 1024 * NIN; dst = (bfu*)(wb + W_IN); R = 1024; C = NIN; }
      else if (j == 1) { src = p.w_out + (size_t)l * 1024 * 1024; dst = (bfu*)(wb + W_OUT); R = 1024; C = 1024; }
      else if (j == 2) { src = p.peer_wq + (size_t)l * 1024 * 2048; dst = (bfu*)(wb + W_Q); R = 1024; C = 2048; }
      else if (j < 5) { int k = j - 3; src = p.nsa_cmp_w1 + ((size_t)l * 2 + k) * 2048 * 256; dst = (bfu*)(wb + W_C1) + (size_t)k * 256 * 2048; R = 2048; C = 256; }
      else if (j < 7) { int k = j - 5; src = p.nsa_cmp_w2 + ((size_t)l * 2 + k) * 256 * 64; dst = (bfu*)(wb + W_C2) + (size_t)k * 64 * 256; R = 256; C = 64; }
      else if (j < 11) { int k = j - 7; src = p.lru_wa + ((size_t)l * 4 + k) * 4096; dst = (bfu*)(wb + W_LA) + k * 4096; R = 64; C = 64; }
      else if (j < 15) { int k = j - 11; src = p.lru_wi + ((size_t)l * 4 + k) * 4096; dst = (bfu*)(wb + W_LI) + k * 4096; R = 64; C = 64; }
      else if (j == 15) { src = p.rwkv_w2 + (size_t)l * 64 * 256; dst = (bfu*)(wb + W_R2); R = 64; C = 256; }
      else if (j == 16) { src = p.rwkv_a2 + (size_t)l * 64 * 256; dst = (bfu*)(wb + W_A2); R = 64; C = 256; }
      else if (j == 17) { src = p.rwkv_g2 + (size_t)l * 128 * 256; dst = (bfu*)(wb + W_G2); R = 128; C = 256; }
      else continue;
      int ntr = (R + 63) / 64, ntc = (C + 63) / 64;
      for (int t = bid_(); t < ntr * ntc; t += gridDim.x) transpose_tile(src, dst, R, C, t / ntc, t % ntc);
    }
    {
      const float* src = p.peer_keys + (size_t)l * 16 * 128 * 128; bfu* dst = (bfu*)(wb + W_KEYS);
      for (int i = bid_() * NTHR + tid_(); i < 16 * 128 * 128; i += gridDim.x * NTHR) dst[i] = f2bf(src[i]);
    }
  }
}
constexpr float PU_SCALE = 512.f, PV_SCALE = 128.f;
DEV unsigned pack_fp8x4(float a, float b, float c, float d, float sc) {
  a = fminf(fmaxf(a * sc, -448.f), 448.f); b = fminf(fmaxf(b * sc, -448.f), 448.f);
  c = fminf(fmaxf(c * sc, -448.f), 448.f); d = fminf(fmaxf(d * sc, -448.f), 448.f);
  int w = 0;
  w = __builtin_amdgcn_cvt_pk_fp8_f32(a, b, w, false);
  w = __builtin_amdgcn_cvt_pk_fp8_f32(c, d, w, true);
  return (unsigned)w;
}
DEV void convert_peer_uv(const Params& p, int l) {
  const float4* su = (const float4*)(p.peer_u + (size_t)l * 16384 * 1024);
  const float4* sv = (const float4*)(p.peer_v + (size_t)l * 16384 * 1024);
  uint4* duv = (uint4*)(p.ws + O_PU);
  const int n16 = 16384 * 1024 / 16;
  for (int i = bid_() * NTHR + tid_(); i < n16; i += gridDim.x * NTHR) {
    float4 a0 = su[i * 4], a1 = su[i * 4 + 1], a2 = su[i * 4 + 2], a3 = su[i * 4 + 3];
    duv[(i >> 6) * 128 + (i & 63)] = make_uint4(pack_fp8x4(a0.x, a0.y, a0.z, a0.w, PU_SCALE), pack_fp8x4(a1.x, a1.y, a1.z, a1.w, PU_SCALE),
                       pack_fp8x4(a2.x, a2.y, a2.z, a2.w, PU_SCALE), pack_fp8x4(a3.x, a3.y, a3.z, a3.w, PU_SCALE));
    float4 b0 = sv[i * 4], b1 = sv[i * 4 + 1], b2 = sv[i * 4 + 2], b3 = sv[i * 4 + 3];
    duv[(i >> 6) * 128 + 64 + (i & 63)] = make_uint4(pack_fp8x4(b0.x, b0.y, b0.z, b0.w, PV_SCALE), pack_fp8x4(b1.x, b1.y, b1.z, b1.w, PV_SCALE),
                       pack_fp8x4(b2.x, b2.y, b2.z, b2.w, PV_SCALE), pack_fp8x4(b3.x, b3.y, b3.z, b3.w, PV_SCALE));
  }
}

DEV void phase_norm(const float* h, const float* g, bfu* dst) {
  int lane = tid_() & 63, wv = tid_() >> 6;
  for (int t = bid_() * 4 + wv; t < T; t += gridDim.x * 4) {
    const float4* hp = (const float4*)(h + (size_t)t * D);
    float4 v[4]; float ss = 0.f;
#pragma unroll
    for (int i = 0; i < 4; ++i) { v[i] = hp[lane + i * 64]; ss += v[i].x * v[i].x + v[i].y * v[i].y + v[i].z * v[i].z + v[i].w * v[i].w; }
    ss = wave_sum(ss);
    float sc = rsqrtf(ss * (1.f / D) + 1e-6f);
#pragma unroll
    for (int i = 0; i < 4; ++i) {
      float4 gg = ((const float4*)g)[lane + i * 64];
      uint2 o = make_uint2(pack2(v[i].x * sc * gg.x, v[i].y * sc * gg.y), pack2(v[i].z * sc * gg.z, v[i].w * sc * gg.w));
      ((uint2*)(dst + (size_t)t * D))[lane + i * 64] = o;
    }
  }
}

template <int N> DEV void gwait4(bf16x8& a0, bf16x8& a1, bf16x8& b0, bf16x8& b1) {
  asm volatile("s_waitcnt vmcnt(%4)" : "+v"(a0), "+v"(a1), "+v"(b0), "+v"(b1) : "n"(N) : "memory");
}
template <int MODE>
DEV void gemm_phase(const bfu* __restrict__ A, const bfu* __restrict__ Bt, int N, int K,
                    bfu* __restrict__ Cb, int ldc, float* __restrict__ side, const float* __restrict__ hin, float* __restrict__ hout) {
  constexpr int STR = 32;
  constexpr int BUFE = 256 * STR;
  bfu* As = (bfu*)smem;
  bfu* Bs = As + 128 * STR;
  const int tid = tid_(), lane = tid & 63, wv = tid >> 6;
  const int wm = wv >> 1, wn = wv & 1;
  const int ntn = (N + 127) / 128, ntm = T / 128;
  const int lr = lane & 15, lq = lane >> 4;
  const int swz = (lq ^ ((0x1320 >> (((lr >> 2) & 3) * 4)) & 3)) * 8;
  const int bid = bid_();
  const bool xmap = (gridDim.x & 7) == 0;
  const int ns = (ntn >= 16) ? 2 : 1;
  const int xcd = bid & 7, nloc = xmap ? (int)(gridDim.x >> 3) : (int)gridDim.x;
  const int ntn_p = xmap ? ntn / ns : ntn, mstep = xmap ? 8 / ns : 1;
  const int xs = xmap ? xcd % ns : 0, xm = xmap ? xcd / ns : 0;
  const int ntile_x = xmap ? (ntm / mstep) * ntn_p : ntm * ntn;
  for (int u = xmap ? (bid >> 3) : bid; u < ntile_x; u += nloc) {
    const int tm = (u / ntn_p) * mstep + xm, tn = xs * ntn_p + (u % ntn_p);
    const int m0 = tm * 128, n0 = tn * 128;
    f32x4 acc[4][4];
#pragma unroll
    for (int i = 0; i < 4; ++i)
#pragma unroll
      for (int j = 0; j < 4; ++j) acc[i][j] = (f32x4){0.f, 0.f, 0.f, 0.f};
    const bfu* ap[2]; const bfu* bp[2]; int so[2];
#pragma unroll
    for (int i = 0; i < 2; ++i) {
      int c = tid + i * NTHR; int row = c >> 2, kc = c & 3;
      ap[i] = A + (size_t)(m0 + row) * K + kc * 8;
      so[i] = row * STR + ((kc ^ ((0x1320 >> (((row >> 2) & 3) * 4)) & 3)) * 8);
      int nr = n0 + row; if (nr > N - 1) nr = N - 1;
      bp[i] = Bt + (size_t)nr * K + kc * 8;
    }
    bf16x8 ra[2][2], rb[2][2];
    __syncthreads();
#pragma unroll
    for (int i = 0; i < 2; ++i) { *(bf16x8*)(As + so[i]) = ld8(ap[i]); *(bf16x8*)(Bs + so[i]) = ld8(bp[i]); }
#pragma unroll
    for (int q = 0; q < 2; ++q)
#pragma unroll
      for (int i = 0; i < 2; ++i) { gld_async(ra[q][i], ap[i] + (q + 1) * 32); gld_async(rb[q][i], bp[i] + (q + 1) * 32); }
    const int nst = K / 32;
    for (int st = 0; st < nst; st += 2) {
#pragma unroll
      for (int q = 0; q < 2; ++q) {
        const int sidx = st + q;
        const bfu* Ar = As + q * BUFE;
        const bfu* Br = Bs + q * BUFE;
        bfu* Aw = As + (q ^ 1) * BUFE;
        bfu* Bw = Bs + (q ^ 1) * BUFE;
        __syncthreads();
        bf16x8 af[4], bfr[4];
#pragma unroll
        for (int i = 0; i < 4; ++i) af[i] = *(const bf16x8*)(Ar + (wm * 64 + i * 16 + lr) * STR + swz);
#pragma unroll
        for (int j = 0; j < 4; ++j) bfr[j] = *(const bf16x8*)(Br + (wn * 64 + j * 16 + lr) * STR + swz);
        const int kn = (sidx + 3 < nst ? sidx + 3 : nst - 1) * 32;
        gwait4<4>(ra[q][0], ra[q][1], rb[q][0], rb[q][1]);
#pragma unroll
        for (int i = 0; i < 2; ++i) { *(bf16x8*)(Aw + so[i]) = ra[q][i]; *(bf16x8*)(Bw + so[i]) = rb[q][i]; }
#pragma unroll
        for (int i = 0; i < 2; ++i) { gld_async(ra[q][i], ap[i] + kn); gld_async(rb[q][i], bp[i] + kn); }
#pragma unroll
        for (int i = 0; i < 4; ++i)
#pragma unroll
          for (int j = 0; j < 4; ++j) mfma16_acc(acc[i][j], bfr[j], af[i]);
      }
    }
#pragma unroll
    for (int q = 0; q < 2; ++q) gwait4<0>(ra[q][0], ra[q][1], rb[q][0], rb[q][1]);
    asm volatile("s_nop 7\n\ts_nop 7\n\ts_nop 7" ::: "memory");
#pragma unroll
    for (int i = 0; i < 4; ++i) {
      const int row = m0 + wm * 64 + i * 16 + lr;
#pragma unroll
      for (int j = 0; j < 4; ++j) {
        const int col = n0 + wn * 64 + j * 16 + lq * 4;
        const f32x4 v = acc[i][j];
        if (MODE == 0) {
          if (col < N) {
            *(uint2*)(Cb + (size_t)row * ldc + col) = make_uint2(pack2(v[0], v[1]), pack2(v[2], v[3]));
            if (col == C_DT) *(float4*)(side + (size_t)row * 16) = make_float4(v[0], v[1], v[2], v[3]);
            if (col >= C_GT) *(float4*)(side + (size_t)row * 16 + 4 + (col - C_GT)) = make_float4(v[0], v[1], v[2], v[3]);
          }
        } else if (MODE == 1) {
          const size_t o = (size_t)row * D + col;
          const float4 h = *(const float4*)(hin + o);
          *(float4*)(hout + o) = make_float4(h.x + v[0], h.y + v[1], h.z + v[2], h.w + v[3]);
        } else {
          *(uint2*)(Cb + (size_t)row * ldc + col) = make_uint2(pack2(v[0], v[1]), pack2(v[2], v[3]));
        }
      }
    }
  }
}

template <int MODE>
DEV void ssd_item(const Params& p, int l, int item) {
  const int g = item & 1, c = (item >> 1) & 127, b = item >> 8;
  const int tid = tid_(), lane = tid & 63, wv = tid >> 6, lr = lane & 15, lq = lane >> 4;
  const bfu* COLS = (const bfu*)(p.ws + O_COLS);
  const float* SIDE = (const float*)(p.ws + O_SIDE);
  float* ST = (float*)(p.ws + O_SST);
  const int tb = b * S + c * 64;
  float* s_dt = (float*)smem;
  float* s_acs = s_dt + 128;
  bfu* XT = (bfu*)(smem + 1024);
  bfu* Bm = XT + 128 * 72;
  bfu* Cm = Bm + 64 * 72;
  bfu* Mw = Cm + 64 * 72 + wv * (16 * 72);
  __syncthreads();
  if (wv < 2) {
    int h = g * 2 + wv;
    float dtv = softplusf_(SIDE[(size_t)(tb + lane) * 16 + h] + p.ssm_dt_bias[l * 4 + h]);
    float s = -__expf(p.ssm_a_log[l * 4 + h]) * dtv;
    for (int o = 1; o < 64; o <<= 1) { float t = __shfl_up(s, o); if (lane >= o) s += t; }
    s_dt[wv * 64 + lane] = dtv; s_acs[wv * 64 + lane] = s;
  }
  __syncthreads();
  {
    const int cg8 = tid & 31, tg = tid >> 5;
    const int lc = cg8 * 8;
    const int xc = (lc < 128) ? (g * 128 + lc) : (lc < 192 ? 256 + g * 64 + (lc - 128) : 384 + g * 64 + (lc - 192));
    if (MODE == 1 || lc < 192) {
      float w[4][8], bias[8];
#pragma unroll
      for (int i = 0; i < 8; ++i) {
        bias[i] = p.ssm_conv_b[l * 512 + xc + i];
#pragma unroll
        for (int k = 0; k < 4; ++k) w[k][i] = p.ssm_conv_w[(l * 4 + k) * 512 + xc + i];
      }
      const int tl0 = tg * 8;
      float win[3][8];
      float outv[8][8];
#pragma unroll
      for (int rr = 0; rr < 11; ++rr) {
        int tl = tl0 - 3 + rr; int tpos = c * 64 + tl;
        float cur[8];
        if (tpos >= 0) {
          uint4 u = *(const uint4*)(COLS + (size_t)(b * S + tpos) * NIN + C_XBC + xc);
          cur[0] = lo2f(u.x); cur[1] = hi2f(u.x); cur[2] = lo2f(u.y); cur[3] = hi2f(u.y); cur[4] = lo2f(u.z); cur[5] = hi2f(u.z); cur[6] = lo2f(u.w); cur[7] = hi2f(u.w);
        } else {
#pragma unroll
          for (int i = 0; i < 8; ++i) cur[i] = 0.f;
        }
        if (rr >= 3) {
#pragma unroll
          for (int i = 0; i < 8; ++i) {
            float a = bias[i] + w[0][i] * win[0][i] + w[1][i] * win[1][i] + w[2][i] * win[2][i] + w[3][i] * cur[i];
            outv[rr - 3][i] = siluf_(a);
          }
        }
#pragma unroll
        for (int i = 0; i < 8; ++i) { win[0][i] = win[1][i]; win[1][i] = win[2][i]; win[2][i] = cur[i]; }
      }
      if (lc < 128) {
        const int hh = lc >> 6;
        float sc[8];
#pragma unroll
        for (int j = 0; j < 8; ++j) {
          float d = s_dt[hh * 64 + tl0 + j];
          if (MODE == 0) d *= __expf(s_acs[hh * 64 + 63] - s_acs[hh * 64 + tl0 + j]);
          sc[j] = d;
        }
#pragma unroll
        for (int i = 0; i < 8; ++i) {
          uint4 o = make_uint4(pack2(outv[0][i] * sc[0], outv[1][i] * sc[1]), pack2(outv[2][i] * sc[2], outv[3][i] * sc[3]),
                               pack2(outv[4][i] * sc[4], outv[5][i] * sc[5]), pack2(outv[6][i] * sc[6], outv[7][i] * sc[7]));
          *(uint4*)(XT + (lc + i) * 72 + tl0) = o;
        }
      } else if (lc < 192) {
        if (MODE == 0) {
#pragma unroll
          for (int i = 0; i < 8; ++i) {
            uint4 o = make_uint4(pack2(outv[0][i], outv[1][i]), pack2(outv[2][i], outv[3][i]), pack2(outv[4][i], outv[5][i]), pack2(outv[6][i], outv[7][i]));
            *(uint4*)(Bm + (lc - 128 + i) * 72 + tl0) = o;
          }
        } else {
#pragma unroll
          for (int j = 0; j < 8; ++j) {
            uint4 o = make_uint4(pack2(outv[j][0], outv[j][1]), pack2(outv[j][2], outv[j][3]), pack2(outv[j][4], outv[j][5]), pack2(outv[j][6], outv[j][7]));
            *(uint4*)(Bm + (tl0 + j) * 72 + (lc - 128)) = o;
          }
        }
      } else {
#pragma unroll
        for (int j = 0; j < 8; ++j) {
          uint4 o = make_uint4(pack2(outv[j][0], outv[j][1]), pack2(outv[j][2], outv[j][3]), pack2(outv[j][4], outv[j][5]), pack2(outv[j][6], outv[j][7]));
          *(uint4*)(Cm + (tl0 + j) * 72 + (lc - 192)) = o;
        }
      }
    }
  }
  __syncthreads();
  if (MODE == 0) {
    const int hh = wv >> 1, ph = wv & 1, h = g * 2 + hh;
    f32x4 acc[2][4];
#pragma unroll
    for (int i = 0; i < 2; ++i)
#pragma unroll
      for (int j = 0; j < 4; ++j) acc[i][j] = (f32x4){0.f, 0.f, 0.f, 0.f};
#pragma unroll
    for (int ks = 0; ks < 2; ++ks) {
      bf16x8 af[2], bfr[4];
#pragma unroll
      for (int i = 0; i < 2; ++i) af[i] = *(const bf16x8*)(XT + (hh * 64 + ph * 32 + i * 16 + lr) * 72 + ks * 32 + lq * 8);
#pragma unroll
      for (int j = 0; j < 4; ++j) bfr[j] = *(const bf16x8*)(Bm + (j * 16 + lr) * 72 + ks * 32 + lq * 8);
#pragma unroll
      for (int i = 0; i < 2; ++i)
#pragma unroll
        for (int j = 0; j < 4; ++j) acc[i][j] = mfma16(af[i], bfr[j], acc[i][j]);
    }
    float* dst = ST + ((size_t)((b * 4 + h) * NCH + c)) * 4096;
#pragma unroll
    for (int i = 0; i < 2; ++i)
#pragma unroll
      for (int j = 0; j < 4; ++j)
#pragma unroll
        for (int r = 0; r < 4; ++r) dst[(ph * 32 + i * 16 + lq * 4 + r) * 64 + j * 16 + lr] = acc[i][j][r];
    if (tid < 2) ((float*)(p.ws + O_SAT))[(b * 4 + g * 2 + tid) * NCH + c] = s_acs[tid * 64 + 63];
  } else {
    bf16x8 cf[2];
#pragma unroll
    for (int ks = 0; ks < 2; ++ks) cf[ks] = *(const bf16x8*)(Cm + (wv * 16 + lr) * 72 + ks * 32 + lq * 8);
    f32x4 G[4];
#pragma unroll
    for (int st = 0; st < 4; ++st) {
      G[st] = (f32x4){0.f, 0.f, 0.f, 0.f};
      if (st <= wv) {
#pragma unroll
        for (int ks = 0; ks < 2; ++ks) G[st] = mfma16(cf[ks], *(const bf16x8*)(Bm + (st * 16 + lr) * 72 + ks * 32 + lq * 8), G[st]);
      }
    }
    f32x4 Y[2][4];
#pragma unroll
    for (int hh = 0; hh < 2; ++hh) {
      const int h = g * 2 + hh;
      const float* Hs = ST + ((size_t)((b * 4 + h) * NCH + c)) * 4096;
      float al[4];
#pragma unroll
      for (int r = 0; r < 4; ++r) al[r] = s_acs[hh * 64 + wv * 16 + lq * 4 + r];
#pragma unroll
      for (int pt = 0; pt < 4; ++pt) {
        f32x4 y = {0.f, 0.f, 0.f, 0.f};
#pragma unroll
        for (int ks = 0; ks < 2; ++ks) {
          const float4* hp = (const float4*)(Hs + (pt * 16 + lr) * 64 + ks * 32 + lq * 8);
          float4 h0 = hp[0], h1 = hp[1];
          bf16x8 hb;
          unsigned u0 = pack2(h0.x, h0.y), u1 = pack2(h0.z, h0.w), u2 = pack2(h1.x, h1.y), u3 = pack2(h1.z, h1.w);
          hb[0] = (short)(u0 & 0xffff); hb[1] = (short)(u0 >> 16); hb[2] = (short)(u1 & 0xffff); hb[3] = (short)(u1 >> 16);
          hb[4] = (short)(u2 & 0xffff); hb[5] = (short)(u2 >> 16); hb[6] = (short)(u3 & 0xffff); hb[7] = (short)(u3 >> 16);
          y = mfma16(cf[ks], hb, y);
        }
#pragma unroll
        for (int r = 0; r < 4; ++r) y[r] *= __expf(al[r]);
        Y[hh][pt] = y;
      }
#pragma unroll
      for (int st = 0; st < 4; ++st) {
        float as = s_acs[hh * 64 + st * 16 + lr];
#pragma unroll
        for (int r = 0; r < 4; ++r) {
          int ll = wv * 16 + lq * 4 + r, ss = st * 16 + lr;
          float m = (ss <= ll) ? G[st][r] * __expf(al[r] - as) : 0.f;
          Mw[(lq * 4 + r) * 72 + st * 16 + lr] = f2bf(m);
        }
      }
      for (int ks = 0; ks <= (wv >> 1); ++ks) {
        bf16x8 ma = *(const bf16x8*)(Mw + lr * 72 + ks * 32 + lq * 8);
#pragma unroll
        for (int pt = 0; pt < 4; ++pt)
          Y[hh][pt] = mfma16(ma, *(const bf16x8*)(XT + (hh * 64 + pt * 16 + lr) * 72 + ks * 32 + lq * 8), Y[hh][pt]);
      }
    }
    float ssq[4] = {0.f, 0.f, 0.f, 0.f};
#pragma unroll
    for (int hh = 0; hh < 2; ++hh) {
      const int h = g * 2 + hh;
      const float dsk = p.ssm_d[l * 4 + h];
#pragma unroll
      for (int pt = 0; pt < 4; ++pt)
#pragma unroll
        for (int r = 0; r < 4; ++r) {
          int ll = wv * 16 + lq * 4 + r, pch = pt * 16 + lr;
          float xs = bf2f(XT[(hh * 64 + pch) * 72 + ll]) / s_dt[hh * 64 + ll];
          float z = bf2f(COLS[(size_t)(tb + ll) * NIN + C_Z + h * 64 + pch]);
          float y = (Y[hh][pt][r] + dsk * xs) * siluf_(z);
          Y[hh][pt][r] = y; ssq[r] += y * y;
        }
    }
    bfu* MIX = (bfu*)(p.ws + O_ACT);
#pragma unroll
    for (int r = 0; r < 4; ++r) {
      float sc = rsqrtf(row16_sum(ssq[r]) * (1.f / 128.f) + 1e-6f);
      int ll = wv * 16 + lq * 4 + r;
#pragma unroll
      for (int hh = 0; hh < 2; ++hh)
#pragma unroll
        for (int pt = 0; pt < 4; ++pt) {
          int ch = (g * 2 + hh) * 64 + pt * 16 + lr;
          MIX[(size_t)(tb + ll) * 1024 + ch] = f2bf(Y[hh][pt][r] * sc * p.ssm_norm[l * 256 + ch]);
        }
    }
  }
}
DEV void ssd_rec_item(const Params& p, int item) {
  const int bh = item >> 4, e = (item & 15) * 256 + tid_();
  float* ST = (float*)(p.ws + O_SST) + (size_t)bh * NCH * 4096 + e;
  const float* AT = (const float*)(p.ws + O_SAT) + bh * NCH;
  float H = 0.f;
  for (int c0 = 0; c0 < NCH; c0 += 8) {
    float s[8];
#pragma unroll
    for (int i = 0; i < 8; ++i) s[i] = ST[(size_t)(c0 + i) * 4096];
#pragma unroll
    for (int i = 0; i < 8; ++i) { ST[(size_t)(c0 + i) * 4096] = H; H = __expf(AT[c0 + i]) * H + s[i]; }
  }
}

template <int MODE>
DEV void lru_item(const Params& p, int l, int item) {
  const int hb = item & 3, c = (item >> 2) & 127, b = item >> 9;
  const int tid = tid_(), lane = tid & 63, wv = tid >> 6, lr = lane & 15, lq = lane >> 4;
  const bfu* COLS = (const bfu*)(p.ws + O_COLS);
  const int tb = b * S + c * 64;
  bfu* Xl = (bfu*)smem;
  float* Af = (float*)(smem + 9216);
  float* Uf = Af + 4096;
  __syncthreads();
  {
    const int cg8 = tid & 7, tg = tid >> 3;
    const int ch = hb * 64 + cg8 * 8;
    float w[4][8], bias[8];
#pragma unroll
    for (int i = 0; i < 8; ++i) {
      bias[i] = p.lru_conv_b[l * 256 + ch + i];
#pragma unroll
      for (int k = 0; k < 4; ++k) w[k][i] = p.lru_conv_w[(l * 4 + k) * 256 + ch + i];
    }
    float win[3][8];
#pragma unroll
    for (int rr = 0; rr < 5; ++rr) {
      int tl = tg * 2 - 3 + rr; int tpos = c * 64 + tl;
      float cur[8];
      if (tpos >= 0) {
        uint4 u = *(const uint4*)(COLS + (size_t)(b * S + tpos) * NIN + C_LX + ch);
        cur[0] = lo2f(u.x); cur[1] = hi2f(u.x); cur[2] = lo2f(u.y); cur[3] = hi2f(u.y); cur[4] = lo2f(u.z); cur[5] = hi2f(u.z); cur[6] = lo2f(u.w); cur[7] = hi2f(u.w);
      } else {
#pragma unroll
        for (int i = 0; i < 8; ++i) cur[i] = 0.f;
      }
      if (rr >= 3) {
        float o[8];
#pragma unroll
        for (int i = 0; i < 8; ++i) o[i] = bias[i] + w[0][i] * win[0][i] + w[1][i] * win[1][i] + w[2][i] * win[2][i] + w[3][i] * cur[i];
        *(uint4*)(Xl + tl * 72 + cg8 * 8) = make_uint4(pack2(o[0], o[1]), pack2(o[2], o[3]), pack2(o[4], o[5]), pack2(o[6], o[7]));
        *(float4*)(Uf + tl * 64 + cg8 * 8) = make_float4(o[0], o[1], o[2], o[3]);
        *(float4*)(Uf + tl * 64 + cg8 * 8 + 4) = make_float4(o[4], o[5], o[6], o[7]);
      }
#pragma unroll
      for (int i = 0; i < 8; ++i) { win[0][i] = win[1][i]; win[1][i] = win[2][i]; win[2][i] = cur[i]; }
    }
  }
  __syncthreads();
  {
    const bfu* waT = (const bfu*)(p.ws + O_W + (size_t)l * W_SZ + W_LA) + hb * 4096;
    const bfu* wiT = (const bfu*)(p.ws + O_W + (size_t)l * W_SZ + W_LI) + hb * 4096;
    bf16x8 xa[2];
#pragma unroll
    for (int ks = 0; ks < 2; ++ks) xa[ks] = *(const bf16x8*)(Xl + (wv * 16 + lr) * 72 + ks * 32 + lq * 8);
#pragma unroll
    for (int jt = 0; jt < 4; ++jt) {
      f32x4 R = {0.f, 0.f, 0.f, 0.f}, I = {0.f, 0.f, 0.f, 0.f};
#pragma unroll
      for (int ks = 0; ks < 2; ++ks) {
        R = mfma16(xa[ks], ld8(waT + (jt * 16 + lr) * 64 + ks * 32 + lq * 8), R);
        I = mfma16(xa[ks], ld8(wiT + (jt * 16 + lr) * 64 + ks * 32 + lq * 8), I);
      }
      const int j = jt * 16 + lr, ch = hb * 64 + j;
      const float ba = p.lru_ba[l * 256 + ch], bi = p.lru_bi[l * 256 + ch];
      const float lsl = -softplusf_(-p.lru_lambda[l * 256 + ch]);
#pragma unroll
      for (int r = 0; r < 4; ++r) {
        int ll = wv * 16 + lq * 4 + r;
        float rg = sigmoidf_(R[r] + ba), ig = sigmoidf_(I[r] + bi);
        float la = 8.f * rg * lsl;
        float a = __expf(la);
        float xb = Uf[ll * 64 + j];
        float u = sqrtf(-expm1f(2.f * la)) * ig * xb;
        Af[ll * 64 + j] = a; Uf[ll * 64 + j] = u;
      }
    }
  }
  __syncthreads();
  const size_t sidx = (size_t)(b * NCH + c) * 256 + hb * 64;
  if (wv == 0) {
    if (MODE == 0) {
      float A = 1.f, h = 0.f;
      for (int t = 0; t < 64; ++t) { float a = Af[t * 64 + lane]; h = a * h + Uf[t * 64 + lane]; A *= a; }
      ((float*)(p.ws + O_LA))[sidx + lane] = A; ((float*)(p.ws + O_LH))[sidx + lane] = h;
    } else {
      float h = ((const float*)(p.ws + O_LH))[sidx + lane];
      for (int t = 0; t < 64; ++t) { h = Af[t * 64 + lane] * h + Uf[t * 64 + lane]; Uf[t * 64 + lane] = h; }
    }
  }
  if (MODE == 1) {
    __syncthreads();
    const int ll = tid >> 2, jq = (tid & 3) * 16;
    bfu* MIX = (bfu*)(p.ws + O_ACT) + (size_t)(tb + ll) * 1024 + 256 + hb * 64 + jq;
    const bfu* gp = COLS + (size_t)(tb + ll) * NIN + C_LG + hb * 64 + jq;
    unsigned ov[8];
#pragma unroll
    for (int i = 0; i < 8; ++i) {
      unsigned gu = *(const unsigned*)(gp + i * 2);
      float y0 = Uf[ll * 64 + jq + i * 2] * geluf_(lo2f(gu)), y1 = Uf[ll * 64 + jq + i * 2 + 1] * geluf_(hi2f(gu));
      ov[i] = pack2(y0, y1);
    }
    *(uint4*)MIX = make_uint4(ov[0], ov[1], ov[2], ov[3]);
    *(uint4*)(MIX + 8) = make_uint4(ov[4], ov[5], ov[6], ov[7]);
  }
}
DEV void lru_carry_item(const Params& p, int item) {
  const int i = item * 256 + tid_();
  const int b = i >> 8, ch = i & 255;
  const float* LA = (const float*)(p.ws + O_LA) + (size_t)b * NCH * 256 + ch;
  float* LH = (float*)(p.ws + O_LH) + (size_t)b * NCH * 256 + ch;
  float H = 0.f;
  for (int c = 0; c < NCH; ++c) { float A = LA[c * 256], he = LH[c * 256]; LH[c * 256] = H; H = A * H + he; }
}
DEV void shifted8(const bfu* COLS, const float* mu, int t, int col, float* out) {
  uint4 u = *(const uint4*)(COLS + (size_t)t * NIN + C_RWKV + col);
  float c[8] = {lo2f(u.x), hi2f(u.x), lo2f(u.y), hi2f(u.y), lo2f(u.z), hi2f(u.z), lo2f(u.w), hi2f(u.w)};
  float pv[8] = {0.f, 0.f, 0.f, 0.f, 0.f, 0.f, 0.f, 0.f};
  if ((t & (S - 1)) != 0) {
    uint4 q = *(const uint4*)(COLS + (size_t)(t - 1) * NIN + C_RWKV + col);
    pv[0] = lo2f(q.x); pv[1] = hi2f(q.x); pv[2] = lo2f(q.y); pv[3] = hi2f(q.y); pv[4] = lo2f(q.z); pv[5] = hi2f(q.z); pv[6] = lo2f(q.w); pv[7] = hi2f(q.w);
  }
#pragma unroll
  for (int i = 0; i < 8; ++i) out[i] = c[i] + (pv[i] - c[i]) * mu[col + i];
}
DEV float shifted1(const bfu* COLS, const float* mu, int t, int col) {
  float c = bf2f(COLS[(size_t)t * NIN + C_RWKV + col]);
  float pv = ((t & (S - 1)) != 0) ? bf2f(COLS[(size_t)(t - 1) * NIN + C_RWKV + col]) : 0.f;
  return c + (pv - c) * mu[col];
}
DEV bf16x8 packf8(const float* v) {
  bf16x8 o;
#pragma unroll
  for (int i = 0; i < 8; ++i) o[i] = (short)f2bf(v[i]);
  return o;
}
DEV void rwkv_prep_item(const Params& p, int l, int item) {
  const int lane = tid_() & 63, wv = tid_() >> 6, lr = lane & 15, lq = lane >> 4;
  const bfu* COLS = (const bfu*)(p.ws + O_COLS);
  const float* mu = p.rwkv_mu + l * 1024;
  const int t0 = item * 64 + wv * 16;
  const unsigned char* wb = p.ws + O_W + (size_t)l * W_SZ;
  const bfu* w2T = (const bfu*)(wb + W_R2); const bfu* a2T = (const bfu*)(wb + W_A2); const bfu* g2T = (const bfu*)(wb + W_G2);
  bf16x8 wdA[2], adA[2], gdA[4];
  {
    float tmp[8];
#pragma unroll
    for (int ks = 0; ks < 2; ++ks) {
      shifted8(COLS, mu, t0 + lr, 768 + ks * 32 + lq * 8, tmp);
#pragma unroll
      for (int i = 0; i < 8; ++i) tmp[i] = tanhf(tmp[i]);
      wdA[ks] = packf8(tmp);
      shifted8(COLS, mu, t0 + lr, 832 + ks * 32 + lq * 8, tmp);
      adA[ks] = packf8(tmp);
    }
#pragma unroll
    for (int ks = 0; ks < 4; ++ks) {
      shifted8(COLS, mu, t0 + lr, 896 + ks * 32 + lq * 8, tmp);
#pragma unroll
      for (int i = 0; i < 8; ++i) tmp[i] = sigmoidf_(tmp[i]);
      gdA[ks] = packf8(tmp);
    }
  }
  const int b = t0 / S;
  bfu* RG = (bfu*)(p.ws + O_RG);
  for (int hd = 0; hd < 4; ++hd) {
    float kkv[4][4], av[4][4], k2v[4][4], rv[4][4], vv[4][4], wv_[4][4];
    float ss[4] = {0.f, 0.f, 0.f, 0.f};
#pragma unroll
    for (int q = 0; q < 4; ++q) {
      const int nt = hd * 4 + q, n = nt * 16 + lr;
      f32x4 W = {0.f, 0.f, 0.f, 0.f}, A = {0.f, 0.f, 0.f, 0.f}, G = {0.f, 0.f, 0.f, 0.f};
#pragma unroll
      for (int ks = 0; ks < 2; ++ks) {
        W = mfma16(wdA[ks], ld8(w2T + n * 64 + ks * 32 + lq * 8), W);
        A = mfma16(adA[ks], ld8(a2T + n * 64 + ks * 32 + lq * 8), A);
      }
#pragma unroll
      for (int ks = 0; ks < 4; ++ks) G = mfma16(gdA[ks], ld8(g2T + n * 128 + ks * 32 + lq * 8), G);
      const float w0 = p.rwkv_w0[l * 256 + n], a0 = p.rwkv_a0[l * 256 + n], kkw = p.rwkv_kk[l * 256 + n], kaw = p.rwkv_ka[l * 256 + n];
#pragma unroll
      for (int r = 0; r < 4; ++r) {
        const int t = t0 + lq * 4 + r;
        float wl = -softplusf_(-(w0 + W[r])) - 0.5f;
        wv_[q][r] = __expf(-__expf(wl));
        float a = sigmoidf_(a0 + A[r]);
        float r_ = shifted1(COLS, mu, t, n), k_ = shifted1(COLS, mu, t, 256 + n), v_ = shifted1(COLS, mu, t, 512 + n);
        float kk = k_ * kkw;
        kkv[q][r] = kk; ss[r] += kk * kk; av[q][r] = a;
        k2v[q][r] = k_ * (1.f + (a - 1.f) * kaw);
        rv[q][r] = r_; vv[q][r] = v_;
        RG[(size_t)t * 256 + n] = f2bf(G[r]);
      }
    }
#pragma unroll
    for (int r = 0; r < 4; ++r) {
      float nrm = fmaxf(sqrtf(row16_sum(ss[r])), 1e-12f);
      float inv = 1.f / nrm;
      const int t = t0 + lq * 4 + r;
      unsigned char* dst = p.ws + O_RIN + ((size_t)(b * 4 + hd) * S + (t & (S - 1))) * 896;
#pragma unroll
      for (int q = 0; q < 4; ++q) {
        const int j = q * 16 + lr;
        float kkn = kkv[q][r] * inv;
        ((float*)dst)[j] = wv_[q][r];
        ((bfu*)(dst + 256))[j] = f2bf(-kkn);
        ((bfu*)(dst + 384))[j] = f2bf(kkn * av[q][r]);
        ((bfu*)(dst + 512))[j] = f2bf(k2v[q][r]);
        ((bfu*)(dst + 640))[j] = f2bf(rv[q][r]);
        ((bfu*)(dst + 768))[j] = f2bf(vv[q][r]);
      }
    }
  }
}
typedef float f32x2s __attribute__((ext_vector_type(2)));
DEV void rwkv_stage_write(float* dstbuf, uint4 v, int off, bool isw) {
  if (isw) { *(uint4*)(dstbuf + off) = v; }
  else {
    *(float4*)(dstbuf + off) = make_float4(lo2f(v.x), hi2f(v.x), lo2f(v.y), hi2f(v.y));
    *(float4*)(dstbuf + off + 4) = make_float4(lo2f(v.z), hi2f(v.z), lo2f(v.w), hi2f(v.w));
  }
}
DEV void rwkv_scan_item(const Params& p, int item) {
  const int bh = item >> 2, qd = item & 3;
  const int tid = tid_(), lane = tid & 63, wv = tid >> 6, lr = lane & 15, lq = lane >> 4;
  const unsigned char* src = p.ws + O_RIN + (size_t)bh * S * 896;
  float* Y = (float*)(p.ws + O_RY) + (size_t)(bh >> 2) * S * 256 + (bh & 3) * 64;
  const int irow = qd * 16 + wv * 4 + lq;
  float* buf = (float*)smem;
  constexpr int CH = 16, CB = CH * 896, CF = CH * 384;
  int soff[4]; bool sw[4];
#pragma unroll
  for (int i = 0; i < 4; ++i) {
    int idx = tid + i * 256; int st = idx / 56, wi = idx - st * 56;
    sw[i] = wi < 16;
    soff[i] = st * 384 + (sw[i] ? wi * 4 : 64 + ((wi - 16) >> 3) * 64 + ((wi - 16) & 7) * 8);
  }
  const bool t3 = tid < 896 - 768;
  __syncthreads();
  uint4 st0, st1, st2, st3 = make_uint4(0, 0, 0, 0);
  st0 = ((const uint4*)src)[tid]; st1 = ((const uint4*)src)[tid + 256]; st2 = ((const uint4*)src)[tid + 512]; if (t3) st3 = ((const uint4*)src)[tid + 768];
  rwkv_stage_write(buf, st0, soff[0], sw[0]); rwkv_stage_write(buf, st1, soff[1], sw[1]); rwkv_stage_write(buf, st2, soff[2], sw[2]);
  if (t3) rwkv_stage_write(buf, st3, soff[3], sw[3]);
  __syncthreads();
  f32x2s s01 = {0.f, 0.f}, s23 = {0.f, 0.f};
  for (int ch = 0; ch < S / CH; ++ch) {
    if (ch + 1 < S / CH) {
      const uint4* nsrc = (const uint4*)(src + (size_t)(ch + 1) * CB);
      st0 = nsrc[tid]; st1 = nsrc[tid + 256]; st2 = nsrc[tid + 512]; if (t3) st3 = nsrc[tid + 768];
    }
    const float* cb = buf + (ch & 1) * CF;
    float ykeep = 0.f;
    float4 W = *(const float4*)(cb + lr * 4), NK = *(const float4*)(cb + 64 + lr * 4), KA = *(const float4*)(cb + 128 + lr * 4);
    float4 KK = *(const float4*)(cb + 192 + lr * 4), RR = *(const float4*)(cb + 256 + lr * 4);
    float v = cb[320 + irow];
#pragma unroll
    for (int s = 0; s < CH; ++s) {
      float4 W2, NK2, KA2, KK2, RR2; float v2;
      if (s + 1 < CH) {
        const float* nb2 = cb + (s + 1) * 384;
        W2 = *(const float4*)(nb2 + lr * 4); NK2 = *(const float4*)(nb2 + 64 + lr * 4); KA2 = *(const float4*)(nb2 + 128 + lr * 4);
        KK2 = *(const float4*)(nb2 + 192 + lr * 4); RR2 = *(const float4*)(nb2 + 256 + lr * 4); v2 = nb2[320 + irow];
      }
      f32x2s t = s01 * (f32x2s){NK.x, NK.y}; t = s23 * (f32x2s){NK.z, NK.w} + t;
      f32x2s vv = {v, v};
      f32x2s u01 = s01 * (f32x2s){W.x, W.y}; u01 = vv * (f32x2s){KK.x, KK.y} + u01;
      f32x2s u23 = s23 * (f32x2s){W.z, W.w}; u23 = vv * (f32x2s){KK.z, KK.w} + u23;
      const float sa = row16_sum(t.x + t.y);
      f32x2s sav = {sa, sa};
      s01 = sav * (f32x2s){KA.x, KA.y} + u01;
      s23 = sav * (f32x2s){KA.z, KA.w} + u23;
      f32x2s yy = s01 * (f32x2s){RR.x, RR.y}; yy = s23 * (f32x2s){RR.z, RR.w} + yy;
      const float y = row16_sum(yy.x + yy.y);
      ykeep = (lr == s) ? y : ykeep;
      if (s + 1 < CH) { W = W2; NK = NK2; KA = KA2; KK = KK2; RR = RR2; v = v2; }
      if (s == 9 && ch + 1 < S / CH) {
        float* nb = buf + ((ch + 1) & 1) * CF;
        rwkv_stage_write(nb, st0, soff[0], sw[0]); rwkv_stage_write(nb, st1, soff[1], sw[1]); rwkv_stage_write(nb, st2, soff[2], sw[2]);
        if (t3) rwkv_stage_write(nb, st3, soff[3], sw[3]);
      }
    }
    Y[(size_t)(ch * CH + lr) * 256 + irow] = ykeep;
    __syncthreads();
  }
}
DEV void rwkv_post_item(const Params& p, int l, int item) {
  const int lane = tid_() & 63, wv = tid_() >> 6;
  const float* RY = (const float*)(p.ws + O_RY);
  const bfu* RG = (const bfu*)(p.ws + O_RG);
  bfu* MIX = (bfu*)(p.ws + O_ACT);
  for (int k = 0; k < 64; ++k) {
    const int t = item * 64 + wv * 16 + (k >> 2), h = k & 3;
    const int b = t / S, tp = t & (S - 1);
    float y = RY[(size_t)t * 256 + h * 64 + lane];
    float mean = wave_sum(y) * (1.f / 64.f);
    float d = y - mean;
    float var = wave_sum(d * d) * (1.f / 64.f);
    const int ch = h * 64 + lane;
    float yn = d * rsqrtf(var + 64e-5f) * p.rwkv_ln_w[l * 256 + ch] + p.rwkv_ln_b[l * 256 + ch];
    const unsigned char* src = p.ws + O_RIN + ((size_t)(b * 4 + h) * S + tp) * 896;
    float k2 = bf2f(((const bfu*)(src + 512))[lane]), r_ = bf2f(((const bfu*)(src + 640))[lane]), v_ = bf2f(((const bfu*)(src + 768))[lane]);
    float bonus = wave_sum(r_ * k2 * p.rwkv_rk[l * 256 + ch]);
    float o = (yn + bonus * v_) * bf2f(RG[(size_t)t * 256 + ch]);
    MIX[(size_t)t * 1024 + 512 + ch] = f2bf(o);
  }
}
DEV void nsa_tr_item(const Params& p, int item) {
  const int which = item & 1, tt = (item >> 1) & 127, b = item >> 8;
  const int tid = tid_();
  const bfu* COLS = (const bfu*)(p.ws + O_COLS);
  bfu* dst = (bfu*)(p.ws + (which ? O_VWT : O_VST)) + (size_t)b * 64 * S;
  const int col0 = which ? C_VW : C_VS;
  bfu* tl = (bfu*)smem;
  __syncthreads();
  for (int i = tid; i < 64 * 32; i += NTHR) {
    int tok = i >> 5, dp = i & 31;
    unsigned u = *(const unsigned*)(COLS + (size_t)(b * S + tt * 64 + tok) * NIN + col0 + dp * 2);
    *(unsigned*)(tl + tok * 66 + dp * 2) = u;
  }
  __syncthreads();
  {
    const int d = tid >> 2, tq = (tid & 3) * 16;
    unsigned o[8];
#pragma unroll
    for (int i = 0; i < 8; ++i) o[i] = (unsigned)tl[(tq + i * 2) * 66 + d] | ((unsigned)tl[(tq + i * 2 + 1) * 66 + d] << 16);
    uint4* dp = (uint4*)(dst + (size_t)d * S + tt * 64 + tq);
    dp[0] = make_uint4(o[0], o[1], o[2], o[3]); dp[1] = make_uint4(o[4], o[5], o[6], o[7]);
  }
}
DEV void nsa_cmp_item(const Params& p, int l, int item) {
  const int mt = item & 31, b = (item >> 5) & 3, which = item >> 7;
  const int tid = tid_(), lane = tid & 63, wv = tid >> 6, lr = lane & 15, lq = lane >> 4;
  const bfu* COLS = (const bfu*)(p.ws + O_COLS);
  const unsigned char* wb = p.ws + O_W + (size_t)l * W_SZ;
  const bfu* w1T = (const bfu*)(wb + W_C1) + (size_t)which * 256 * 2048;
  const bfu* w2T = (const bfu*)(wb + W_C2) + (size_t)which * 64 * 256;
  const float* pos = p.nsa_cmp_pos + ((size_t)l * 2 + which) * 2048;
  const int col0 = which ? C_VC : C_KC;
  bfu* Hs = (bfu*)smem;
  int blk = mt * 16 + lr; if (blk > 510) blk = 510;
  const bfu* arow = COLS + (size_t)(b * S + blk * 16) * NIN + col0 + lq * 8;
  f32x4 acc[4];
#pragma unroll
  for (int j = 0; j < 4; ++j) acc[j] = (f32x4){0.f, 0.f, 0.f, 0.f};
  for (int ks = 0; ks < 64; ++ks) {
    uint4 u = *(const uint4*)(arow + (size_t)(ks >> 1) * NIN + (ks & 1) * 32);
    const float4* pp = (const float4*)(pos + ks * 32 + lq * 8);
    float4 p0 = pp[0], p1 = pp[1];
    float av[8] = {lo2f(u.x) + p0.x, hi2f(u.x) + p0.y, lo2f(u.y) + p0.z, hi2f(u.y) + p0.w, lo2f(u.z) + p1.x, hi2f(u.z) + p1.y, lo2f(u.w) + p1.z, hi2f(u.w) + p1.w};
    bf16x8 a = packf8(av);
#pragma unroll
    for (int j = 0; j < 4; ++j) acc[j] = mfma16(a, ld8(w1T + (size_t)(wv * 64 + j * 16 + lr) * 2048 + ks * 32 + lq * 8), acc[j]);
  }
  __syncthreads();
#pragma unroll
  for (int j = 0; j < 4; ++j)
#pragma unroll
    for (int r = 0; r < 4; ++r) Hs[(lq * 4 + r) * 264 + wv * 64 + j * 16 + lr] = f2bf(geluf_(acc[j][r]));
  __syncthreads();
  f32x4 o = {0.f, 0.f, 0.f, 0.f};
#pragma unroll
  for (int ks = 0; ks < 8; ++ks) o = mfma16(*(const bf16x8*)(Hs + lr * 264 + ks * 32 + lq * 8), ld8(w2T + (wv * 16 + lr) * 256 + ks * 32 + lq * 8), o);
#pragma unroll
  for (int r = 0; r < 4; ++r) {
    int bi = mt * 16 + lq * 4 + r, d = wv * 16 + lr;
    float v = (bi < 511) ? o[r] : 0.f;
    if (which == 0) ((bfu*)(p.ws + O_KCMP))[((size_t)b * 512 + bi) * 64 + d] = f2bf(v);
    else ((bfu*)(p.ws + O_VCT))[((size_t)b * 64 + d) * 512 + bi] = f2bf(v);
  }
}

struct AttnState { float m[4], l[4]; f32x4 O[4]; };
DEV void attn_init(AttnState& st) {
#pragma unroll
  for (int r = 0; r < 4; ++r) { st.m[r] = -1e30f; st.l[r] = 0.f; st.O[r] = (f32x4){0.f, 0.f, 0.f, 0.f}; }
}
struct KVF { bf16x8 k00, k01, k10, k11, v0, v1, v2, v3; };
DEV void attn_load(KVF& f, const bfu* kp0, const bfu* kp1, const bfu* vt, size_t vs16) {
  f.k00 = ld8(kp0); f.k01 = ld8(kp0 + 32); f.k10 = ld8(kp1); f.k11 = ld8(kp1 + 32);
  f.v0 = ld8(vt); f.v1 = ld8(vt + vs16); f.v2 = ld8(vt + 2 * vs16); f.v3 = ld8(vt + 3 * vs16);
}
DEV void attn_compute(AttnState& st, const bf16x8* q, const KVF& f, float dist0, bool val0, float dist1, bool val1, bfu* pbuf, int lr, int lq) {
  f32x4 s0 = {0.f, 0.f, 0.f, 0.f}, s1 = {0.f, 0.f, 0.f, 0.f};
  s0 = mfma16(q[0], f.k00, s0); s0 = mfma16(q[1], f.k01, s0);
  s1 = mfma16(q[0], f.k10, s1); s1 = mfma16(q[1], f.k11, s1);
#pragma unroll
  for (int r = 0; r < 4; ++r) {
    const float slope = (r == 0) ? 0.25f : (r == 1) ? 0.0625f : (r == 2) ? 0.015625f : 0.00390625f;
    float a0 = val0 ? s0[r] * 0.125f - slope * dist0 : -1e30f;
    float a1 = val1 ? s1[r] * 0.125f - slope * dist1 : -1e30f;
    float mn = fmaxf(st.m[r], row16_max(fmaxf(a0, a1)));
    float p0 = val0 ? __expf(a0 - mn) : 0.f, p1 = val1 ? __expf(a1 - mn) : 0.f;
    float corr = __expf(st.m[r] - mn);
    st.m[r] = mn;
    st.l[r] = st.l[r] * corr + row16_sum(p0 + p1);
#pragma unroll
    for (int dt = 0; dt < 4; ++dt) st.O[dt][r] *= corr;
    pbuf[(lq * 4 + r) * 40 + lr] = f2bf(p0); pbuf[(lq * 4 + r) * 40 + 16 + lr] = f2bf(p1);
  }
  bf16x8 pa = *(const bf16x8*)(pbuf + lr * 40 + lq * 8);
  st.O[0] = mfma16(pa, f.v0, st.O[0]); st.O[1] = mfma16(pa, f.v1, st.O[1]);
  st.O[2] = mfma16(pa, f.v2, st.O[2]); st.O[3] = mfma16(pa, f.v3, st.O[3]);
}
DEV float wave_maxf_u(float v) {
  v = row16_max(v);
  v = fmaxf(v, __int_as_float(__builtin_amdgcn_update_dpp(__float_as_int(-__builtin_inff()), __float_as_int(v), 0x142, 0xA, 0xF, false)));
  v = fmaxf(v, __int_as_float(__builtin_amdgcn_update_dpp(__float_as_int(-__builtin_inff()), __float_as_int(v), 0x143, 0xC, 0xF, false)));
  return __int_as_float(__builtin_amdgcn_readlane(__float_as_int(v), 63));
}
template <int CTRL> DEV int dppi(int v) { return __builtin_amdgcn_update_dpp(0, v, CTRL, 0xf, 0xf, true); }
DEV int wave_mini_u(int v) {
  v = min(v, dppi<0xB1>(v)); v = min(v, dppi<0x4E>(v)); v = min(v, dppi<0x141>(v)); v = min(v, dppi<0x140>(v));
  v = min(v, __builtin_amdgcn_update_dpp(0x7fffffff, v, 0x142, 0xA, 0xF, false));
  v = min(v, __builtin_amdgcn_update_dpp(0x7fffffff, v, 0x143, 0xC, 0xF, false));
  return __builtin_amdgcn_readlane(v, 63);
}

DEV void nsa_cmpattn_item(const Params& p, int item) {
  const int lane = tid_() & 63, wv = tid_() >> 6, lr = lane & 15, lq = lane >> 4;
  const bfu* COLS = (const bfu*)(p.ws + O_COLS);
  const int t0 = item * 16 + wv * 4;
  const int b = t0 / S, tp0 = t0 & (S - 1);
  const bfu* KC = (const bfu*)(p.ws + O_KCMP) + (size_t)b * 512 * 64;
  const bfu* VCT = (const bfu*)(p.ws + O_VCT) + (size_t)b * 64 * 512;
  bfu* pbuf = (bfu*)smem + wv * 640;
  float* ps = (float*)(smem + 5120) + wv * (4 * 516);
  bf16x8 q[2];
#pragma unroll
  for (int ks = 0; ks < 2; ++ks) q[ks] = ld8(COLS + (size_t)(t0 + (lr >> 2)) * NIN + C_Q + (lr & 3) * 64 + ks * 32 + lq * 8);
  const int pos = tp0 + lq;
  const int pmax = tp0 + 3;
  const int nvalid = (pmax >= 31) ? ((pmax - 31) >> 4) + 1 : 0;
  const int nkt = (nvalid + 31) >> 5;
  float m[4] = {-1e30f, -1e30f, -1e30f, -1e30f}, z[4] = {0.f, 0.f, 0.f, 0.f};
  for (int kt = 0; kt < nkt; ++kt) {
    const int n0 = kt * 32 + lr, n1 = n0 + 16;
    f32x4 s0 = {0.f, 0.f, 0.f, 0.f}, s1 = {0.f, 0.f, 0.f, 0.f};
    s0 = mfma16(q[0], ld8(KC + n0 * 64 + lq * 8), s0); s0 = mfma16(q[1], ld8(KC + n0 * 64 + 32 + lq * 8), s0);
    s1 = mfma16(q[0], ld8(KC + n1 * 64 + lq * 8), s1); s1 = mfma16(q[1], ld8(KC + n1 * 64 + 32 + lq * 8), s1);
    const int d0 = pos - (16 * n0 + 31), d1 = pos - (16 * n1 + 31);
#pragma unroll
    for (int r = 0; r < 4; ++r) {
      const float slope = (r == 0) ? 0.25f : (r == 1) ? 0.0625f : (r == 2) ? 0.015625f : 0.00390625f;
      float a0 = (d0 >= 0) ? s0[r] * 0.125f - slope * (float)d0 : -1e30f;
      float a1 = (d1 >= 0) ? s1[r] * 0.125f - slope * (float)d1 : -1e30f;
      float mn = fmaxf(m[r], row16_max(fmaxf(a0, a1)));
      float p0 = (d0 >= 0) ? __expf(a0 - mn) : 0.f, p1 = (d1 >= 0) ? __expf(a1 - mn) : 0.f;
      z[r] = z[r] * __expf(m[r] - mn) + row16_sum(p0 + p1);
      m[r] = mn;
    }
  }
  float iz[4];
#pragma unroll
  for (int r = 0; r < 4; ++r) iz[r] = 1.f / fmaxf(z[r], 1e-30f);
  f32x4 O[4];
#pragma unroll
  for (int dt = 0; dt < 4; ++dt) O[dt] = (f32x4){0.f, 0.f, 0.f, 0.f};
  for (int kt = 0; kt < nkt; ++kt) {
    const int n0 = kt * 32 + lr, n1 = n0 + 16;
    f32x4 s0 = {0.f, 0.f, 0.f, 0.f}, s1 = {0.f, 0.f, 0.f, 0.f};
    s0 = mfma16(q[0], ld8(KC + n0 * 64 + lq * 8), s0); s0 = mfma16(q[1], ld8(KC + n0 * 64 + 32 + lq * 8), s0);
    s1 = mfma16(q[0], ld8(KC + n1 * 64 + lq * 8), s1); s1 = mfma16(q[1], ld8(KC + n1 * 64 + 32 + lq * 8), s1);
    const int d0 = pos - (16 * n0 + 31), d1 = pos - (16 * n1 + 31);
    float ps0 = 0.f, ps1 = 0.f;
#pragma unroll
    for (int r = 0; r < 4; ++r) {
      const float slope = (r == 0) ? 0.25f : (r == 1) ? 0.0625f : (r == 2) ? 0.015625f : 0.00390625f;
      float p0 = (d0 >= 0) ? __expf(s0[r] * 0.125f - slope * (float)d0 - m[r]) * iz[r] : 0.f;
      float p1 = (d1 >= 0) ? __expf(s1[r] * 0.125f - slope * (float)d1 - m[r]) * iz[r] : 0.f;
      ps0 += p0; ps1 += p1;
      pbuf[(lq * 4 + r) * 40 + lr] = f2bf(p0); pbuf[(lq * 4 + r) * 40 + 16 + lr] = f2bf(p1);
    }
    ps[lq * 516 + n0] = ps0; ps[lq * 516 + n1] = ps1;
    bf16x8 pa = *(const bf16x8*)(pbuf + lr * 40 + lq * 8);
#pragma unroll
    for (int dt = 0; dt < 4; ++dt) O[dt] = mfma16(pa, ld8(VCT + (size_t)(dt * 16 + lr) * 512 + kt * 32 + lq * 8), O[dt]);
  }
  bfu* OC = (bfu*)(p.ws + O_OCMP);
#pragma unroll
  for (int dt = 0; dt < 4; ++dt)
#pragma unroll
    for (int r = 0; r < 4; ++r) OC[(size_t)(t0 + lq) * 256 + r * 64 + dt * 16 + lr] = f2bf(O[dt][r]);
  const int nproc = nkt * 32;
  unsigned long long* SEL = (unsigned long long*)(p.ws + O_SEL);
  for (int tk = 0; tk < 4; ++tk) {
    const int tpos = tp0 + tk, cur = tpos >> 6;
    const float* pr = ps + tk * 516;
    float iv[2];
#pragma unroll
    for (int hh = 0; hh < 2; ++hh) {
      const int j = lane + hh * 64;
      float v = -__builtin_inff();
      if (j <= cur) {
        if (j == 0 || j == cur || j == cur - 1) v = 1e4f;
        else {
          float a = 0.f;
#pragma unroll
          for (int e = -1; e < 4; ++e) {
            int n = 4 * j + e;
            float w = (e == -1 || e == 3) ? 0.5f : 1.f;
            if (n >= 0 && n <= 510 && n < nproc) a += w * pr[n];
          }
          v = a;
        }
      }
      iv[hh] = v;
    }
    bool sel0 = false, sel1 = false;
    const int nsel = (cur + 1 < 16) ? cur + 1 : 16;
    for (int rd = 0; rd < nsel; ++rd) {
      float c0 = sel0 ? -__builtin_inff() : iv[0], c1 = sel1 ? -__builtin_inff() : iv[1];
      const float gm = wave_maxf_u(fmaxf(c0, c1));
      const int bi = wave_mini_u((c0 == gm) ? lane : ((c1 == gm) ? lane + 64 : 0x7fffffff));
      if (bi == lane) sel0 = true;
      if (bi == lane + 64) sel1 = true;
    }
    unsigned long long mlo = __ballot(sel0), mhi = __ballot(sel1);
    if (lane == 0) { SEL[(size_t)(t0 + tk) * 2] = mlo; SEL[(size_t)(t0 + tk) * 2 + 1] = mhi; }
  }
}

DEV void nsa_finish_item(const Params& p, int item) {
  const int lane = tid_() & 63, wv = tid_() >> 6, lr = lane & 15, lq = lane >> 4;
  const bfu* COLS = (const bfu*)(p.ws + O_COLS);
  const float* SIDE = (const float*)(p.ws + O_SIDE);
  const int t0 = item * 16 + wv * 4;
  const int b = t0 / S, tp0 = t0 & (S - 1);
  bfu* pbuf = (bfu*)smem + wv * 640;
  bf16x8 q[2];
#pragma unroll
  for (int ks = 0; ks < 2; ++ks) q[ks] = ld8(COLS + (size_t)(t0 + (lr >> 2)) * NIN + C_Q + (lr & 3) * 64 + ks * 32 + lq * 8);
  const int pos = tp0 + lq;
  const bfu* rowb = COLS + (size_t)b * S * NIN;
  AttnState sw; attn_init(sw);
  KVF cur, nxt;
  {
    const bfu* VT = (const bfu*)(p.ws + O_VWT) + (size_t)b * 64 * S;
    int kb = tp0 - 511; if (kb < 0) kb = 0; kb &= ~31;
    const int last = tp0 + 3;
    attn_load(cur, rowb + (size_t)(kb + lr) * NIN + C_KW + lq * 8, rowb + (size_t)(kb + 16 + lr) * NIN + C_KW + lq * 8, VT + (size_t)lr * S + kb + lq * 8, (size_t)16 * S);
    for (; kb <= last; kb += 32) {
      const bool more = kb + 32 <= last;
      const int kn = kb + 32;
      if (more) attn_load(nxt, rowb + (size_t)(kn + lr) * NIN + C_KW + lq * 8, rowb + (size_t)(kn + 16 + lr) * NIN + C_KW + lq * 8, VT + (size_t)lr * S + kn + lq * 8, (size_t)16 * S);
      const int d0 = pos - (kb + lr), d1 = d0 - 16;
      attn_compute(sw, q, cur, (float)d0, d0 >= 0 && d0 < 512, (float)d1, d1 >= 0 && d1 < 512, pbuf, lr, lq);
      if (more) cur = nxt;
    }
  }
  AttnState ss; attn_init(ss);
  {
    const bfu* VT = (const bfu*)(p.ws + O_VST) + (size_t)b * 64 * S;
    const unsigned long long* SEL = (const unsigned long long*)(p.ws + O_SEL);
    const unsigned long long mylo = SEL[(size_t)(t0 + lq) * 2], myhi = SEL[(size_t)(t0 + lq) * 2 + 1];
    unsigned long long ulo = 0, uhi = 0;
#pragma unroll
    for (int k = 0; k < 4; ++k) { ulo |= SEL[(size_t)(t0 + k) * 2]; uhi |= SEL[(size_t)(t0 + k) * 2 + 1]; }
    unsigned ul0 = __builtin_amdgcn_readfirstlane((unsigned)ulo), ul1 = __builtin_amdgcn_readfirstlane((unsigned)(ulo >> 32));
    unsigned uh0 = __builtin_amdgcn_readfirstlane((unsigned)uhi), uh1 = __builtin_amdgcn_readfirstlane((unsigned)(uhi >> 32));
    int j = -1, hb = 1;
    auto adv = [&]() -> bool {
      if (hb == 0) { hb = 1; return true; }
      hb = 0;
      if (ul0) { j = __builtin_ctz(ul0); ul0 &= ul0 - 1; return true; }
      if (ul1) { j = 32 + __builtin_ctz(ul1); ul1 &= ul1 - 1; return true; }
      if (uh0) { j = 64 + __builtin_ctz(uh0); uh0 &= uh0 - 1; return true; }
      if (uh1) { j = 96 + __builtin_ctz(uh1); uh1 &= uh1 - 1; return true; }
      return false;
    };
    bool ok = adv();
    if (ok) { const int kb = j * 64 + hb * 32; attn_load(cur, rowb + (size_t)(kb + lr) * NIN + C_KS + lq * 8, rowb + (size_t)(kb + 16 + lr) * NIN + C_KS + lq * 8, VT + (size_t)lr * S + kb + lq * 8, (size_t)16 * S); }
    while (ok) {
      const int cj = j, kb = j * 64 + hb * 32;
      const bool nk = adv();
      if (nk) { const int kn = j * 64 + hb * 32; attn_load(nxt, rowb + (size_t)(kn + lr) * NIN + C_KS + lq * 8, rowb + (size_t)(kn + 16 + lr) * NIN + C_KS + lq * 8, VT + (size_t)lr * S + kn + lq * 8, (size_t)16 * S); }
      const bool has = (((cj < 64) ? (mylo >> cj) : (myhi >> (cj - 64))) & 1ull) != 0;
      const int d0 = pos - (kb + lr), d1 = d0 - 16;
      attn_compute(ss, q, cur, (float)d0, has && d0 >= 0, (float)d1, has && d1 >= 0, pbuf, lr, lq);
      if (nk) cur = nxt;
      ok = nk;
    }
  }
  const bfu* OC = (const bfu*)(p.ws + O_OCMP);
  bfu* MIX = (bfu*)(p.ws + O_ACT);
  const int t = t0 + lq;
#pragma unroll
  for (int r = 0; r < 4; ++r) {
    const float g0 = sigmoidf_(SIDE[(size_t)t * 16 + 4 + r * 3]), g1 = sigmoidf_(SIDE[(size_t)t * 16 + 5 + r * 3]), g2 = sigmoidf_(SIDE[(size_t)t * 16 + 6 + r * 3]);
    const float is = g1 / fmaxf(ss.l[r], 1e-30f), iw = g2 / fmaxf(sw.l[r], 1e-30f);
#pragma unroll
    for (int dt = 0; dt < 4; ++dt) {
      const int ch = r * 64 + dt * 16 + lr;
      float o = g0 * bf2f(OC[(size_t)t * 256 + ch]) + is * ss.O[dt][r] + iw * sw.O[dt][r];
      MIX[(size_t)t * 1024 + 768 + ch] = f2bf(o);
    }
  }
}

DEV void phase_rwkv_prep(const Params& p, int l) {
  for (int it = bid_(); it < 512; it += gridDim.x) rwkv_prep_item(p, l, it);
}
DEV void sub_arrive(unsigned* bar) {
  asm volatile("s_waitcnt vmcnt(0)" ::: "memory");
  __syncthreads();
  if (tid_() == 0) { __threadfence(); atomicAdd(bar, 1u); }
}
DEV void sub_wait(unsigned* bar, unsigned target) {
  if (tid_() == 0) { while (__hip_atomic_load(bar, __ATOMIC_RELAXED, __HIP_MEMORY_SCOPE_AGENT) < target) __builtin_amdgcn_s_sleep(2); __threadfence(); }
  __syncthreads();
}
DEV void phase_mix_scan_finish(const Params& p, int l) {
  unsigned* barA = (unsigned*)(p.ws + O_SYNC) + l * 4;
  unsigned* barB = barA + 1;
  unsigned* que = barA + 2;
  const unsigned nothers = gridDim.x - 64;
  if (bid_() < 64) {
    __builtin_amdgcn_s_setprio(3);
    for (int rep = 0; rep < R_SCAN; ++rep) rwkv_scan_item(p, bid_());
    __builtin_amdgcn_s_setprio(0);
  } else {
    constexpr int P0 = 1024, P1 = P0 + 2048, P2 = P1 + 1024, P3 = P2 + 256;
    for (int it = bid_() - 64; it < P3; it += gridDim.x - 64) {
      if (it < P0) ssd_item<0>(p, l, it);
      else if (it < P1) lru_item<0>(p, l, it - P0);
      else if (it < P2) nsa_tr_item(p, it - P1);
      else nsa_cmp_item(p, l, it - P2);
    }
    sub_arrive(barA);
    sub_wait(barA, nothers);
    constexpr int N0 = 2048, N1 = N0 + 256, N2 = N1 + 4;
    for (int it = bid_() - 64; it < N2; it += gridDim.x - 64) {
      if (it < N0) { for (int rep = 0; rep < R_CMPA; ++rep) { __syncthreads(); nsa_cmpattn_item(p, it); } }
      else if (it < N1) ssd_rec_item(p, it - N0);
      else lru_carry_item(p, it - N1);
    }
    sub_arrive(barB);
  }
  sub_wait(barB, nothers);
  constexpr int M0 = 2048, M1 = M0 + 1024, M2 = M1 + 2048;
  for (;;) {
    __syncthreads();
    if (tid_() == 0) s_qitem = (int)atomicAdd(que, 1u);
    __syncthreads();
    const int it = s_qitem;
    if (it >= M2) break;
    for (int rep = 0; rep < R_FIN; ++rep) {
    if (it < M0) { __syncthreads(); nsa_finish_item(p, it); }
    else if (it < M1) ssd_item<1>(p, l, it - M0);
    else lru_item<1>(p, l, it - M1);
    }
  }
}
DEV void phase_rwkv_post(const Params& p, int l) {
  for (int it = bid_(); it < 512; it += gridDim.x) rwkv_post_item(p, l, it);
}

template <int CTRL> DEV int dppi_(int v) { return __builtin_amdgcn_update_dpp(0, v, CTRL, 0xf, 0xf, true); }
DEV int row16_mini(int v) { v = min(v, dppi_<0xB1>(v)); v = min(v, dppi_<0x4E>(v)); v = min(v, dppi_<0x141>(v)); v = min(v, dppi_<0x140>(v)); return v; }
DEV void phase_peer_topk(const Params& p, int l) {
  const bfu* Q = (const bfu*)(p.ws + O_PQ);
  const bfu* keys = (const bfu*)(p.ws + O_W + (size_t)l * W_SZ + W_KEYS);
  int* PE = (int*)(p.ws + O_PE); float* PG = (float*)(p.ws + O_PG);
  const int lane = tid_() & 63, wv = tid_() >> 6, lr = lane & 15, lq = lane >> 4;
  float* ps = (float*)smem + wv * 1024;
  int* pi = (int*)ps + 512;
  const float NINF = -__builtin_inff();
  int ca[4], cb[4]; bool cok[4];
#pragma unroll
  for (int sl = 0; sl < 4; ++sl) {
    int k = sl * 16 + lr, a = 0; bool ok = false;
    for (int aa = 0; aa < 16; ++aa) { int cnt = 16 / (aa + 1); if (!ok) { if (k < cnt) { ok = true; a = aa; } else k -= cnt; } }
    ca[sl] = a; cb[sl] = ok ? k : 0; cok[sl] = ok;
  }
  for (int item = bid_(); item < (T / 64) * 8; item += gridDim.x) {
    const int tt = item >> 3, hd = item & 7;
    const int t0 = tt * 64 + wv * 16;
    for (int c = 0; c < 2; ++c) {
      bf16x8 qa[4];
#pragma unroll
      for (int ks = 0; ks < 4; ++ks) qa[ks] = ld8(Q + (size_t)(t0 + lr) * 2048 + hd * 256 + c * 128 + ks * 32 + lq * 8);
      const bfu* kb = keys + (size_t)(hd * 2 + c) * 128 * 128;
      float v[4][8];
#pragma unroll
      for (int nt = 0; nt < 8; ++nt) {
        f32x4 a = {0.f, 0.f, 0.f, 0.f};
#pragma unroll
        for (int ks = 0; ks < 4; ++ks) a = mfma16(qa[ks], ld8(kb + (size_t)(nt * 16 + lr) * 128 + ks * 32 + lq * 8), a);
#pragma unroll
        for (int r = 0; r < 4; ++r) v[r][nt] = a[r];
      }
      float mys[4] = {0.f, 0.f, 0.f, 0.f}; int myi[4] = {0, 0, 0, 0};
      for (int rd = 0; rd < 16; ++rd) {
#pragma unroll
        for (int r = 0; r < 4; ++r) {
          float lm = fmaxf(fmaxf(fmaxf(v[r][0], v[r][1]), fmaxf(v[r][2], v[r][3])), fmaxf(fmaxf(v[r][4], v[r][5]), fmaxf(v[r][6], v[r][7])));
          const float gm = row16_max(lm);
          int cand = 0x7fffffff;
#pragma unroll
          for (int nt = 7; nt >= 0; --nt) cand = (v[r][nt] == gm) ? nt * 16 + lr : cand;
          const int bi = row16_mini(cand);
#pragma unroll
          for (int nt = 0; nt < 8; ++nt) v[r][nt] = (bi == nt * 16 + lr) ? NINF : v[r][nt];
          if (lr == rd) { mys[r] = gm; myi[r] = bi; }
        }
      }
#pragma unroll
      for (int r = 0; r < 4; ++r) { ps[c * 256 + (lq * 4 + r) * 16 + lr] = mys[r]; pi[c * 256 + (lq * 4 + r) * 16 + lr] = myi[r]; }
    }
    float cv[4][4];
#pragma unroll
    for (int r = 0; r < 4; ++r)
#pragma unroll
      for (int sl = 0; sl < 4; ++sl) {
        float sv = ps[(lq * 4 + r) * 16 + ca[sl]] + ps[256 + (lq * 4 + r) * 16 + cb[sl]];
        cv[r][sl] = cok[sl] ? sv : NINF;
      }
    float tops[4] = {0.f, 0.f, 0.f, 0.f}; int topf[4] = {0, 0, 0, 0};
    for (int rd = 0; rd < 16; ++rd) {
#pragma unroll
      for (int r = 0; r < 4; ++r) {
        const float gm = row16_max(fmaxf(fmaxf(cv[r][0], cv[r][1]), fmaxf(cv[r][2], cv[r][3])));
        int cand = 0x7fffffff;
#pragma unroll
        for (int sl = 0; sl < 4; ++sl) { int fl = ca[sl] * 16 + cb[sl]; cand = (cv[r][sl] == gm && fl < cand) ? fl : cand; }
        const int bi = row16_mini(cand);
#pragma unroll
        for (int sl = 0; sl < 4; ++sl) cv[r][sl] = (bi == ca[sl] * 16 + cb[sl]) ? NINF : cv[r][sl];
        if (lr == rd) { tops[r] = gm; topf[r] = bi; }
      }
    }
#pragma unroll
    for (int r = 0; r < 4; ++r) {
      const int row = lq * 4 + r;
      const float mx = row16_max(tops[r]);
      const float e = __expf(tops[r] - mx);
      const float den = row16_sum(e);
      const int a = topf[r] >> 4, bb = topf[r] & 15;
      const size_t o = (size_t)(t0 + row) * 128 + hd * 16 + lr;
      PE[o] = pi[row * 16 + a] * 128 + pi[256 + row * 16 + bb];
      PG[o] = e / den;
    }
  }
}

typedef float f32x2 __attribute__((ext_vector_type(2)));
DEV float wave_total(float v) {
  v = row16_sum(v);
  v += __int_as_float(__builtin_amdgcn_update_dpp(0, __float_as_int(v), 0x142, 0xA, 0xF, false));
  v += __int_as_float(__builtin_amdgcn_update_dpp(0, __float_as_int(v), 0x143, 0xC, 0xF, false));
  return __int_as_float(__builtin_amdgcn_readlane(__float_as_int(v), 63));
}
DEV float dot_fp8(uint4 u, const f32x2* x) {
  f32x2 acc = __builtin_amdgcn_cvt_pk_f32_fp8((int)u.x, false) * x[0];
  acc = __builtin_amdgcn_cvt_pk_f32_fp8((int)u.x, true) * x[1] + acc;
  acc = __builtin_amdgcn_cvt_pk_f32_fp8((int)u.y, false) * x[2] + acc;
  acc = __builtin_amdgcn_cvt_pk_f32_fp8((int)u.y, true) * x[3] + acc;
  acc = __builtin_amdgcn_cvt_pk_f32_fp8((int)u.z, false) * x[4] + acc;
  acc = __builtin_amdgcn_cvt_pk_f32_fp8((int)u.z, true) * x[5] + acc;
  acc = __builtin_amdgcn_cvt_pk_f32_fp8((int)u.w, false) * x[6] + acc;
  acc = __builtin_amdgcn_cvt_pk_f32_fp8((int)u.w, true) * x[7] + acc;
  return acc.x + acc.y;
}
DEV void axpy_fp8(uint4 v, float c, f32x2* y) {
  f32x2 cc = {c, c};
  y[0] = __builtin_amdgcn_cvt_pk_f32_fp8((int)v.x, false) * cc + y[0];
  y[1] = __builtin_amdgcn_cvt_pk_f32_fp8((int)v.x, true) * cc + y[1];
  y[2] = __builtin_amdgcn_cvt_pk_f32_fp8((int)v.y, false) * cc + y[2];
  y[3] = __builtin_amdgcn_cvt_pk_f32_fp8((int)v.y, true) * cc + y[3];
  y[4] = __builtin_amdgcn_cvt_pk_f32_fp8((int)v.z, false) * cc + y[4];
  y[5] = __builtin_amdgcn_cvt_pk_f32_fp8((int)v.z, true) * cc + y[5];
  y[6] = __builtin_amdgcn_cvt_pk_f32_fp8((int)v.w, false) * cc + y[6];
  y[7] = __builtin_amdgcn_cvt_pk_f32_fp8((int)v.w, true) * cc + y[7];
}
struct PBatch { uint4 u[4], v[4]; };
DEV void peer_load(PBatch& pb, const unsigned char* PU, const unsigned char* PV, int me0, int me1, int e, int lane) {
#pragma unroll
  for (int k = 0; k < 4; ++k) {
    int ee = e + k;
    int idx = __builtin_amdgcn_readlane((ee < 64) ? me0 : me1, ee & 63);
    pb.u[k] = *(const uint4*)(PU + (size_t)idx * 2048 + lane * 16);
    pb.v[k] = *(const uint4*)(PU + (size_t)idx * 2048 + 1024 + lane * 16);
  }
}
DEV void peer_compute(const PBatch& pb, const f32x2* x, f32x2* y, float mg0, float mg1, int e) {
  float d[4];
#pragma unroll
  for (int k = 0; k < 4; ++k) d[k] = dot_fp8(pb.u[k], x);
#pragma unroll
  for (int k = 0; k < 4; ++k) {
    int ee = e + k;
    float g = __int_as_float(__builtin_amdgcn_readlane(__float_as_int((ee < 64) ? mg0 : mg1), ee & 63));
    float act = wave_total(d[k]) * (1.f / PU_SCALE);
    axpy_fp8(pb.v[k], g * geluf_(act), y);
  }
}
DEV void phase_peer_gather(const Params& p, const float* gnext, bool last) {
  const bfu* XN = (const bfu*)(p.ws + O_ACT);
  const unsigned char* PU = p.ws + O_PU; const unsigned char* PV = p.ws + O_PV;
  const int* PE = (const int*)(p.ws + O_PE); const float* PG = (const float*)(p.ws + O_PG);
  const int lane = tid_() & 63, wv = tid_() >> 6;
  for (int t = bid_() * 4 + wv; t < T; t += gridDim.x * 4) {
    f32x2 x[8], y[8];
    {
      uint4 a = *(const uint4*)(XN + (size_t)t * D + lane * 16);
      uint4 b = *(const uint4*)(XN + (size_t)t * D + lane * 16 + 8);
      x[0] = (f32x2){lo2f(a.x), hi2f(a.x)}; x[1] = (f32x2){lo2f(a.y), hi2f(a.y)}; x[2] = (f32x2){lo2f(a.z), hi2f(a.z)}; x[3] = (f32x2){lo2f(a.w), hi2f(a.w)};
      x[4] = (f32x2){lo2f(b.x), hi2f(b.x)}; x[5] = (f32x2){lo2f(b.y), hi2f(b.y)}; x[6] = (f32x2){lo2f(b.z), hi2f(b.z)}; x[7] = (f32x2){lo2f(b.w), hi2f(b.w)};
    }
#pragma unroll
    for (int i = 0; i < 8; ++i) y[i] = (f32x2){0.f, 0.f};
    const int me0 = PE[(size_t)t * 128 + lane], me1 = PE[(size_t)t * 128 + 64 + lane];
    const float mg0 = PG[(size_t)t * 128 + lane], mg1 = PG[(size_t)t * 128 + 64 + lane];
    PBatch A, B;
    for (int rep = 0; rep < R_GATH; ++rep) {
#pragma unroll
    for (int i = 0; i < 8; ++i) y[i] = (f32x2){0.f, 0.f};
    peer_load(A, PU, PV, me0, me1, 0, lane);
    for (int e = 0; e < 128; e += 8) {
      peer_load(B, PU, PV, me0, me1, e + 4, lane);
      peer_compute(A, x, y, mg0, mg1, e);
      if (e + 8 < 128) peer_load(A, PU, PV, me0, me1, e + 8, lane);
      peer_compute(B, x, y, mg0, mg1, e + 4);
    }
    }
    float* hp = p.out + (size_t)t * D + lane * 16;
    float4 h0 = *(const float4*)(hp), h1 = *(const float4*)(hp + 4), h2 = *(const float4*)(hp + 8), h3 = *(const float4*)(hp + 12);
    float hv[16] = {h0.x, h0.y, h0.z, h0.w, h1.x, h1.y, h1.z, h1.w, h2.x, h2.y, h2.z, h2.w, h3.x, h3.y, h3.z, h3.w};
    float ss = 0.f;
#pragma unroll
    for (int i = 0; i < 8; ++i) {
      hv[i * 2] += y[i].x * (1.f / PV_SCALE); hv[i * 2 + 1] += y[i].y * (1.f / PV_SCALE);
      ss += hv[i * 2] * hv[i * 2] + hv[i * 2 + 1] * hv[i * 2 + 1];
    }
    ss = wave_total(ss);
    const float scl = rsqrtf(ss * (1.f / D) + 1e-6f);
    float gv[16];
    {
      const float* gp = gnext + lane * 16;
      float4 g0 = *(const float4*)(gp), g1 = *(const float4*)(gp + 4), g2 = *(const float4*)(gp + 8), g3 = *(const float4*)(gp + 12);
      float gt[16] = {g0.x, g0.y, g0.z, g0.w, g1.x, g1.y, g1.z, g1.w, g2.x, g2.y, g2.z, g2.w, g3.x, g3.y, g3.z, g3.w};
#pragma unroll
      for (int i = 0; i < 16; ++i) gv[i] = hv[i] * scl * gt[i];
    }
    if (last) {
      *(float4*)(hp) = make_float4(gv[0], gv[1], gv[2], gv[3]); *(float4*)(hp + 4) = make_float4(gv[4], gv[5], gv[6], gv[7]);
      *(float4*)(hp + 8) = make_float4(gv[8], gv[9], gv[10], gv[11]); *(float4*)(hp + 12) = make_float4(gv[12], gv[13], gv[14], gv[15]);
    } else {
      *(float4*)(hp) = make_float4(hv[0], hv[1], hv[2], hv[3]); *(float4*)(hp + 4) = make_float4(hv[4], hv[5], hv[6], hv[7]);
      *(float4*)(hp + 8) = make_float4(hv[8], hv[9], hv[10], hv[11]); *(float4*)(hp + 12) = make_float4(hv[12], hv[13], hv[14], hv[15]);
      bfu* up = (bfu*)(p.ws + O_ACT) + (size_t)t * D + lane * 16;
      *(uint4*)(up) = make_uint4(pack2(gv[0], gv[1]), pack2(gv[2], gv[3]), pack2(gv[4], gv[5]), pack2(gv[6], gv[7]));
      *(uint4*)(up + 8) = make_uint4(pack2(gv[8], gv[9]), pack2(gv[10], gv[11]), pack2(gv[12], gv[13]), pack2(gv[14], gv[15]));
    }
  }
}

#include <cstdint>
#define XB_TMO      128
#define XB_XCNT(j)  (256  + 64 * (j))
#define XB_XSUB(j)  (1280 + 64 * (j))
#define XB_XGEN(j)  (2304 + 64 * (j))
#define XB_TOP      3328
#define XB_TOPGEN   3392
#define XCD_BAR_WORDS 3456
#define XB_SPIN_CAP (1u << 18)
#define LAS __attribute__((address_space(3)))

__device__ __forceinline__ unsigned xb_ld(unsigned* p)              { return __hip_atomic_load(p, __ATOMIC_RELAXED, __HIP_MEMORY_SCOPE_AGENT); }
__device__ __forceinline__ unsigned xb_add(unsigned* p, unsigned v) { return __hip_atomic_fetch_add(p, v, __ATOMIC_RELAXED, __HIP_MEMORY_SCOPE_AGENT); }
__device__ __forceinline__ unsigned xb_xcc_id() { return (unsigned)__builtin_amdgcn_s_getreg((3 << 11) | 20) & 0xFu; }
#define XB_SPIN(cond, bar) do { unsigned _sp = 0; while (cond) { __builtin_amdgcn_s_sleep(1); \
    if ((++_sp & 255u) == 0u) { if (xb_ld(&(bar)[XB_TMO])) break; if (_sp > XB_SPIN_CAP) { atomicAdd(&(bar)[XB_TMO], 1u); break; } } } } while (0)

struct XcdBarrier {
    unsigned* bar; unsigned x;
    volatile LAS unsigned* st;
};

__device__ __forceinline__ XcdBarrier xcd_barrier_post(unsigned* bar, volatile LAS unsigned* st) {
    XcdBarrier b; b.bar = bar; b.x = xb_xcc_id(); b.st = st;
    if (threadIdx.x == 0) (void)xb_add(&bar[XB_XCNT(b.x)], 1u);
    return b;
}
__device__ __forceinline__ void xcd_barrier_complete(unsigned* bar, unsigned x, unsigned& nloc, unsigned& nx) {
    const unsigned G = gridDim.x * gridDim.y * gridDim.z;
    unsigned sum, cnt, mine, sp = 0u;
    for (;;) {
        sum = 0u; cnt = 0u; mine = 0u;
#pragma unroll
        for (unsigned j = 0; j < 16; ++j) { const unsigned c = xb_ld(&bar[XB_XCNT(j)]); sum += c; cnt += (c > 0u) ? 1u : 0u; mine = (j == x) ? c : mine; }
        if (sum == G) break;
        __builtin_amdgcn_s_sleep(1);
        if ((++sp & 255u) == 0u) { if (xb_ld(&bar[XB_TMO])) break; if (sp > XB_SPIN_CAP) { atomicAdd(&bar[XB_TMO], 1u); break; } }
    }
    nloc = mine > 0u ? mine : 1u; nx = cnt > 0u ? cnt : 1u;
}

__device__ __forceinline__ void xcd_barrier(const XcdBarrier& b) {
    asm volatile("s_waitcnt vmcnt(0)" ::: "memory");
    __syncthreads();
    if (threadIdx.x == 0) {
        unsigned* bar = b.bar;
        __builtin_amdgcn_s_waitcnt(0);
        unsigned nloc = b.st[0], nx = b.st[1];
        if (nloc == 0u) { xcd_barrier_complete(bar, b.x, nloc, nx); b.st[0] = nloc; b.st[1] = nx; }
        const unsigned old = xb_add(&bar[XB_XSUB(b.x)], 1u);
        const unsigned gen = old / nloc;
        if (old + 1u == (gen + 1u) * nloc) {
            __builtin_amdgcn_fence(__ATOMIC_RELEASE, "agent");
            asm volatile("s_waitcnt vmcnt(0)" ::: "memory");
            const unsigned og = xb_add(&bar[XB_TOP], 1u);
            const unsigned tg = og / nx;
            if (og + 1u == (tg + 1u) * nx) xb_add(&bar[XB_TOPGEN], 1u);
            else XB_SPIN(xb_ld(&bar[XB_TOPGEN]) == tg, bar);
            __builtin_amdgcn_fence(__ATOMIC_ACQUIRE, "agent");
            xb_add(&bar[XB_XGEN(b.x)], 1u);
            asm volatile("s_waitcnt vmcnt(0)" ::: "memory");
        } else {
            XB_SPIN(xb_ld(&bar[XB_XGEN(b.x)]) == gen, bar);
            __builtin_amdgcn_fence(__ATOMIC_ACQUIRE, "agent");
            asm volatile("s_waitcnt vmcnt(0)" ::: "memory");
        }
    }
    __syncthreads();
}

__shared__ uint4 xb_words;
DEV void seam_barrier(unsigned char* ws) {
  XcdBarrier b; b.bar = (unsigned*)(ws + O_XB); b.x = xb_xcc_id(); b.st = (volatile LAS unsigned*)&xb_words;
  xcd_barrier(b);
}

DEV void launder_all(Params& q) {
  const float** pp = (const float**)&q;
#pragma unroll
  for (int i = 0; i < 39; ++i) { const float* t = pp[i]; asm volatile("" : "+s"(t)); pp[i] = t; }
}
__global__ void __launch_bounds__(NTHR, 2) fwd_megakernel(Params p0) {
  cg::grid_group grid = cg::this_grid();
  int ph = 0;
  if (threadIdx.x == 0) xb_words = make_uint4(0u, 0u, 0u, 0u);
  __syncthreads();
#define PHASE(body) { if (ph >= p0.ph_lo && ph < p0.ph_hi) { Params q_ = p0; launder_all(q_); { const Params& p = q_; body; } \
    if (ph + 1 < p0.ph_hi) { if (ph == 0) { grid.sync(); (void)xcd_barrier_post((unsigned*)(q_.ws + O_XB), (volatile LAS unsigned*)&xb_words); } else seam_barrier(q_.ws); } } ++ph; }
  PHASE(phase_convert(p); phase_norm(p.x, p.mix_norm, (bfu*)(p.ws + O_ACT)))
  for (int l = 0; l < DEPTH; ++l) {
#define wb (p.ws + O_W + (size_t)l * W_SZ)
    PHASE(for (int rep = 0; rep < R_GEMM; ++rep) gemm_phase<0>((const bfu*)(p.ws + O_ACT), (const bfu*)(wb + W_IN), NIN, 1024, (bfu*)(p.ws + O_COLS), NIN, (float*)(p.ws + O_SIDE), nullptr, nullptr))
    PHASE(for (int rep = 0; rep < R_PREP; ++rep) phase_rwkv_prep(p, l))
    PHASE(phase_mix_scan_finish(p, l))
    PHASE(phase_rwkv_post(p, l))
    PHASE(gemm_phase<1>((const bfu*)(p.ws + O_ACT), (const bfu*)(wb + W_OUT), 1024, 1024, nullptr, 0, nullptr, l == 0 ? p.x : p.out, p.out); convert_peer_uv(p, l))
    PHASE(phase_norm(p.out, p.ffn_norm + (size_t)l * D, (bfu*)(p.ws + O_ACT)))
    PHASE(for (int rep = 0; rep < R_GEMM; ++rep) gemm_phase<2>((const bfu*)(p.ws + O_ACT), (const bfu*)(wb + W_Q), 2048, 1024, (bfu*)(p.ws + O_PQ), 2048, nullptr, nullptr, nullptr))
    PHASE(for (int rep = 0; rep < R_TOPK; ++rep) phase_peer_topk(p, l))
    PHASE(phase_peer_gather(p, l + 1 < DEPTH ? p.mix_norm + (size_t)(l + 1) * D : p.final_norm, l + 1 == DEPTH))
  }
}

extern "C" void kernel_launch(void* const* d_in, const int* in_sizes, int n_in, void* d_out, int out_size, void* d_ws, size_t ws_size,
                              hipStream_t stream) {
  static int grid_blocks = 0;
  if (!grid_blocks) {
    int dev = 0, cus = 0, per_cu = 0;
    hipGetDevice(&dev);
    hipDeviceGetAttribute(&cus, hipDeviceAttributeMultiprocessorCount, dev);
    hipOccupancyMaxActiveBlocksPerMultiprocessor(&per_cu, fwd_megakernel, NTHR, 0);
    if (per_cu > 2) per_cu = 2;
    grid_blocks = cus * per_cu;
  }
  Params p{};
  const float** pp = (const float**)&p;
  for (int i = 0; i < 37; ++i) pp[i] = (const float*)d_in[i];
  p.out = (float*)d_out; p.ws = (unsigned char*)d_ws; p.ph_lo = 0; p.ph_hi = 1000;
  void* args[] = {&p};
  hipError_t e = hipLaunchCooperativeKernel((void*)fwd_megakernel, dim3(grid_blocks), dim3(NTHR), args, 0, stream);
  if (e != hipSuccess) fprintf(stderr, "cooperative launch failed: %s (grid %d)\n", hipGetErrorString(e), grid_blocks);
}
```

```cpp
#include <hip/hip_runtime.h>
#include <hip/hip_bf16.h>
#include <hip/hip_cooperative_groups.h>
#include <cstdio>
namespace cg = cooperative_groups;

typedef unsigned short bfu;
using bf16x8 = __attribute__((ext_vector_type(8))) short;
using f32x4 = __attribute__((ext_vector_type(4))) float;

#define DEV __device__ __forceinline__

constexpr int Bsz = 4, S = 8192, T = Bsz * S, D = 1024, NIN = 2960, DEPTH = 2;
constexpr int C_SSM = 0, C_LRU = 772, C_RWKV = 1284, C_NSA = 2308;
constexpr int C_Z = 0, C_XBC = 256, C_DT = 768;
constexpr int C_LG = 772, C_LX = 1028;
constexpr int C_Q = 2308, C_KC = 2564, C_VC = 2628, C_KS = 2692, C_VS = 2756, C_KW = 2820, C_VW = 2884, C_GT = 2948;
constexpr int NCH = 128;
constexpr int NTHR = 256;
#ifndef R_GEMM
#define R_GEMM 1
#endif
#ifndef R_PREP
#define R_PREP 1
#endif
#ifndef R_SCAN
#define R_SCAN 1
#endif
#ifndef R_FIN
#define R_FIN 1
#endif
#ifndef R_TOPK
#define R_TOPK 1
#endif
#ifndef R_GATH
#define R_GATH 1
#endif
#ifndef R_CMPA
#define R_CMPA 1
#endif

constexpr size_t AL(size_t x) { return (x + 255) & ~(size_t)255; }
constexpr size_t O_ACT = 0;
constexpr size_t O_COLS = O_ACT + AL((size_t)T * 1024 * 2);
constexpr size_t O_SIDE = O_COLS + AL((size_t)T * NIN * 2);
constexpr size_t O_RIN = O_SIDE + AL((size_t)T * 16 * 4);
constexpr size_t O_RY = O_RIN + AL((size_t)16 * S * 896);
constexpr size_t O_RG = O_RY + AL((size_t)T * 256 * 4);
constexpr size_t O_SST = O_RG + AL((size_t)T * 256 * 2);
constexpr size_t O_SAT = O_SST + AL((size_t)16 * NCH * 4096 * 4);
constexpr size_t O_LA = O_SAT + AL((size_t)16 * NCH * 4);
constexpr size_t O_LH = O_LA + AL((size_t)4 * NCH * 256 * 4);
constexpr size_t O_KCMP = O_LH + AL((size_t)4 * NCH * 256 * 4);
constexpr size_t O_VCT = O_KCMP + AL((size_t)4 * 512 * 64 * 2);
constexpr size_t O_VWT = O_VCT + AL((size_t)4 * 512 * 64 * 2);
constexpr size_t O_VST = O_VWT + AL((size_t)4 * 64 * S * 2);
constexpr size_t O_OCMP = O_VST + AL((size_t)4 * 64 * S * 2);
constexpr size_t O_SEL = O_OCMP + AL((size_t)T * 256 * 2);
constexpr size_t O_SYNC = O_SEL + AL((size_t)T * 16);
constexpr size_t O_XB = O_SYNC + 256;
constexpr size_t O_W = O_XB + 16384;
constexpr size_t W_IN = 0;
constexpr size_t W_OUT = W_IN + AL((size_t)NIN * 1024 * 2);
constexpr size_t W_Q = W_OUT + AL((size_t)1024 * 1024 * 2);
constexpr size_t W_KEYS = W_Q + AL((size_t)2048 * 1024 * 2);
constexpr size_t W_C1 = W_KEYS + AL((size_t)16 * 128 * 128 * 2);
constexpr size_t W_C2 = W_C1 + AL((size_t)2 * 256 * 2048 * 2);
constexpr size_t W_LA = W_C2 + AL((size_t)2 * 64 * 256 * 2);
constexpr size_t W_LI = W_LA + AL((size_t)4 * 64 * 64 * 2);
constexpr size_t W_R2 = W_LI + AL((size_t)4 * 64 * 64 * 2);
constexpr size_t W_A2 = W_R2 + AL((size_t)256 * 64 * 2);
constexpr size_t W_G2 = W_A2 + AL((size_t)256 * 64 * 2);
constexpr size_t W_SZ = W_G2 + AL((size_t)256 * 128 * 2);
constexpr size_t O_END = O_W + 2 * W_SZ;
constexpr size_t O_PU = O_COLS;
constexpr size_t O_PV = O_PU + AL((size_t)16384 * 1024);
constexpr size_t O_PQ = O_PV + AL((size_t)16384 * 1024);
constexpr size_t O_PE = O_PQ + AL((size_t)T * 2048 * 2);
constexpr size_t O_PG = O_PE + AL((size_t)T * 128 * 4);
constexpr size_t O_PEND = O_PG + AL((size_t)T * 128 * 4);
static_assert(O_PEND <= O_RY, "peer scratch overlaps live buffers");
static_assert(O_END <= (size_t)536870912, "workspace too large");

struct Params {
  const float* x; const float* mix_norm; const float* w_in; const float* w_out;
  const float* ssm_conv_w; const float* ssm_conv_b; const float* ssm_dt_bias; const float* ssm_a_log; const float* ssm_d; const float* ssm_norm;
  const float* lru_conv_w; const float* lru_conv_b; const float* lru_wa; const float* lru_ba; const float* lru_wi; const float* lru_bi; const float* lru_lambda;
  const float* rwkv_mu; const float* rwkv_w0; const float* rwkv_w2; const float* rwkv_a0; const float* rwkv_a2; const float* rwkv_g2;
  const float* rwkv_kk; const float* rwkv_ka; const float* rwkv_rk; const float* rwkv_ln_w; const float* rwkv_ln_b;
  const float* nsa_cmp_pos; const float* nsa_cmp_w1; const float* nsa_cmp_w2;
  const float* ffn_norm; const float* peer_wq; const float* peer_keys; const float* peer_u; const float* peer_v; const float* final_norm;
  float* out; unsigned char* ws;
  int ph_lo, ph_hi;
};

DEV int tid_() { int t = threadIdx.x; asm volatile("" : "+v"(t)); return t; }
DEV int bid_() { int b = blockIdx.x; asm volatile("" : "+s"(b)); return b; }
DEV bfu f2bf(float f) { unsigned u = __float_as_uint(f); u += 0x7fffu + ((u >> 16) & 1u); return (bfu)(u >> 16); }
DEV float bf2f(bfu b) { return __uint_as_float(((unsigned)b) << 16); }
DEV unsigned pack2(float a, float b) { return (unsigned)f2bf(a) | ((unsigned)f2bf(b) << 16); }
DEV float lo2f(unsigned u) { return __uint_as_float(u << 16); }
DEV float hi2f(unsigned u) { return __uint_as_float(u & 0xffff0000u); }
DEV float sigmoidf_(float x) { return 1.f / (1.f + __expf(-x)); }
DEV float siluf_(float x) { return x / (1.f + __expf(-x)); }
DEV float softplusf_(float x) { return fmaxf(x, 0.f) + log1pf(__expf(-fabsf(x))); }
DEV float geluf_(float x) { float u = 0.7978845608028654f * (x + 0.044715f * x * x * x); return 0.5f * x * (1.f + tanhf(u)); }

template <int CTRL> DEV float dppf(float v) {
  return __int_as_float(__builtin_amdgcn_update_dpp(0, __float_as_int(v), CTRL, 0xf, 0xf, true));
}
DEV float row16_sum(float v) { v += dppf<0xB1>(v); v += dppf<0x4E>(v); v += dppf<0x141>(v); v += dppf<0x140>(v); return v; }
DEV float row16_max(float v) { v = fmaxf(v, dppf<0xB1>(v)); v = fmaxf(v, dppf<0x4E>(v)); v = fmaxf(v, dppf<0x141>(v)); v = fmaxf(v, dppf<0x140>(v)); return v; }
DEV float wave_sum(float v) { v = row16_sum(v); v += __shfl_xor(v, 16); v += __shfl_xor(v, 32); return v; }

DEV bf16x8 ld8(const bfu* p) { return *(const bf16x8*)p; }
DEV f32x4 mfma16(bf16x8 a, bf16x8 b, f32x4 c) { return __builtin_amdgcn_mfma_f32_16x16x32_bf16(a, b, c, 0, 0, 0); }

DEV void mfma16_acc(f32x4& c, bf16x8 a, bf16x8 b) { asm("v_mfma_f32_16x16x32_bf16 %0, %1, %2, %0" : "+a"(c) : "v"(a), "v"(b)); }
DEV void gld_async(bf16x8& v, const bfu* p) { asm volatile("global_load_dwordx4 %0, %1, off" : "=v"(v) : "v"(p) : "memory"); }
template <int N> DEV void gwait6(bf16x8& a0, bf16x8& a1, bf16x8& a2, bf16x8& a3, bf16x8& b0, bf16x8& b1) {
  asm volatile("s_waitcnt vmcnt(%6)" : "+v"(a0), "+v"(a1), "+v"(a2), "+v"(a3), "+v"(b0), "+v"(b1) : "n"(N) : "memory");
}
__shared__ __attribute__((aligned(16))) unsigned char smem[61440];
__shared__ int s_qitem;

DEV void transpose_tile(const float* src, bfu* dst, int R, int C, int tr, int tc) {
  float* tl = (float*)smem;
  int tid = tid_();
  __syncthreads();
  for (int i = tid; i < 4096; i += NTHR) {
    int r = i >> 6, c = i & 63;
    int gr = tr * 64 + r, gc = tc * 64 + c;
    tl[r * 65 + c] = (gr < R && gc < C) ? src[(size_t)gr * C + gc] : 0.f;
  }
  __syncthreads();
  for (int i = tid; i < 4096; i += NTHR) {
    int c = i >> 6, r = i & 63;
    int gr = tr * 64 + r, gc = tc * 64 + c;
    if (gr < R && gc < C) dst[(size_t)gc * R + gr] = f2bf(tl[r * 65 + c]);
  }
}
struct TJob { const float* src; bfu* dst; int R, C; };
DEV void phase_convert(const Params& p) {
  if (bid_() == 0) { if (tid_() < 64) ((unsigned*)(p.ws + O_SYNC))[tid_()] = 0u; for (int i = tid_(); i < 4096; i += NTHR) ((unsigned*)(p.ws + O_XB))[i] = 0u; }
  for (int l = 0; l < DEPTH; ++l) {
    unsigned char* wb = p.ws + O_W + (size_t)l * W_SZ;
    for (int j = 0; j < 20; ++j) {
      const float* src; bfu* dst; int R, C;
      if (j == 0) { src = p.w_in + (size_t)l * 1024 * NIN; dst = (bfu*)(wb + W_IN); R = 1024; C = NIN; }
      else if (j == 1) { src = p.w_out + (size_t)l * 1024 * 1024; dst = (bfu*)(wb + W_OUT); R = 1024; C = 1024; }
      else if (j == 2) { src = p.peer_wq + (size_t)l * 1024 * 2048; dst = (bfu*)(wb + W_Q); R = 1024; C = 2048; }
      else if (j < 5) { int k = j - 3; src = p.nsa_cmp_w1 + ((size_t)l * 2 + k) * 2048 * 256; dst = (bfu*)(wb + W_C1) + (size_t)k * 256 * 2048; R = 2048; C = 256; }
      else if (j < 7) { int k = j - 5; src = p.nsa_cmp_w2 + ((size_t)l * 2 + k) * 256 * 64; dst = (bfu*)(wb + W_C2) + (size_t)k * 64 * 256; R = 256; C = 64; }
      else if (j < 11) { int k = j - 7; src = p.lru_wa + ((size_t)l * 4 + k) * 4096; dst = (bfu*)(wb + W_LA) + k * 4096; R = 64; C = 64; }
      else if (j < 15) { int k = j - 11; src = p.lru_wi + ((size_t)l * 4 + k) * 4096; dst = (bfu*)(wb + W_LI) + k * 4096; R = 64; C = 64; }
      else if (j == 15) { src = p.rwkv_w2 + (size_t)l * 64 * 256; dst = (bfu*)(wb + W_R2); R = 64; C = 256; }
      else if (j == 16) { src = p.rwkv_a2 + (size_t)l * 64 * 256; dst = (bfu*)(wb + W_A2); R = 64; C = 256; }
      else if (j == 17) { src = p.rwkv_g2 + (size_t)l * 128 * 256; dst = (bfu*)(wb + W_G2); R = 128; C = 256; }
      else continue;
      int ntr = (R + 63) / 64, ntc = (C + 63) / 64;
      for (int t = bid_(); t < ntr * ntc; t += gridDim.x) transpose_tile(src, dst, R, C, t / ntc, t % ntc);
    }
    {
      const float* src = p.peer_keys + (size_t)l * 16 * 128 * 128; bfu* dst = (bfu*)(wb + W_KEYS);
      for (int i = bid_() * NTHR + tid_(); i < 16 * 128 * 128; i += gridDim.x * NTHR) dst[i] = f2bf(src[i]);
    }
  }
}
constexpr float PU_SCALE = 512.f, PV_SCALE = 128.f;
DEV unsigned pack_fp8x4(float a, float b, float c, float d, float sc) {
  a = fminf(fmaxf(a * sc, -448.f), 448.f); b = fminf(fmaxf(b * sc, -448.f), 448.f);
  c = fminf(fmaxf(c * sc, -448.f), 448.f); d = fminf(fmaxf(d * sc, -448.f), 448.f);
  int w = 0;
  w = __builtin_amdgcn_cvt_pk_fp8_f32(a, b, w, false);
  w = __builtin_amdgcn_cvt_pk_fp8_f32(c, d, w, true);
  return (unsigned)w;
}
DEV void convert_peer_uv(const Params& p, int l) {
  typedef float f4v __attribute__((ext_vector_type(4)));
  const f4v* su = (const f4v*)(p.peer_u + (size_t)l * 16384 * 1024);
  const f4v* sv = (const f4v*)(p.peer_v + (size_t)l * 16384 * 1024);
  unsigned* duv = (unsigned*)(p.ws + O_PU);
  const int n4 = 16384 * 1024 / 4;
  const int stride = gridDim.x * NTHR;
  for (int i0 = bid_() * NTHR + tid_(); i0 < n4; i0 += stride * 4) {
    f4v a[4], b[4];
#pragma unroll
    for (int k = 0; k < 4; ++k) {
      const int i = i0 + k * stride;
      if (i < n4) { a[k] = __builtin_nontemporal_load(su + i); b[k] = __builtin_nontemporal_load(sv + i); }
    }
#pragma unroll
    for (int k = 0; k < 4; ++k) {
      const int i = i0 + k * stride;
      if (i < n4) {
        const int e = i >> 8, c = i & 255;
        duv[e * 512 + c] = pack_fp8x4(a[k].x, a[k].y, a[k].z, a[k].w, PU_SCALE);
        duv[e * 512 + 256 + c] = pack_fp8x4(b[k].x, b[k].y, b[k].z, b[k].w, PV_SCALE);
      }
    }
  }
}

DEV void phase_norm(const float* h, const float* g, bfu* dst) {
  int lane = tid_() & 63, wv = tid_() >> 6;
  for (int t = bid_() * 4 + wv; t < T; t += gridDim.x * 4) {
    const float4* hp = (const float4*)(h + (size_t)t * D);
    float4 v[4]; float ss = 0.f;
#pragma unroll
    for (int i = 0; i < 4; ++i) { v[i] = hp[lane + i * 64]; ss += v[i].x * v[i].x + v[i].y * v[i].y + v[i].z * v[i].z + v[i].w * v[i].w; }
    ss = wave_sum(ss);
    float sc = rsqrtf(ss * (1.f / D) + 1e-6f);
#pragma unroll
    for (int i = 0; i < 4; ++i) {
      float4 gg = ((const float4*)g)[lane + i * 64];
      uint2 o = make_uint2(pack2(v[i].x * sc * gg.x, v[i].y * sc * gg.y), pack2(v[i].z * sc * gg.z, v[i].w * sc * gg.w));
      ((uint2*)(dst + (size_t)t * D))[lane + i * 64] = o;
    }
  }
}

template <int N> DEV void gwait4(bf16x8& a0, bf16x8& a1, bf16x8& b0, bf16x8& b1) {
  asm volatile("s_waitcnt vmcnt(%4)" : "+v"(a0), "+v"(a1), "+v"(b0), "+v"(b1) : "n"(N) : "memory");
}
template <int MODE>
DEV void gemm_phase(const bfu* __restrict__ A, const bfu* __restrict__ Bt, int N, int K,
                    bfu* __restrict__ Cb, int ldc, float* __restrict__ side, const float* __restrict__ hin, float* __restrict__ hout) {
  constexpr int STR = 32;
  constexpr int BUFE = 256 * STR;
  bfu* As = (bfu*)smem;
  bfu* Bs = As + 128 * STR;
  const int tid = tid_(), lane = tid & 63, wv = tid >> 6;
  const int wm = wv >> 1, wn = wv & 1;
  const int ntn = (N + 127) / 128, ntm = T / 128;
  const int lr = lane & 15, lq = lane >> 4;
  const int swz = (lq ^ ((0x1320 >> (((lr >> 2) & 3) * 4)) & 3)) * 8;
  const int bid = bid_();
  const bool xmap = (gridDim.x & 7) == 0;
  const int ns = (ntn >= 16) ? 2 : 1;
  const int xcd = bid & 7, nloc = xmap ? (int)(gridDim.x >> 3) : (int)gridDim.x;
  const int ntn_p = xmap ? ntn / ns : ntn, mstep = xmap ? 8 / ns : 1;
  const int xs = xmap ? xcd % ns : 0, xm = xmap ? xcd / ns : 0;
  const int ntile_x = xmap ? (ntm / mstep) * ntn_p : ntm * ntn;
  for (int u = xmap ? (bid >> 3) : bid; u < ntile_x; u += nloc) {
    const int tm = (u / ntn_p) * mstep + xm, tn = xs * ntn_p + (u % ntn_p);
    const int m0 = tm * 128, n0 = tn * 128;
    f32x4 acc[4][4];
#pragma unroll
    for (int i = 0; i < 4; ++i)
#pragma unroll
      for (int j = 0; j < 4; ++j) acc[i][j] = (f32x4){0.f, 0.f, 0.f, 0.f};
    const bfu* ap[2]; const bfu* bp[2]; int so[2];
#pragma unroll
    for (int i = 0; i < 2; ++i) {
      int c = tid + i * NTHR; int row = c >> 2, kc = c & 3;
      ap[i] = A + (size_t)(m0 + row) * K + kc * 8;
      so[i] = row * STR + ((kc ^ ((0x1320 >> (((row >> 2) & 3) * 4)) & 3)) * 8);
      int nr = n0 + row; if (nr > N - 1) nr = N - 1;
      bp[i] = Bt + (size_t)nr * K + kc * 8;
    }
    bf16x8 ra[2][2], rb[2][2];
    __syncthreads();
#pragma unroll
    for (int i = 0; i < 2; ++i) { *(bf16x8*)(As + so[i]) = ld8(ap[i]); *(bf16x8*)(Bs + so[i]) = ld8(bp[i]); }
#pragma unroll
    for (int q = 0; q < 2; ++q)
#pragma unroll
      for (int i = 0; i < 2; ++i) { gld_async(ra[q][i], ap[i] + (q + 1) * 32); gld_async(rb[q][i], bp[i] + (q + 1) * 32); }
    const int nst = K / 32;
    for (int st = 0; st < nst; st += 2) {
#pragma unroll
      for (int q = 0; q < 2; ++q) {
        const int sidx = st + q;
        const bfu* Ar = As + q * BUFE;
        const bfu* Br = Bs + q * BUFE;
        bfu* Aw = As + (q ^ 1) * BUFE;
        bfu* Bw = Bs + (q ^ 1) * BUFE;
        __syncthreads();
        bf16x8 af[4], bfr[4];
#pragma unroll
        for (int i = 0; i < 4; ++i) af[i] = *(const bf16x8*)(Ar + (wm * 64 + i * 16 + lr) * STR + swz);
#pragma unroll
        for (int j = 0; j < 4; ++j) bfr[j] = *(const bf16x8*)(Br + (wn * 64 + j * 16 + lr) * STR + swz);
        const int kn = (sidx + 3 < nst ? sidx + 3 : nst - 1) * 32;
        gwait4<4>(ra[q][0], ra[q][1], rb[q][0], rb[q][1]);
#pragma unroll
        for (int i = 0; i < 2; ++i) { *(bf16x8*)(Aw + so[i]) = ra[q][i]; *(bf16x8*)(Bw + so[i]) = rb[q][i]; }
#pragma unroll
        for (int i = 0; i < 2; ++i) { gld_async(ra[q][i], ap[i] + kn); gld_async(rb[q][i], bp[i] + kn); }
#pragma unroll
        for (int i = 0; i < 4; ++i)
#pragma unroll
          for (int j = 0; j < 4; ++j) mfma16_acc(acc[i][j], bfr[j], af[i]);
      }
    }
#pragma unroll
    for (int q = 0; q < 2; ++q) gwait4<0>(ra[q][0], ra[q][1], rb[q][0], rb[q][1]);
    asm volatile("s_nop 7\n\ts_nop 7\n\ts_nop 7" ::: "memory");
#pragma unroll
    for (int i = 0; i < 4; ++i) {
      const int row = m0 + wm * 64 + i * 16 + lr;
#pragma unroll
      for (int j = 0; j < 4; ++j) {
        const int col = n0 + wn * 64 + j * 16 + lq * 4;
        const f32x4 v = acc[i][j];
        if (MODE == 0) {
          if (col < N) {
            *(uint2*)(Cb + (size_t)row * ldc + col) = make_uint2(pack2(v[0], v[1]), pack2(v[2], v[3]));
            if (col == C_DT) *(float4*)(side + (size_t)row * 16) = make_float4(v[0], v[1], v[2], v[3]);
            if (col >= C_GT) *(float4*)(side + (size_t)row * 16 + 4 + (col - C_GT)) = make_float4(v[0], v[1], v[2], v[3]);
          }
        } else if (MODE == 1) {
          const size_t o = (size_t)row * D + col;
          const float4 h = *(const float4*)(hin + o);
          *(float4*)(hout + o) = make_float4(h.x + v[0], h.y + v[1], h.z + v[2], h.w + v[3]);
        } else {
          *(uint2*)(Cb + (size_t)row * ldc + col) = make_uint2(pack2(v[0], v[1]), pack2(v[2], v[3]));
        }
      }
    }
  }
}

template <int MODE>
DEV void ssd_item(const Params& p, int l, int item) {
  const int g = item & 1, c = (item >> 1) & 127, b = item >> 8;
  const int tid = tid_(), lane = tid & 63, wv = tid >> 6, lr = lane & 15, lq = lane >> 4;
  const bfu* COLS = (const bfu*)(p.ws + O_COLS);
  const float* SIDE = (const float*)(p.ws + O_SIDE);
  float* ST = (float*)(p.ws + O_SST);
  const int tb = b * S + c * 64;
  float* s_dt = (float*)smem;
  float* s_acs = s_dt + 128;
  bfu* XT = (bfu*)(smem + 1024);
  bfu* Bm = XT + 128 * 72;
  bfu* Cm = Bm + 64 * 72;
  bfu* Mw = Cm + 64 * 72 + wv * (16 * 72);
  __syncthreads();
  if (wv < 2) {
    int h = g * 2 + wv;
    float dtv = softplusf_(SIDE[(size_t)(tb + lane) * 16 + h] + p.ssm_dt_bias[l * 4 + h]);
    float s = -__expf(p.ssm_a_log[l * 4 + h]) * dtv;
    for (int o = 1; o < 64; o <<= 1) { float t = __shfl_up(s, o); if (lane >= o) s += t; }
    s_dt[wv * 64 + lane] = dtv; s_acs[wv * 64 + lane] = s;
  }
  __syncthreads();
  {
    const int cg8 = tid & 31, tg = tid >> 5;
    const int lc = cg8 * 8;
    const int xc = (lc < 128) ? (g * 128 + lc) : (lc < 192 ? 256 + g * 64 + (lc - 128) : 384 + g * 64 + (lc - 192));
    if (MODE == 1 || lc < 192) {
      float w[4][8], bias[8];
#pragma unroll
      for (int i = 0; i < 8; ++i) {
        bias[i] = p.ssm_conv_b[l * 512 + xc + i];
#pragma unroll
        for (int k = 0; k < 4; ++k) w[k][i] = p.ssm_conv_w[(l * 4 + k) * 512 + xc + i];
      }
      const int tl0 = tg * 8;
      float win[3][8];
      float outv[8][8];
#pragma unroll
      for (int rr = 0; rr < 11; ++rr) {
        int tl = tl0 - 3 + rr; int tpos = c * 64 + tl;
        float cur[8];
        if (tpos >= 0) {
          uint4 u = *(const uint4*)(COLS + (size_t)(b * S + tpos) * NIN + C_XBC + xc);
          cur[0] = lo2f(u.x); cur[1] = hi2f(u.x); cur[2] = lo2f(u.y); cur[3] = hi2f(u.y); cur[4] = lo2f(u.z); cur[5] = hi2f(u.z); cur[6] = lo2f(u.w); cur[7] = hi2f(u.w);
        } else {
#pragma unroll
          for (int i = 0; i < 8; ++i) cur[i] = 0.f;
        }
        if (rr >= 3) {
#pragma unroll
          for (int i = 0; i < 8; ++i) {
            float a = bias[i] + w[0][i] * win[0][i] + w[1][i] * win[1][i] + w[2][i] * win[2][i] + w[3][i] * cur[i];
            outv[rr - 3][i] = siluf_(a);
          }
        }
#pragma unroll
        for (int i = 0; i < 8; ++i) { win[0][i] = win[1][i]; win[1][i] = win[2][i]; win[2][i] = cur[i]; }
      }
      if (lc < 128) {
        const int hh = lc >> 6;
        float sc[8];
#pragma unroll
        for (int j = 0; j < 8; ++j) {
          float d = s_dt[hh * 64 + tl0 + j];
          if (MODE == 0) d *= __expf(s_acs[hh * 64 + 63] - s_acs[hh * 64 + tl0 + j]);
          sc[j] = d;
        }
#pragma unroll
        for (int i = 0; i < 8; ++i) {
          uint4 o = make_uint4(pack2(outv[0][i] * sc[0], outv[1][i] * sc[1]), pack2(outv[2][i] * sc[2], outv[3][i] * sc[3]),
                               pack2(outv[4][i] * sc[4], outv[5][i] * sc[5]), pack2(outv[6][i] * sc[6], outv[7][i] * sc[7]));
          *(uint4*)(XT + (lc + i) * 72 + tl0) = o;
        }
      } else if (lc < 192) {
        if (MODE == 0) {
#pragma unroll
          for (int i = 0; i < 8; ++i) {
            uint4 o = make_uint4(pack2(outv[0][i], outv[1][i]), pack2(outv[2][i], outv[3][i]), pack2(outv[4][i], outv[5][i]), pack2(outv[6][i], outv[7][i]));
            *(uint4*)(Bm + (lc - 128 + i) * 72 + tl0) = o;
          }
        } else {
#pragma unroll
          for (int j = 0; j < 8; ++j) {
            uint4 o = make_uint4(pack2(outv[j][0], outv[j][1]), pack2(outv[j][2], outv[j][3]), pack2(outv[j][4], outv[j][5]), pack2(outv[j][6], outv[j][7]));
            *(uint4*)(Bm + (tl0 + j) * 72 + (lc - 128)) = o;
          }
        }
      } else {
#pragma unroll
        for (int j = 0; j < 8; ++j) {
          uint4 o = make_uint4(pack2(outv[j][0], outv[j][1]), pack2(outv[j][2], outv[j][3]), pack2(outv[j][4], outv[j][5]), pack2(outv[j][6], outv[j][7]));
          *(uint4*)(Cm + (tl0 + j) * 72 + (lc - 192)) = o;
        }
      }
    }
  }
  __syncthreads();
  if (MODE == 0) {
    const int hh = wv >> 1, ph = wv & 1, h = g * 2 + hh;
    f32x4 acc[2][4];
#pragma unroll
    for (int i = 0; i < 2; ++i)
#pragma unroll
      for (int j = 0; j < 4; ++j) acc[i][j] = (f32x4){0.f, 0.f, 0.f, 0.f};
#pragma unroll
    for (int ks = 0; ks < 2; ++ks) {
      bf16x8 af[2], bfr[4];
#pragma unroll
      for (int i = 0; i < 2; ++i) af[i] = *(const bf16x8*)(XT + (hh * 64 + ph * 32 + i * 16 + lr) * 72 + ks * 32 + lq * 8);
#pragma unroll
      for (int j = 0; j < 4; ++j) bfr[j] = *(const bf16x8*)(Bm + (j * 16 + lr) * 72 + ks * 32 + lq * 8);
#pragma unroll
      for (int i = 0; i < 2; ++i)
#pragma unroll
        for (int j = 0; j < 4; ++j) acc[i][j] = mfma16(af[i], bfr[j], acc[i][j]);
    }
    float* dst = ST + ((size_t)((b * 4 + h) * NCH + c)) * 4096;
#pragma unroll
    for (int i = 0; i < 2; ++i)
#pragma unroll
      for (int j = 0; j < 4; ++j)
#pragma unroll
        for (int r = 0; r < 4; ++r) dst[(ph * 32 + i * 16 + lq * 4 + r) * 64 + j * 16 + lr] = acc[i][j][r];
    if (tid < 2) ((float*)(p.ws + O_SAT))[(b * 4 + g * 2 + tid) * NCH + c] = s_acs[tid * 64 + 63];
  } else {
    bf16x8 cf[2];
#pragma unroll
    for (int ks = 0; ks < 2; ++ks) cf[ks] = *(const bf16x8*)(Cm + (wv * 16 + lr) * 72 + ks * 32 + lq * 8);
    f32x4 G[4];
#pragma unroll
    for (int st = 0; st < 4; ++st) {
      G[st] = (f32x4){0.f, 0.f, 0.f, 0.f};
      if (st <= wv) {
#pragma unroll
        for (int ks = 0; ks < 2; ++ks) G[st] = mfma16(cf[ks], *(const bf16x8*)(Bm + (st * 16 + lr) * 72 + ks * 32 + lq * 8), G[st]);
      }
    }
    f32x4 Y[2][4];
#pragma unroll
    for (int hh = 0; hh < 2; ++hh) {
      const int h = g * 2 + hh;
      const float* Hs = ST + ((size_t)((b * 4 + h) * NCH + c)) * 4096;
      float al[4];
#pragma unroll
      for (int r = 0; r < 4; ++r) al[r] = s_acs[hh * 64 + wv * 16 + lq * 4 + r];
#pragma unroll
      for (int pt = 0; pt < 4; ++pt) {
        f32x4 y = {0.f, 0.f, 0.f, 0.f};
#pragma unroll
        for (int ks = 0; ks < 2; ++ks) {
          const float4* hp = (const float4*)(Hs + (pt * 16 + lr) * 64 + ks * 32 + lq * 8);
          float4 h0 = hp[0], h1 = hp[1];
          bf16x8 hb;
          unsigned u0 = pack2(h0.x, h0.y), u1 = pack2(h0.z, h0.w), u2 = pack2(h1.x, h1.y), u3 = pack2(h1.z, h1.w);
          hb[0] = (short)(u0 & 0xffff); hb[1] = (short)(u0 >> 16); hb[2] = (short)(u1 & 0xffff); hb[3] = (short)(u1 >> 16);
          hb[4] = (short)(u2 & 0xffff); hb[5] = (short)(u2 >> 16); hb[6] = (short)(u3 & 0xffff); hb[7] = (short)(u3 >> 16);
          y = mfma16(cf[ks], hb, y);
        }
#pragma unroll
        for (int r = 0; r < 4; ++r) y[r] *= __expf(al[r]);
        Y[hh][pt] = y;
      }
#pragma unroll
      for (int st = 0; st < 4; ++st) {
        float as = s_acs[hh * 64 + st * 16 + lr];
#pragma unroll
        for (int r = 0; r < 4; ++r) {
          int ll = wv * 16 + lq * 4 + r, ss = st * 16 + lr;
          float m = (ss <= ll) ? G[st][r] * __expf(al[r] - as) : 0.f;
          Mw[(lq * 4 + r) * 72 + st * 16 + lr] = f2bf(m);
        }
      }
      for (int ks = 0; ks <= (wv >> 1); ++ks) {
        bf16x8 ma = *(const bf16x8*)(Mw + lr * 72 + ks * 32 + lq * 8);
#pragma unroll
        for (int pt = 0; pt < 4; ++pt)
          Y[hh][pt] = mfma16(ma, *(const bf16x8*)(XT + (hh * 64 + pt * 16 + lr) * 72 + ks * 32 + lq * 8), Y[hh][pt]);
      }
    }
    float ssq[4] = {0.f, 0.f, 0.f, 0.f};
#pragma unroll
    for (int hh = 0; hh < 2; ++hh) {
      const int h = g * 2 + hh;
      const float dsk = p.ssm_d[l * 4 + h];
#pragma unroll
      for (int pt = 0; pt < 4; ++pt)
#pragma unroll
        for (int r = 0; r < 4; ++r) {
          int ll = wv * 16 + lq * 4 + r, pch = pt * 16 + lr;
          float xs = bf2f(XT[(hh * 64 + pch) * 72 + ll]) / s_dt[hh * 64 + ll];
          float z = bf2f(COLS[(size_t)(tb + ll) * NIN + C_Z + h * 64 + pch]);
          float y = (Y[hh][pt][r] + dsk * xs) * siluf_(z);
          Y[hh][pt][r] = y; ssq[r] += y * y;
        }
    }
    bfu* MIX = (bfu*)(p.ws + O_ACT);
#pragma unroll
    for (int r = 0; r < 4; ++r) {
      float sc = rsqrtf(row16_sum(ssq[r]) * (1.f / 128.f) + 1e-6f);
      int ll = wv * 16 + lq * 4 + r;
#pragma unroll
      for (int hh = 0; hh < 2; ++hh)
#pragma unroll
        for (int pt = 0; pt < 4; ++pt) {
          int ch = (g * 2 + hh) * 64 + pt * 16 + lr;
          MIX[(size_t)(tb + ll) * 1024 + ch] = f2bf(Y[hh][pt][r] * sc * p.ssm_norm[l * 256 + ch]);
        }
    }
  }
}
DEV void ssd_rec_item(const Params& p, int item) {
  const int bh = item >> 4, e = (item & 15) * 256 + tid_();
  float* ST = (float*)(p.ws + O_SST) + (size_t)bh * NCH * 4096 + e;
  const float* AT = (const float*)(p.ws + O_SAT) + bh * NCH;
  float H = 0.f;
  for (int c0 = 0; c0 < NCH; c0 += 8) {
    float s[8];
#pragma unroll
    for (int i = 0; i < 8; ++i) s[i] = ST[(size_t)(c0 + i) * 4096];
#pragma unroll
    for (int i = 0; i < 8; ++i) { ST[(size_t)(c0 + i) * 4096] = H; H = __expf(AT[c0 + i]) * H + s[i]; }
  }
}

template <int MODE>
DEV void lru_item(const Params& p, int l, int item) {
  const int hb = item & 3, c = (item >> 2) & 127, b = item >> 9;
  const int tid = tid_(), lane = tid & 63, wv = tid >> 6, lr = lane & 15, lq = lane >> 4;
  const bfu* COLS = (const bfu*)(p.ws + O_COLS);
  const int tb = b * S + c * 64;
  bfu* Xl = (bfu*)smem;
  float* Af = (float*)(smem + 9216);
  float* Uf = Af + 4096;
  __syncthreads();
  {
    const int cg8 = tid & 7, tg = tid >> 3;
    const int ch = hb * 64 + cg8 * 8;
    float w[4][8], bias[8];
#pragma unroll
    for (int i = 0; i < 8; ++i) {
      bias[i] = p.lru_conv_b[l * 256 + ch + i];
#pragma unroll
      for (int k = 0; k < 4; ++k) w[k][i] = p.lru_conv_w[(l * 4 + k) * 256 + ch + i];
    }
    float win[3][8];
#pragma unroll
    for (int rr = 0; rr < 5; ++rr) {
      int tl = tg * 2 - 3 + rr; int tpos = c * 64 + tl;
      float cur[8];
      if (tpos >= 0) {
        uint4 u = *(const uint4*)(COLS + (size_t)(b * S + tpos) * NIN + C_LX + ch);
        cur[0] = lo2f(u.x); cur[1] = hi2f(u.x); cur[2] = lo2f(u.y); cur[3] = hi2f(u.y); cur[4] = lo2f(u.z); cur[5] = hi2f(u.z); cur[6] = lo2f(u.w); cur[7] = hi2f(u.w);
      } else {
#pragma unroll
        for (int i = 0; i < 8; ++i) cur[i] = 0.f;
      }
      if (rr >= 3) {
        float o[8];
#pragma unroll
        for (int i = 0; i < 8; ++i) o[i] = bias[i] + w[0][i] * win[0][i] + w[1][i] * win[1][i] + w[2][i] * win[2][i] + w[3][i] * cur[i];
        *(uint4*)(Xl + tl * 72 + cg8 * 8) = make_uint4(pack2(o[0], o[1]), pack2(o[2], o[3]), pack2(o[4], o[5]), pack2(o[6], o[7]));
        *(float4*)(Uf + tl * 64 + cg8 * 8) = make_float4(o[0], o[1], o[2], o[3]);
        *(float4*)(Uf + tl * 64 + cg8 * 8 + 4) = make_float4(o[4], o[5], o[6], o[7]);
      }
#pragma unroll
      for (int i = 0; i < 8; ++i) { win[0][i] = win[1][i]; win[1][i] = win[2][i]; win[2][i] = cur[i]; }
    }
  }
  __syncthreads();
  {
    const bfu* waT = (const bfu*)(p.ws + O_W + (size_t)l * W_SZ + W_LA) + hb * 4096;
    const bfu* wiT = (const bfu*)(p.ws + O_W + (size_t)l * W_SZ + W_LI) + hb * 4096;
    bf16x8 xa[2];
#pragma unroll
    for (int ks = 0; ks < 2; ++ks) xa[ks] = *(const bf16x8*)(Xl + (wv * 16 + lr) * 72 + ks * 32 + lq * 8);
#pragma unroll
    for (int jt = 0; jt < 4; ++jt) {
      f32x4 R = {0.f, 0.f, 0.f, 0.f}, I = {0.f, 0.f, 0.f, 0.f};
#pragma unroll
      for (int ks = 0; ks < 2; ++ks) {
        R = mfma16(xa[ks], ld8(waT + (jt * 16 + lr) * 64 + ks * 32 + lq * 8), R);
        I = mfma16(xa[ks], ld8(wiT + (jt * 16 + lr) * 64 + ks * 32 + lq * 8), I);
      }
      const int j = jt * 16 + lr, ch = hb * 64 + j;
      const float ba = p.lru_ba[l * 256 + ch], bi = p.lru_bi[l * 256 + ch];
      const float lsl = -softplusf_(-p.lru_lambda[l * 256 + ch]);
#pragma unroll
      for (int r = 0; r < 4; ++r) {
        int ll = wv * 16 + lq * 4 + r;
        float rg = sigmoidf_(R[r] + ba), ig = sigmoidf_(I[r] + bi);
        float la = 8.f * rg * lsl;
        float a = __expf(la);
        float xb = Uf[ll * 64 + j];
        float u = sqrtf(-expm1f(2.f * la)) * ig * xb;
        Af[ll * 64 + j] = a; Uf[ll * 64 + j] = u;
      }
    }
  }
  __syncthreads();
  const size_t sidx = (size_t)(b * NCH + c) * 256 + hb * 64;
  if (wv == 0) {
    if (MODE == 0) {
      float A = 1.f, h = 0.f;
      for (int t = 0; t < 64; ++t) { float a = Af[t * 64 + lane]; h = a * h + Uf[t * 64 + lane]; A *= a; }
      ((float*)(p.ws + O_LA))[sidx + lane] = A; ((float*)(p.ws + O_LH))[sidx + lane] = h;
    } else {
      float h = ((const float*)(p.ws + O_LH))[sidx + lane];
      for (int t = 0; t < 64; ++t) { h = Af[t * 64 + lane] * h + Uf[t * 64 + lane]; Uf[t * 64 + lane] = h; }
    }
  }
  if (MODE == 1) {
    __syncthreads();
    const int ll = tid >> 2, jq = (tid & 3) * 16;
    bfu* MIX = (bfu*)(p.ws + O_ACT) + (size_t)(tb + ll) * 1024 + 256 + hb * 64 + jq;
    const bfu* gp = COLS + (size_t)(tb + ll) * NIN + C_LG + hb * 64 + jq;
    unsigned ov[8];
#pragma unroll
    for (int i = 0; i < 8; ++i) {
      unsigned gu = *(const unsigned*)(gp + i * 2);
      float y0 = Uf[ll * 64 + jq + i * 2] * geluf_(lo2f(gu)), y1 = Uf[ll * 64 + jq + i * 2 + 1] * geluf_(hi2f(gu));
      ov[i] = pack2(y0, y1);
    }
    *(uint4*)MIX = make_uint4(ov[0], ov[1], ov[2], ov[3]);
    *(uint4*)(MIX + 8) = make_uint4(ov[4], ov[5], ov[6], ov[7]);
  }
}
DEV void lru_carry_item(const Params& p, int item) {
  const int i = item * 256 + tid_();
  const int b = i >> 8, ch = i & 255;
  const float* LA = (const float*)(p.ws + O_LA) + (size_t)b * NCH * 256 + ch;
  float* LH = (float*)(p.ws + O_LH) + (size_t)b * NCH * 256 + ch;
  float H = 0.f;
  for (int c = 0; c < NCH; ++c) { float A = LA[c * 256], he = LH[c * 256]; LH[c * 256] = H; H = A * H + he; }
}
DEV void shifted8(const bfu* COLS, const float* mu, int t, int col, float* out) {
  uint4 u = *(const uint4*)(COLS + (size_t)t * NIN + C_RWKV + col);
  float c[8] = {lo2f(u.x), hi2f(u.x), lo2f(u.y), hi2f(u.y), lo2f(u.z), hi2f(u.z), lo2f(u.w), hi2f(u.w)};
  float pv[8] = {0.f, 0.f, 0.f, 0.f, 0.f, 0.f, 0.f, 0.f};
  if ((t & (S - 1)) != 0) {
    uint4 q = *(const uint4*)(COLS + (size_t)(t - 1) * NIN + C_RWKV + col);
    pv[0] = lo2f(q.x); pv[1] = hi2f(q.x); pv[2] = lo2f(q.y); pv[3] = hi2f(q.y); pv[4] = lo2f(q.z); pv[5] = hi2f(q.z); pv[6] = lo2f(q.w); pv[7] = hi2f(q.w);
  }
#pragma unroll
  for (int i = 0; i < 8; ++i) out[i] = c[i] + (pv[i] - c[i]) * mu[col + i];
}
DEV float shifted1(const bfu* COLS, const float* mu, int t, int col) {
  float c = bf2f(COLS[(size_t)t * NIN + C_RWKV + col]);
  float pv = ((t & (S - 1)) != 0) ? bf2f(COLS[(size_t)(t - 1) * NIN + C_RWKV + col]) : 0.f;
  return c + (pv - c) * mu[col];
}
DEV bf16x8 packf8(const float* v) {
  bf16x8 o;
#pragma unroll
  for (int i = 0; i < 8; ++i) o[i] = (short)f2bf(v[i]);
  return o;
}
DEV void rwkv_prep_item(const Params& p, int l, int item) {
  const int lane = tid_() & 63, wv = tid_() >> 6, lr = lane & 15, lq = lane >> 4;
  const bfu* COLS = (const bfu*)(p.ws + O_COLS);
  const float* mu = p.rwkv_mu + l * 1024;
  const int t0 = item * 64 + wv * 16;
  const unsigned char* wb = p.ws + O_W + (size_t)l * W_SZ;
  const bfu* w2T = (const bfu*)(wb + W_R2); const bfu* a2T = (const bfu*)(wb + W_A2); const bfu* g2T = (const bfu*)(wb + W_G2);
  bf16x8 wdA[2], adA[2], gdA[4];
  {
    float tmp[8];
#pragma unroll
    for (int ks = 0; ks < 2; ++ks) {
      shifted8(COLS, mu, t0 + lr, 768 + ks * 32 + lq * 8, tmp);
#pragma unroll
      for (int i = 0; i < 8; ++i) tmp[i] = tanhf(tmp[i]);
      wdA[ks] = packf8(tmp);
      shifted8(COLS, mu, t0 + lr, 832 + ks * 32 + lq * 8, tmp);
      adA[ks] = packf8(tmp);
    }
#pragma unroll
    for (int ks = 0; ks < 4; ++ks) {
      shifted8(COLS, mu, t0 + lr, 896 + ks * 32 + lq * 8, tmp);
#pragma unroll
      for (int i = 0; i < 8; ++i) tmp[i] = sigmoidf_(tmp[i]);
      gdA[ks] = packf8(tmp);
    }
  }
  const int b = t0 / S;
  bfu* RG = (bfu*)(p.ws + O_RG);
  for (int hd = 0; hd < 4; ++hd) {
    float kkv[4][4], av[4][4], k2v[4][4], rv[4][4], vv[4][4], wv_[4][4];
    float ss[4] = {0.f, 0.f, 0.f, 0.f};
#pragma unroll
    for (int q = 0; q < 4; ++q) {
      const int nt = hd * 4 + q, n = nt * 16 + lr;
      f32x4 W = {0.f, 0.f, 0.f, 0.f}, A = {0.f, 0.f, 0.f, 0.f}, G = {0.f, 0.f, 0.f, 0.f};
#pragma unroll
      for (int ks = 0; ks < 2; ++ks) {
        W = mfma16(wdA[ks], ld8(w2T + n * 64 + ks * 32 + lq * 8), W);
        A = mfma16(adA[ks], ld8(a2T + n * 64 + ks * 32 + lq * 8), A);
      }
#pragma unroll
      for (int ks = 0; ks < 4; ++ks) G = mfma16(gdA[ks], ld8(g2T + n * 128 + ks * 32 + lq * 8), G);
      const float w0 = p.rwkv_w0[l * 256 + n], a0 = p.rwkv_a0[l * 256 + n], kkw = p.rwkv_kk[l * 256 + n], kaw = p.rwkv_ka[l * 256 + n];
#pragma unroll
      for (int r = 0; r < 4; ++r) {
        const int t = t0 + lq * 4 + r;
        float wl = -softplusf_(-(w0 + W[r])) - 0.5f;
        wv_[q][r] = __expf(-__expf(wl));
        float a = sigmoidf_(a0 + A[r]);
        float r_ = shifted1(COLS, mu, t, n), k_ = shifted1(COLS, mu, t, 256 + n), v_ = shifted1(COLS, mu, t, 512 + n);
        float kk = k_ * kkw;
        kkv[q][r] = kk; ss[r] += kk * kk; av[q][r] = a;
        k2v[q][r] = k_ * (1.f + (a - 1.f) * kaw);
        rv[q][r] = r_; vv[q][r] = v_;
        RG[(size_t)t * 256 + n] = f2bf(G[r]);
      }
    }
#pragma unroll
    for (int r = 0; r < 4; ++r) {
      float nrm = fmaxf(sqrtf(row16_sum(ss[r])), 1e-12f);
      float inv = 1.f / nrm;
      const int t = t0 + lq * 4 + r;
      unsigned char* dst = p.ws + O_RIN + ((size_t)(b * 4 + hd) * S + (t & (S - 1))) * 896;
#pragma unroll
      for (int q = 0; q < 4; ++q) {
        const int j = q * 16 + lr;
        float kkn = kkv[q][r] * inv;
        ((float*)dst)[j] = wv_[q][r];
        ((bfu*)(dst + 256))[j] = f2bf(-kkn);
        ((bfu*)(dst + 384))[j] = f2bf(kkn * av[q][r]);
        ((bfu*)(dst + 512))[j] = f2bf(k2v[q][r]);
        ((bfu*)(dst + 640))[j] = f2bf(rv[q][r]);
        ((bfu*)(dst + 768))[j] = f2bf(vv[q][r]);
      }
    }
  }
}
typedef float f32x2s __attribute__((ext_vector_type(2)));
DEV void rwkv_stage_write(float* dstbuf, uint4 v, int off, bool isw) {
  if (isw) { *(uint4*)(dstbuf + off) = v; }
  else {
    *(float4*)(dstbuf + off) = make_float4(lo2f(v.x), hi2f(v.x), lo2f(v.y), hi2f(v.y));
    *(float4*)(dstbuf + off + 4) = make_float4(lo2f(v.z), hi2f(v.z), lo2f(v.w), hi2f(v.w));
  }
}
DEV void rwkv_scan_item(const Params& p, int item) {
  const int bh = item >> 2, qd = item & 3;
  const int tid = tid_(), lane = tid & 63, wv = tid >> 6, lr = lane & 15, lq = lane >> 4;
  const unsigned char* src = p.ws + O_RIN + (size_t)bh * S * 896;
  float* Y = (float*)(p.ws + O_RY) + (size_t)(bh >> 2) * S * 256 + (bh & 3) * 64;
  const int irow = qd * 16 + wv * 4 + lq;
  float* buf = (float*)smem;
  constexpr int CH = 16, CB = CH * 896, CF = CH * 384;
  int soff[4]; bool sw[4];
#pragma unroll
  for (int i = 0; i < 4; ++i) {
    int idx = tid + i * 256; int st = idx / 56, wi = idx - st * 56;
    sw[i] = wi < 16;
    soff[i] = st * 384 + (sw[i] ? wi * 4 : 64 + ((wi - 16) >> 3) * 64 + ((wi - 16) & 7) * 8);
  }
  const bool t3 = tid < 896 - 768;
  __syncthreads();
  uint4 st0, st1, st2, st3 = make_uint4(0, 0, 0, 0);
  st0 = ((const uint4*)src)[tid]; st1 = ((const uint4*)src)[tid + 256]; st2 = ((const uint4*)src)[tid + 512]; if (t3) st3 = ((const uint4*)src)[tid + 768];
  rwkv_stage_write(buf, st0, soff[0], sw[0]); rwkv_stage_write(buf, st1, soff[1], sw[1]); rwkv_stage_write(buf, st2, soff[2], sw[2]);
  if (t3) rwkv_stage_write(buf, st3, soff[3], sw[3]);
  __syncthreads();
  f32x2s s01 = {0.f, 0.f}, s23 = {0.f, 0.f};
  for (int ch = 0; ch < S / CH; ++ch) {
    if (ch + 1 < S / CH) {
      const uint4* nsrc = (const uint4*)(src + (size_t)(ch + 1) * CB);
      st0 = nsrc[tid]; st1 = nsrc[tid + 256]; st2 = nsrc[tid + 512]; if (t3) st3 = nsrc[tid + 768];
    }
    const float* cb = buf + (ch & 1) * CF;
    float ykeep = 0.f;
    float4 W = *(const float4*)(cb + lr * 4), NK = *(const float4*)(cb + 64 + lr * 4), KA = *(const float4*)(cb + 128 + lr * 4);
    float4 KK = *(const float4*)(cb + 192 + lr * 4), RR = *(const float4*)(cb + 256 + lr * 4);
    float v = cb[320 + irow];
#pragma unroll
    for (int s = 0; s < CH; ++s) {
      float4 W2, NK2, KA2, KK2, RR2; float v2;
      if (s + 1 < CH) {
        const float* nb2 = cb + (s + 1) * 384;
        W2 = *(const float4*)(nb2 + lr * 4); NK2 = *(const float4*)(nb2 + 64 + lr * 4); KA2 = *(const float4*)(nb2 + 128 + lr * 4);
        KK2 = *(const float4*)(nb2 + 192 + lr * 4); RR2 = *(const float4*)(nb2 + 256 + lr * 4); v2 = nb2[320 + irow];
      }
      f32x2s t = s01 * (f32x2s){NK.x, NK.y}; t = s23 * (f32x2s){NK.z, NK.w} + t;
      f32x2s vv = {v, v};
      f32x2s u01 = s01 * (f32x2s){W.x, W.y}; u01 = vv * (f32x2s){KK.x, KK.y} + u01;
      f32x2s u23 = s23 * (f32x2s){W.z, W.w}; u23 = vv * (f32x2s){KK.z, KK.w} + u23;
      const float sa = row16_sum(t.x + t.y);
      f32x2s sav = {sa, sa};
      s01 = sav * (f32x2s){KA.x, KA.y} + u01;
      s23 = sav * (f32x2s){KA.z, KA.w} + u23;
      f32x2s yy = s01 * (f32x2s){RR.x, RR.y}; yy = s23 * (f32x2s){RR.z, RR.w} + yy;
      const float y = row16_sum(yy.x + yy.y);
      ykeep = (lr == s) ? y : ykeep;
      if (s + 1 < CH) { W = W2; NK = NK2; KA = KA2; KK = KK2; RR = RR2; v = v2; }
      if (s == 9 && ch + 1 < S / CH) {
        float* nb = buf + ((ch + 1) & 1) * CF;
        rwkv_stage_write(nb, st0, soff[0], sw[0]); rwkv_stage_write(nb, st1, soff[1], sw[1]); rwkv_stage_write(nb, st2, soff[2], sw[2]);
        if (t3) rwkv_stage_write(nb, st3, soff[3], sw[3]);
      }
    }
    Y[(size_t)(ch * CH + lr) * 256 + irow] = ykeep;
    __syncthreads();
  }
}
DEV void rwkv_post_item(const Params& p, int l, int item) {
  const int lane = tid_() & 63, wv = tid_() >> 6;
  const float* RY = (const float*)(p.ws + O_RY);
  const bfu* RG = (const bfu*)(p.ws + O_RG);
  bfu* MIX = (bfu*)(p.ws + O_ACT);
  for (int k = 0; k < 64; ++k) {
    const int t = item * 64 + wv * 16 + (k >> 2), h = k & 3;
    const int b = t / S, tp = t & (S - 1);
    float y = RY[(size_t)t * 256 + h * 64 + lane];
    float mean = wave_sum(y) * (1.f / 64.f);
    float d = y - mean;
    float var = wave_sum(d * d) * (1.f / 64.f);
    const int ch = h * 64 + lane;
    float yn = d * rsqrtf(var + 64e-5f) * p.rwkv_ln_w[l * 256 + ch] + p.rwkv_ln_b[l * 256 + ch];
    const unsigned char* src = p.ws + O_RIN + ((size_t)(b * 4 + h) * S + tp) * 896;
    float k2 = bf2f(((const bfu*)(src + 512))[lane]), r_ = bf2f(((const bfu*)(src + 640))[lane]), v_ = bf2f(((const bfu*)(src + 768))[lane]);
    float bonus = wave_sum(r_ * k2 * p.rwkv_rk[l * 256 + ch]);
    float o = (yn + bonus * v_) * bf2f(RG[(size_t)t * 256 + ch]);
    MIX[(size_t)t * 1024 + 512 + ch] = f2bf(o);
  }
}
DEV void nsa_tr_item(const Params& p, int item) {
  const int which = item & 1, tt = (item >> 1) & 127, b = item >> 8;
  const int tid = tid_();
  const bfu* COLS = (const bfu*)(p.ws + O_COLS);
  bfu* dst = (bfu*)(p.ws + (which ? O_VWT : O_VST)) + (size_t)b * 64 * S;
  const int col0 = which ? C_VW : C_VS;
  bfu* tl = (bfu*)smem;
  __syncthreads();
  for (int i = tid; i < 64 * 32; i += NTHR) {
    int tok = i >> 5, dp = i & 31;
    unsigned u = *(const unsigned*)(COLS + (size_t)(b * S + tt * 64 + tok) * NIN + col0 + dp * 2);
    *(unsigned*)(tl + tok * 66 + dp * 2) = u;
  }
  __syncthreads();
  {
    const int d = tid >> 2, tq = (tid & 3) * 16;
    unsigned o[8];
#pragma unroll
    for (int i = 0; i < 8; ++i) o[i] = (unsigned)tl[(tq + i * 2) * 66 + d] | ((unsigned)tl[(tq + i * 2 + 1) * 66 + d] << 16);
    uint4* dp = (uint4*)(dst + (size_t)d * S + tt * 64 + tq);
    dp[0] = make_uint4(o[0], o[1], o[2], o[3]); dp[1] = make_uint4(o[4], o[5], o[6], o[7]);
  }
}
DEV void nsa_cmp_item(const Params& p, int l, int item) {
  const int mt = item & 31, b = (item >> 5) & 3, which = item >> 7;
  const int tid = tid_(), lane = tid & 63, wv = tid >> 6, lr = lane & 15, lq = lane >> 4;
  const bfu* COLS = (const bfu*)(p.ws + O_COLS);
  const unsigned char* wb = p.ws + O_W + (size_t)l * W_SZ;
  const bfu* w1T = (const bfu*)(wb + W_C1) + (size_t)which * 256 * 2048;
  const bfu* w2T = (const bfu*)(wb + W_C2) + (size_t)which * 64 * 256;
  const float* pos = p.nsa_cmp_pos + ((size_t)l * 2 + which) * 2048;
  const int col0 = which ? C_VC : C_KC;
  bfu* Hs = (bfu*)smem;
  int blk = mt * 16 + lr; if (blk > 510) blk = 510;
  const bfu* arow = COLS + (size_t)(b * S + blk * 16) * NIN + col0 + lq * 8;
  f32x4 acc[4];
#pragma unroll
  for (int j = 0; j < 4; ++j) acc[j] = (f32x4){0.f, 0.f, 0.f, 0.f};
  for (int ks = 0; ks < 64; ++ks) {
    uint4 u = *(const uint4*)(arow + (size_t)(ks >> 1) * NIN + (ks & 1) * 32);
    const float4* pp = (const float4*)(pos + ks * 32 + lq * 8);
    float4 p0 = pp[0], p1 = pp[1];
    float av[8] = {lo2f(u.x) + p0.x, hi2f(u.x) + p0.y, lo2f(u.y) + p0.z, hi2f(u.y) + p0.w, lo2f(u.z) + p1.x, hi2f(u.z) + p1.y, lo2f(u.w) + p1.z, hi2f(u.w) + p1.w};
    bf16x8 a = packf8(av);
#pragma unroll
    for (int j = 0; j < 4; ++j) acc[j] = mfma16(a, ld8(w1T + (size_t)(wv * 64 + j * 16 + lr) * 2048 + ks * 32 + lq * 8), acc[j]);
  }
  __syncthreads();
#pragma unroll
  for (int j = 0; j < 4; ++j)
#pragma unroll
    for (int r = 0; r < 4; ++r) Hs[(lq * 4 + r) * 264 + wv * 64 + j * 16 + lr] = f2bf(geluf_(acc[j][r]));
  __syncthreads();
  f32x4 o = {0.f, 0.f, 0.f, 0.f};
#pragma unroll
  for (int ks = 0; ks < 8; ++ks) o = mfma16(*(const bf16x8*)(Hs + lr * 264 + ks * 32 + lq * 8), ld8(w2T + (wv * 16 + lr) * 256 + ks * 32 + lq * 8), o);
#pragma unroll
  for (int r = 0; r < 4; ++r) {
    int bi = mt * 16 + lq * 4 + r, d = wv * 16 + lr;
    float v = (bi < 511) ? o[r] : 0.f;
    if (which == 0) ((bfu*)(p.ws + O_KCMP))[((size_t)b * 512 + bi) * 64 + d] = f2bf(v);
    else ((bfu*)(p.ws + O_VCT))[((size_t)b * 64 + d) * 512 + bi] = f2bf(v);
  }
}

struct AttnState { float m[4], l[4]; f32x4 O[4]; };
DEV void attn_init(AttnState& st) {
#pragma unroll
  for (int r = 0; r < 4; ++r) { st.m[r] = -1e30f; st.l[r] = 0.f; st.O[r] = (f32x4){0.f, 0.f, 0.f, 0.f}; }
}
struct KVF { bf16x8 k00, k01, k10, k11, v0, v1, v2, v3; };
DEV void attn_load(KVF& f, const bfu* kp0, const bfu* kp1, const bfu* vt, size_t vs16) {
  f.k00 = ld8(kp0); f.k01 = ld8(kp0 + 32); f.k10 = ld8(kp1); f.k11 = ld8(kp1 + 32);
  f.v0 = ld8(vt); f.v1 = ld8(vt + vs16); f.v2 = ld8(vt + 2 * vs16); f.v3 = ld8(vt + 3 * vs16);
}
DEV void attn_compute(AttnState& st, const bf16x8* q, const KVF& f, float dist0, bool val0, float dist1, bool val1, bfu* pbuf, int lr, int lq) {
  f32x4 s0 = {0.f, 0.f, 0.f, 0.f}, s1 = {0.f, 0.f, 0.f, 0.f};
  s0 = mfma16(q[0], f.k00, s0); s0 = mfma16(q[1], f.k01, s0);
  s1 = mfma16(q[0], f.k10, s1); s1 = mfma16(q[1], f.k11, s1);
#pragma unroll
  for (int r = 0; r < 4; ++r) {
    const float slope = (r == 0) ? 0.25f : (r == 1) ? 0.0625f : (r == 2) ? 0.015625f : 0.00390625f;
    float a0 = val0 ? s0[r] * 0.125f - slope * dist0 : -1e30f;
    float a1 = val1 ? s1[r] * 0.125f - slope * dist1 : -1e30f;
    float mn = fmaxf(st.m[r], row16_max(fmaxf(a0, a1)));
    float p0 = val0 ? __expf(a0 - mn) : 0.f, p1 = val1 ? __expf(a1 - mn) : 0.f;
    float corr = __expf(st.m[r] - mn);
    st.m[r] = mn;
    st.l[r] = st.l[r] * corr + row16_sum(p0 + p1);
#pragma unroll
    for (int dt = 0; dt < 4; ++dt) st.O[dt][r] *= corr;
    pbuf[(lq * 4 + r) * 40 + lr] = f2bf(p0); pbuf[(lq * 4 + r) * 40 + 16 + lr] = f2bf(p1);
  }
  bf16x8 pa = *(const bf16x8*)(pbuf + lr * 40 + lq * 8);
  st.O[0] = mfma16(pa, f.v0, st.O[0]); st.O[1] = mfma16(pa, f.v1, st.O[1]);
  st.O[2] = mfma16(pa, f.v2, st.O[2]); st.O[3] = mfma16(pa, f.v3, st.O[3]);
}
DEV float wave_maxf_u(float v) {
  v = row16_max(v);
  v = fmaxf(v, __int_as_float(__builtin_amdgcn_update_dpp(__float_as_int(-__builtin_inff()), __float_as_int(v), 0x142, 0xA, 0xF, false)));
  v = fmaxf(v, __int_as_float(__builtin_amdgcn_update_dpp(__float_as_int(-__builtin_inff()), __float_as_int(v), 0x143, 0xC, 0xF, false)));
  return __int_as_float(__builtin_amdgcn_readlane(__float_as_int(v), 63));
}
template <int CTRL> DEV int dppi(int v) { return __builtin_amdgcn_update_dpp(0, v, CTRL, 0xf, 0xf, true); }
DEV int wave_mini_u(int v) {
  v = min(v, dppi<0xB1>(v)); v = min(v, dppi<0x4E>(v)); v = min(v, dppi<0x141>(v)); v = min(v, dppi<0x140>(v));
  v = min(v, __builtin_amdgcn_update_dpp(0x7fffffff, v, 0x142, 0xA, 0xF, false));
  v = min(v, __builtin_amdgcn_update_dpp(0x7fffffff, v, 0x143, 0xC, 0xF, false));
  return __builtin_amdgcn_readlane(v, 63);
}

DEV void nsa_cmpattn_item(const Params& p, int item) {
  const int lane = tid_() & 63, wv = tid_() >> 6, lr = lane & 15, lq = lane >> 4;
  const bfu* COLS = (const bfu*)(p.ws + O_COLS);
  const int t0 = item * 16 + wv * 4;
  const int b = t0 / S, tp0 = t0 & (S - 1);
  const bfu* KC = (const bfu*)(p.ws + O_KCMP) + (size_t)b * 512 * 64;
  const bfu* VCT = (const bfu*)(p.ws + O_VCT) + (size_t)b * 64 * 512;
  bfu* pbuf = (bfu*)smem + wv * 640;
  float* ps = (float*)(smem + 5120) + wv * (4 * 516);
  bf16x8 q[2];
#pragma unroll
  for (int ks = 0; ks < 2; ++ks) q[ks] = ld8(COLS + (size_t)(t0 + (lr >> 2)) * NIN + C_Q + (lr & 3) * 64 + ks * 32 + lq * 8);
  const int pos = tp0 + lq;
  const int pmax = tp0 + 3;
  const int nvalid = (pmax >= 31) ? ((pmax - 31) >> 4) + 1 : 0;
  const int nkt = (nvalid + 31) >> 5;
  float m[4] = {-1e30f, -1e30f, -1e30f, -1e30f}, z[4] = {0.f, 0.f, 0.f, 0.f};
  for (int kt = 0; kt < nkt; ++kt) {
    const int n0 = kt * 32 + lr, n1 = n0 + 16;
    f32x4 s0 = {0.f, 0.f, 0.f, 0.f}, s1 = {0.f, 0.f, 0.f, 0.f};
    s0 = mfma16(q[0], ld8(KC + n0 * 64 + lq * 8), s0); s0 = mfma16(q[1], ld8(KC + n0 * 64 + 32 + lq * 8), s0);
    s1 = mfma16(q[0], ld8(KC + n1 * 64 + lq * 8), s1); s1 = mfma16(q[1], ld8(KC + n1 * 64 + 32 + lq * 8), s1);
    const int d0 = pos - (16 * n0 + 31), d1 = pos - (16 * n1 + 31);
#pragma unroll
    for (int r = 0; r < 4; ++r) {
      const float slope = (r == 0) ? 0.25f : (r == 1) ? 0.0625f : (r == 2) ? 0.015625f : 0.00390625f;
      float a0 = (d0 >= 0) ? s0[r] * 0.125f - slope * (float)d0 : -1e30f;
      float a1 = (d1 >= 0) ? s1[r] * 0.125f - slope * (float)d1 : -1e30f;
      float mn = fmaxf(m[r], row16_max(fmaxf(a0, a1)));
      float p0 = (d0 >= 0) ? __expf(a0 - mn) : 0.f, p1 = (d1 >= 0) ? __expf(a1 - mn) : 0.f;
      z[r] = z[r] * __expf(m[r] - mn) + row16_sum(p0 + p1);
      m[r] = mn;
    }
  }
  float iz[4];
#pragma unroll
  for (int r = 0; r < 4; ++r) iz[r] = 1.f / fmaxf(z[r], 1e-30f);
  f32x4 O[4];
#pragma unroll
  for (int dt = 0; dt < 4; ++dt) O[dt] = (f32x4){0.f, 0.f, 0.f, 0.f};
  for (int kt = 0; kt < nkt; ++kt) {
    const int n0 = kt * 32 + lr, n1 = n0 + 16;
    f32x4 s0 = {0.f, 0.f, 0.f, 0.f}, s1 = {0.f, 0.f, 0.f, 0.f};
    s0 = mfma16(q[0], ld8(KC + n0 * 64 + lq * 8), s0); s0 = mfma16(q[1], ld8(KC + n0 * 64 + 32 + lq * 8), s0);
    s1 = mfma16(q[0], ld8(KC + n1 * 64 + lq * 8), s1); s1 = mfma16(q[1], ld8(KC + n1 * 64 + 32 + lq * 8), s1);
    const int d0 = pos - (16 * n0 + 31), d1 = pos - (16 * n1 + 31);
    float ps0 = 0.f, ps1 = 0.f;
#pragma unroll
    for (int r = 0; r < 4; ++r) {
      const float slope = (r == 0) ? 0.25f : (r == 1) ? 0.0625f : (r == 2) ? 0.015625f : 0.00390625f;
      float p0 = (d0 >= 0) ? __expf(s0[r] * 0.125f - slope * (float)d0 - m[r]) * iz[r] : 0.f;
      float p1 = (d1 >= 0) ? __expf(s1[r] * 0.125f - slope * (float)d1 - m[r]) * iz[r] : 0.f;
      ps0 += p0; ps1 += p1;
      pbuf[(lq * 4 + r) * 40 + lr] = f2bf(p0); pbuf[(lq * 4 + r) * 40 + 16 + lr] = f2bf(p1);
    }
    ps[lq * 516 + n0] = ps0; ps[lq * 516 + n1] = ps1;
    bf16x8 pa = *(const bf16x8*)(pbuf + lr * 40 + lq * 8);
#pragma unroll
    for (int dt = 0; dt < 4; ++dt) O[dt] = mfma16(pa, ld8(VCT + (size_t)(dt * 16 + lr) * 512 + kt * 32 + lq * 8), O[dt]);
  }
  bfu* OC = (bfu*)(p.ws + O_OCMP);
#pragma unroll
  for (int dt = 0; dt < 4; ++dt)
#pragma unroll
    for (int r = 0; r < 4; ++r) OC[(size_t)(t0 + lq) * 256 + r * 64 + dt * 16 + lr] = f2bf(O[dt][r]);
  const int nproc = nkt * 32;
  unsigned long long* SEL = (unsigned long long*)(p.ws + O_SEL);
  for (int tk = 0; tk < 4; ++tk) {
    const int tpos = tp0 + tk, cur = tpos >> 6;
    const float* pr = ps + tk * 516;
    float iv[2];
#pragma unroll
    for (int hh = 0; hh < 2; ++hh) {
      const int j = lane + hh * 64;
      float v = -__builtin_inff();
      if (j <= cur) {
        if (j == 0 || j == cur || j == cur - 1) v = 1e4f;
        else {
          float a = 0.f;
#pragma unroll
          for (int e = -1; e < 4; ++e) {
            int n = 4 * j + e;
            float w = (e == -1 || e == 3) ? 0.5f : 1.f;
            if (n >= 0 && n <= 510 && n < nproc) a += w * pr[n];
          }
          v = a;
        }
      }
      iv[hh] = v;
    }
    bool sel0 = false, sel1 = false;
    const int nsel = (cur + 1 < 16) ? cur + 1 : 16;
    for (int rd = 0; rd < nsel; ++rd) {
      float c0 = sel0 ? -__builtin_inff() : iv[0], c1 = sel1 ? -__builtin_inff() : iv[1];
      const float gm = wave_maxf_u(fmaxf(c0, c1));
      const int bi = wave_mini_u((c0 == gm) ? lane : ((c1 == gm) ? lane + 64 : 0x7fffffff));
      if (bi == lane) sel0 = true;
      if (bi == lane + 64) sel1 = true;
    }
    unsigned long long mlo = __ballot(sel0), mhi = __ballot(sel1);
    if (lane == 0) { SEL[(size_t)(t0 + tk) * 2] = mlo; SEL[(size_t)(t0 + tk) * 2 + 1] = mhi; }
  }
}

DEV void nsa_finish_item(const Params& p, int item) {
  const int lane = tid_() & 63, wv = tid_() >> 6, lr = lane & 15, lq = lane >> 4;
  const bfu* COLS = (const bfu*)(p.ws + O_COLS);
  const float* SIDE = (const float*)(p.ws + O_SIDE);
  const int t0 = item * 16 + wv * 4;
  const int b = t0 / S, tp0 = t0 & (S - 1);
  bfu* pbuf = (bfu*)smem + wv * 640;
  bf16x8 q[2];
#pragma unroll
  for (int ks = 0; ks < 2; ++ks) q[ks] = ld8(COLS + (size_t)(t0 + (lr >> 2)) * NIN + C_Q + (lr & 3) * 64 + ks * 32 + lq * 8);
  const int pos = tp0 + lq;
  const bfu* rowb = COLS + (size_t)b * S * NIN;
  AttnState sw; attn_init(sw);
  KVF cur, nxt;
  {
    const bfu* VT = (const bfu*)(p.ws + O_VWT) + (size_t)b * 64 * S;
    int kb = tp0 - 511; if (kb < 0) kb = 0; kb &= ~31;
    const int last = tp0 + 3;
    attn_load(cur, rowb + (size_t)(kb + lr) * NIN + C_KW + lq * 8, rowb + (size_t)(kb + 16 + lr) * NIN + C_KW + lq * 8, VT + (size_t)lr * S + kb + lq * 8, (size_t)16 * S);
    for (; kb <= last; kb += 32) {
      const bool more = kb + 32 <= last;
      const int kn = kb + 32;
      if (more) attn_load(nxt, rowb + (size_t)(kn + lr) * NIN + C_KW + lq * 8, rowb + (size_t)(kn + 16 + lr) * NIN + C_KW + lq * 8, VT + (size_t)lr * S + kn + lq * 8, (size_t)16 * S);
      const int d0 = pos - (kb + lr), d1 = d0 - 16;
      attn_compute(sw, q, cur, (float)d0, d0 >= 0 && d0 < 512, (float)d1, d1 >= 0 && d1 < 512, pbuf, lr, lq);
      if (more) cur = nxt;
    }
  }
  AttnState ss; attn_init(ss);
  {
    const bfu* VT = (const bfu*)(p.ws + O_VST) + (size_t)b * 64 * S;
    const unsigned long long* SEL = (const unsigned long long*)(p.ws + O_SEL);
    const unsigned long long mylo = SEL[(size_t)(t0 + lq) * 2], myhi = SEL[(size_t)(t0 + lq) * 2 + 1];
    unsigned long long ulo = 0, uhi = 0;
#pragma unroll
    for (int k = 0; k < 4; ++k) { ulo |= SEL[(size_t)(t0 + k) * 2]; uhi |= SEL[(size_t)(t0 + k) * 2 + 1]; }
    unsigned ul0 = __builtin_amdgcn_readfirstlane((unsigned)ulo), ul1 = __builtin_amdgcn_readfirstlane((unsigned)(ulo >> 32));
    unsigned uh0 = __builtin_amdgcn_readfirstlane((unsigned)uhi), uh1 = __builtin_amdgcn_readfirstlane((unsigned)(uhi >> 32));
    int j = -1, hb = 1;
    auto adv = [&]() -> bool {
      if (hb == 0) { hb = 1; return true; }
      hb = 0;
      if (ul0) { j = __builtin_ctz(ul0); ul0 &= ul0 - 1; return true; }
      if (ul1) { j = 32 + __builtin_ctz(ul1); ul1 &= ul1 - 1; return true; }
      if (uh0) { j = 64 + __builtin_ctz(uh0); uh0 &= uh0 - 1; return true; }
      if (uh1) { j = 96 + __builtin_ctz(uh1); uh1 &= uh1 - 1; return true; }
      return false;
    };
    bool ok = adv();
    if (ok) { const int kb = j * 64 + hb * 32; attn_load(cur, rowb + (size_t)(kb + lr) * NIN + C_KS + lq * 8, rowb + (size_t)(kb + 16 + lr) * NIN + C_KS + lq * 8, VT + (size_t)lr * S + kb + lq * 8, (size_t)16 * S); }
    while (ok) {
      const int cj = j, kb = j * 64 + hb * 32;
      const bool nk = adv();
      if (nk) { const int kn = j * 64 + hb * 32; attn_load(nxt, rowb + (size_t)(kn + lr) * NIN + C_KS + lq * 8, rowb + (size_t)(kn + 16 + lr) * NIN + C_KS + lq * 8, VT + (size_t)lr * S + kn + lq * 8, (size_t)16 * S); }
      const bool has = (((cj < 64) ? (mylo >> cj) : (myhi >> (cj - 64))) & 1ull) != 0;
      const int d0 = pos - (kb + lr), d1 = d0 - 16;
      attn_compute(ss, q, cur, (float)d0, has && d0 >= 0, (float)d1, has && d1 >= 0, pbuf, lr, lq);
      if (nk) cur = nxt;
      ok = nk;
    }
  }
  const bfu* OC = (const bfu*)(p.ws + O_OCMP);
  bfu* MIX = (bfu*)(p.ws + O_ACT);
  const int t = t0 + lq;
#pragma unroll
  for (int r = 0; r < 4; ++r) {
    const float g0 = sigmoidf_(SIDE[(size_t)t * 16 + 4 + r * 3]), g1 = sigmoidf_(SIDE[(size_t)t * 16 + 5 + r * 3]), g2 = sigmoidf_(SIDE[(size_t)t * 16 + 6 + r * 3]);
    const float is = g1 / fmaxf(ss.l[r], 1e-30f), iw = g2 / fmaxf(sw.l[r], 1e-30f);
#pragma unroll
    for (int dt = 0; dt < 4; ++dt) {
      const int ch = r * 64 + dt * 16 + lr;
      float o = g0 * bf2f(OC[(size_t)t * 256 + ch]) + is * ss.O[dt][r] + iw * sw.O[dt][r];
      MIX[(size_t)t * 1024 + 768 + ch] = f2bf(o);
    }
  }
}

DEV void phase_rwkv_prep(const Params& p, int l) {
  for (int it = bid_(); it < 512; it += gridDim.x) rwkv_prep_item(p, l, it);
}
DEV void sub_arrive(unsigned* bar) {
  asm volatile("s_waitcnt vmcnt(0)" ::: "memory");
  __syncthreads();
  if (tid_() == 0) { __threadfence(); atomicAdd(bar, 1u); }
}
DEV void sub_wait(unsigned* bar, unsigned target) {
  if (tid_() == 0) { while (__hip_atomic_load(bar, __ATOMIC_RELAXED, __HIP_MEMORY_SCOPE_AGENT) < target) __builtin_amdgcn_s_sleep(2); __threadfence(); }
  __syncthreads();
}
DEV void phase_mix_scan_finish(const Params& p, int l) {
  unsigned* barA = (unsigned*)(p.ws + O_SYNC) + l * 4;
  unsigned* barB = barA + 1;
  unsigned* que = barA + 2;
  const unsigned nothers = gridDim.x - 64;
  if (bid_() < 64) {
    __builtin_amdgcn_s_setprio(3);
    for (int rep = 0; rep < R_SCAN; ++rep) rwkv_scan_item(p, bid_());
    __builtin_amdgcn_s_setprio(0);
  } else {
    constexpr int P0 = 1024, P1 = P0 + 2048, P2 = P1 + 1024, P3 = P2 + 256;
    for (int it = bid_() - 64; it < P3; it += gridDim.x - 64) {
      if (it < P0) ssd_item<0>(p, l, it);
      else if (it < P1) lru_item<0>(p, l, it - P0);
      else if (it < P2) nsa_tr_item(p, it - P1);
      else nsa_cmp_item(p, l, it - P2);
    }
    sub_arrive(barA);
    sub_wait(barA, nothers);
    constexpr int N0 = 2048, N1 = N0 + 256, N2 = N1 + 4;
    for (int it = bid_() - 64; it < N2; it += gridDim.x - 64) {
      if (it < N0) { for (int rep = 0; rep < R_CMPA; ++rep) { __syncthreads(); nsa_cmpattn_item(p, it); } }
      else if (it < N1) ssd_rec_item(p, it - N0);
      else lru_carry_item(p, it - N1);
    }
    sub_arrive(barB);
  }
  sub_wait(barB, nothers);
  constexpr int M0 = 2048, M1 = M0 + 1024, M2 = M1 + 2048;
  for (;;) {
    __syncthreads();
    if (tid_() == 0) s_qitem = (int)atomicAdd(que, 1u);
    __syncthreads();
    const int it = s_qitem;
    if (it >= M2) break;
    for (int rep = 0; rep < R_FIN; ++rep) {
    if (it < M0) { __syncthreads(); nsa_finish_item(p, it); }
    else if (it < M1) ssd_item<1>(p, l, it - M0);
    else lru_item<1>(p, l, it - M1);
    }
  }
}
DEV void phase_rwkv_post(const Params& p, int l) {
  for (int it = bid_(); it < 512; it += gridDim.x) rwkv_post_item(p, l, it);
}

template <int CTRL> DEV int dppi_(int v) { return __builtin_amdgcn_update_dpp(0, v, CTRL, 0xf, 0xf, true); }
DEV int row16_mini(int v) { v = min(v, dppi_<0xB1>(v)); v = min(v, dppi_<0x4E>(v)); v = min(v, dppi_<0x141>(v)); v = min(v, dppi_<0x140>(v)); return v; }
DEV void phase_peer_topk(const Params& p, int l) {
  const bfu* Q = (const bfu*)(p.ws + O_PQ);
  const bfu* keys = (const bfu*)(p.ws + O_W + (size_t)l * W_SZ + W_KEYS);
  int* PE = (int*)(p.ws + O_PE); float* PG = (float*)(p.ws + O_PG);
  const int lane = tid_() & 63, wv = tid_() >> 6, lr = lane & 15, lq = lane >> 4;
  float* ps = (float*)smem + wv * 1024;
  int* pi = (int*)ps + 512;
  const float NINF = -__builtin_inff();
  int ca[4], cb[4]; bool cok[4];
#pragma unroll
  for (int sl = 0; sl < 4; ++sl) {
    int k = sl * 16 + lr, a = 0; bool ok = false;
    for (int aa = 0; aa < 16; ++aa) { int cnt = 16 / (aa + 1); if (!ok) { if (k < cnt) { ok = true; a = aa; } else k -= cnt; } }
    ca[sl] = a; cb[sl] = ok ? k : 0; cok[sl] = ok;
  }
  for (int item = bid_(); item < (T / 64) * 8; item += gridDim.x) {
    const int tt = item >> 3, hd = item & 7;
    const int t0 = tt * 64 + wv * 16;
    for (int c = 0; c < 2; ++c) {
      bf16x8 qa[4];
#pragma unroll
      for (int ks = 0; ks < 4; ++ks) qa[ks] = ld8(Q + (size_t)(t0 + lr) * 2048 + hd * 256 + c * 128 + ks * 32 + lq * 8);
      const bfu* kb = keys + (size_t)(hd * 2 + c) * 128 * 128;
      float v[4][8];
#pragma unroll
      for (int nt = 0; nt < 8; ++nt) {
        f32x4 a = {0.f, 0.f, 0.f, 0.f};
#pragma unroll
        for (int ks = 0; ks < 4; ++ks) a = mfma16(qa[ks], ld8(kb + (size_t)(nt * 16 + lr) * 128 + ks * 32 + lq * 8), a);
#pragma unroll
        for (int r = 0; r < 4; ++r) v[r][nt] = a[r];
      }
      float mys[4] = {0.f, 0.f, 0.f, 0.f}; int myi[4] = {0, 0, 0, 0};
      for (int rd = 0; rd < 16; ++rd) {
#pragma unroll
        for (int r = 0; r < 4; ++r) {
          float lm = fmaxf(fmaxf(fmaxf(v[r][0], v[r][1]), fmaxf(v[r][2], v[r][3])), fmaxf(fmaxf(v[r][4], v[r][5]), fmaxf(v[r][6], v[r][7])));
          const float gm = row16_max(lm);
          int cand = 0x7fffffff;
#pragma unroll
          for (int nt = 7; nt >= 0; --nt) cand = (v[r][nt] == gm) ? nt * 16 + lr : cand;
          const int bi = row16_mini(cand);
#pragma unroll
          for (int nt = 0; nt < 8; ++nt) v[r][nt] = (bi == nt * 16 + lr) ? NINF : v[r][nt];
          if (lr == rd) { mys[r] = gm; myi[r] = bi; }
        }
      }
#pragma unroll
      for (int r = 0; r < 4; ++r) { ps[c * 256 + (lq * 4 + r) * 16 + lr] = mys[r]; pi[c * 256 + (lq * 4 + r) * 16 + lr] = myi[r]; }
    }
    float cv[4][4];
#pragma unroll
    for (int r = 0; r < 4; ++r)
#pragma unroll
      for (int sl = 0; sl < 4; ++sl) {
        float sv = ps[(lq * 4 + r) * 16 + ca[sl]] + ps[256 + (lq * 4 + r) * 16 + cb[sl]];
        cv[r][sl] = cok[sl] ? sv : NINF;
      }
    float tops[4] = {0.f, 0.f, 0.f, 0.f}; int topf[4] = {0, 0, 0, 0};
    for (int rd = 0; rd < 16; ++rd) {
#pragma unroll
      for (int r = 0; r < 4; ++r) {
        const float gm = row16_max(fmaxf(fmaxf(cv[r][0], cv[r][1]), fmaxf(cv[r][2], cv[r][3])));
        int cand = 0x7fffffff;
#pragma unroll
        for (int sl = 0; sl < 4; ++sl) { int fl = ca[sl] * 16 + cb[sl]; cand = (cv[r][sl] == gm && fl < cand) ? fl : cand; }
        const int bi = row16_mini(cand);
#pragma unroll
        for (int sl = 0; sl < 4; ++sl) cv[r][sl] = (bi == ca[sl] * 16 + cb[sl]) ? NINF : cv[r][sl];
        if (lr == rd) { tops[r] = gm; topf[r] = bi; }
      }
    }
#pragma unroll
    for (int r = 0; r < 4; ++r) {
      const int row = lq * 4 + r;
      const float mx = row16_max(tops[r]);
      const float e = __expf(tops[r] - mx);
      const float den = row16_sum(e);
      const int a = topf[r] >> 4, bb = topf[r] & 15;
      const size_t o = (size_t)(t0 + row) * 128 + hd * 16 + lr;
      PE[o] = pi[row * 16 + a] * 128 + pi[256 + row * 16 + bb];
      PG[o] = e / den;
    }
  }
}

typedef float f32x2 __attribute__((ext_vector_type(2)));
DEV float wave_total(float v) {
  v = row16_sum(v);
  v += __int_as_float(__builtin_amdgcn_update_dpp(0, __float_as_int(v), 0x142, 0xA, 0xF, false));
  v += __int_as_float(__builtin_amdgcn_update_dpp(0, __float_as_int(v), 0x143, 0xC, 0xF, false));
  return __int_as_float(__builtin_amdgcn_readlane(__float_as_int(v), 63));
}
DEV float dot_fp8(uint4 u, const f32x2* x) {
  f32x2 acc = __builtin_amdgcn_cvt_pk_f32_fp8((int)u.x, false) * x[0];
  acc = __builtin_amdgcn_cvt_pk_f32_fp8((int)u.x, true) * x[1] + acc;
  acc = __builtin_amdgcn_cvt_pk_f32_fp8((int)u.y, false) * x[2] + acc;
  acc = __builtin_amdgcn_cvt_pk_f32_fp8((int)u.y, true) * x[3] + acc;
  acc = __builtin_amdgcn_cvt_pk_f32_fp8((int)u.z, false) * x[4] + acc;
  acc = __builtin_amdgcn_cvt_pk_f32_fp8((int)u.z, true) * x[5] + acc;
  acc = __builtin_amdgcn_cvt_pk_f32_fp8((int)u.w, false) * x[6] + acc;
  acc = __builtin_amdgcn_cvt_pk_f32_fp8((int)u.w, true) * x[7] + acc;
  return acc.x + acc.y;
}
DEV void axpy_fp8(uint4 v, float c, f32x2* y) {
  f32x2 cc = {c, c};
  y[0] = __builtin_amdgcn_cvt_pk_f32_fp8((int)v.x, false) * cc + y[0];
  y[1] = __builtin_amdgcn_cvt_pk_f32_fp8((int)v.x, true) * cc + y[1];
  y[2] = __builtin_amdgcn_cvt_pk_f32_fp8((int)v.y, false) * cc + y[2];
  y[3] = __builtin_amdgcn_cvt_pk_f32_fp8((int)v.y, true) * cc + y[3];
  y[4] = __builtin_amdgcn_cvt_pk_f32_fp8((int)v.z, false) * cc + y[4];
  y[5] = __builtin_amdgcn_cvt_pk_f32_fp8((int)v.z, true) * cc + y[5];
  y[6] = __builtin_amdgcn_cvt_pk_f32_fp8((int)v.w, false) * cc + y[6];
  y[7] = __builtin_amdgcn_cvt_pk_f32_fp8((int)v.w, true) * cc + y[7];
}
struct PBatch { uint4 u[4], v[4]; };
DEV void peer_load(PBatch& pb, const unsigned char* PU, const unsigned char* PV, int me0, int me1, int e, int lane) {
#pragma unroll
  for (int k = 0; k < 4; ++k) {
    int ee = e + k;
    int idx = __builtin_amdgcn_readlane((ee < 64) ? me0 : me1, ee & 63);
    pb.u[k] = *(const uint4*)(PU + (size_t)idx * 2048 + lane * 16);
    pb.v[k] = *(const uint4*)(PU + (size_t)idx * 2048 + 1024 + lane * 16);
  }
}
DEV void peer_compute(const PBatch& pb, const f32x2* x, f32x2* y, float mg0, float mg1, int e) {
  float d[4];
#pragma unroll
  for (int k = 0; k < 4; ++k) d[k] = dot_fp8(pb.u[k], x);
#pragma unroll
  for (int k = 0; k < 4; ++k) {
    int ee = e + k;
    float g = __int_as_float(__builtin_amdgcn_readlane(__float_as_int((ee < 64) ? mg0 : mg1), ee & 63));
    float act = wave_total(d[k]) * (1.f / PU_SCALE);
    axpy_fp8(pb.v[k], g * geluf_(act), y);
  }
}
DEV void phase_peer_gather(const Params& p, const float* gnext, bool last) {
  const bfu* XN = (const bfu*)(p.ws + O_ACT);
  const unsigned char* PU = p.ws + O_PU; const unsigned char* PV = p.ws + O_PV;
  const int* PE = (const int*)(p.ws + O_PE); const float* PG = (const float*)(p.ws + O_PG);
  const int lane = tid_() & 63, wv = tid_() >> 6;
  for (int t = bid_() * 4 + wv; t < T; t += gridDim.x * 4) {
    f32x2 x[8], y[8];
    {
      uint4 a = *(const uint4*)(XN + (size_t)t * D + lane * 16);
      uint4 b = *(const uint4*)(XN + (size_t)t * D + lane * 16 + 8);
      x[0] = (f32x2){lo2f(a.x), hi2f(a.x)}; x[1] = (f32x2){lo2f(a.y), hi2f(a.y)}; x[2] = (f32x2){lo2f(a.z), hi2f(a.z)}; x[3] = (f32x2){lo2f(a.w), hi2f(a.w)};
      x[4] = (f32x2){lo2f(b.x), hi2f(b.x)}; x[5] = (f32x2){lo2f(b.y), hi2f(b.y)}; x[6] = (f32x2){lo2f(b.z), hi2f(b.z)}; x[7] = (f32x2){lo2f(b.w), hi2f(b.w)};
    }
#pragma unroll
    for (int i = 0; i < 8; ++i) y[i] = (f32x2){0.f, 0.f};
    const int me0 = PE[(size_t)t * 128 + lane], me1 = PE[(size_t)t * 128 + 64 + lane];
    const float mg0 = PG[(size_t)t * 128 + lane], mg1 = PG[(size_t)t * 128 + 64 + lane];
    PBatch A, B;
    for (int rep = 0; rep < R_GATH; ++rep) {
#pragma unroll
    for (int i = 0; i < 8; ++i) y[i] = (f32x2){0.f, 0.f};
    peer_load(A, PU, PV, me0, me1, 0, lane);
    for (int e = 0; e < 128; e += 8) {
      peer_load(B, PU, PV, me0, me1, e + 4, lane);
      peer_compute(A, x, y, mg0, mg1, e);
      if (e + 8 < 128) peer_load(A, PU, PV, me0, me1, e + 8, lane);
      peer_compute(B, x, y, mg0, mg1, e + 4);
    }
    }
    float* hp = p.out + (size_t)t * D + lane * 16;
    float4 h0 = *(const float4*)(hp), h1 = *(const float4*)(hp + 4), h2 = *(const float4*)(hp + 8), h3 = *(const float4*)(hp + 12);
    float hv[16] = {h0.x, h0.y, h0.z, h0.w, h1.x, h1.y, h1.z, h1.w, h2.x, h2.y, h2.z, h2.w, h3.x, h3.y, h3.z, h3.w};
    float ss = 0.f;
#pragma unroll
    for (int i = 0; i < 8; ++i) {
      hv[i * 2] += y[i].x * (1.f / PV_SCALE); hv[i * 2 + 1] += y[i].y * (1.f / PV_SCALE);
      ss += hv[i * 2] * hv[i * 2] + hv[i * 2 + 1] * hv[i * 2 + 1];
    }
    ss = wave_total(ss);
    const float scl = rsqrtf(ss * (1.f / D) + 1e-6f);
    float gv[16];
    {
      const float* gp = gnext + lane * 16;
      float4 g0 = *(const float4*)(gp), g1 = *(const float4*)(gp + 4), g2 = *(const float4*)(gp + 8), g3 = *(const float4*)(gp + 12);
      float gt[16] = {g0.x, g0.y, g0.z, g0.w, g1.x, g1.y, g1.z, g1.w, g2.x, g2.y, g2.z, g2.w, g3.x, g3.y, g3.z, g3.w};
#pragma unroll
      for (int i = 0; i < 16; ++i) gv[i] = hv[i] * scl * gt[i];
    }
    if (last) {
      *(float4*)(hp) = make_float4(gv[0], gv[1], gv[2], gv[3]); *(float4*)(hp + 4) = make_float4(gv[4], gv[5], gv[6], gv[7]);
      *(float4*)(hp + 8) = make_float4(gv[8], gv[9], gv[10], gv[11]); *(float4*)(hp + 12) = make_float4(gv[12], gv[13], gv[14], gv[15]);
    } else {
      *(float4*)(hp) = make_float4(hv[0], hv[1], hv[2], hv[3]); *(float4*)(hp + 4) = make_float4(hv[4], hv[5], hv[6], hv[7]);
      *(float4*)(hp + 8) = make_float4(hv[8], hv[9], hv[10], hv[11]); *(float4*)(hp + 12) = make_float4(hv[12], hv[13], hv[14], hv[15]);
      bfu* up = (bfu*)(p.ws + O_ACT) + (size_t)t * D + lane * 16;
      *(uint4*)(up) = make_uint4(pack2(gv[0], gv[1]), pack2(gv[2], gv[3]), pack2(gv[4], gv[5]), pack2(gv[6], gv[7]));
      *(uint4*)(up + 8) = make_uint4(pack2(gv[8], gv[9]), pack2(gv[10], gv[11]), pack2(gv[12], gv[13]), pack2(gv[14], gv[15]));
    }
  }
}

#include <cstdint>
#define XB_TMO      128
#define XB_XCNT(j)  (256  + 64 * (j))
#define XB_XSUB(j)  (1280 + 64 * (j))
#define XB_XGEN(j)  (2304 + 64 * (j))
#define XB_TOP      3328
#define XB_TOPGEN   3392
#define XCD_BAR_WORDS 3456
#define XB_SPIN_CAP (1u << 18)
#define LAS __attribute__((address_space(3)))

__device__ __forceinline__ unsigned xb_ld(unsigned* p)              { return __hip_atomic_load(p, __ATOMIC_RELAXED, __HIP_MEMORY_SCOPE_AGENT); }
__device__ __forceinline__ unsigned xb_add(unsigned* p, unsigned v) { return __hip_atomic_fetch_add(p, v, __ATOMIC_RELAXED, __HIP_MEMORY_SCOPE_AGENT); }
__device__ __forceinline__ unsigned xb_xcc_id() { return (unsigned)__builtin_amdgcn_s_getreg((3 << 11) | 20) & 0xFu; }
#define XB_SPIN(cond, bar) do { unsigned _sp = 0; while (cond) { __builtin_amdgcn_s_sleep(1); \
    if ((++_sp & 255u) == 0u) { if (xb_ld(&(bar)[XB_TMO])) break; if (_sp > XB_SPIN_CAP) { atomicAdd(&(bar)[XB_TMO], 1u); break; } } } } while (0)

struct XcdBarrier {
    unsigned* bar; unsigned x;
    volatile LAS unsigned* st;
};

__device__ __forceinline__ XcdBarrier xcd_barrier_post(unsigned* bar, volatile LAS unsigned* st) {
    XcdBarrier b; b.bar = bar; b.x = xb_xcc_id(); b.st = st;
    if (threadIdx.x == 0) (void)xb_add(&bar[XB_XCNT(b.x)], 1u);
    return b;
}
__device__ __forceinline__ void xcd_barrier_complete(unsigned* bar, unsigned x, unsigned& nloc, unsigned& nx) {
    const unsigned G = gridDim.x * gridDim.y * gridDim.z;
    unsigned sum, cnt, mine, sp = 0u;
    for (;;) {
        sum = 0u; cnt = 0u; mine = 0u;
#pragma unroll
        for (unsigned j = 0; j < 16; ++j) { const unsigned c = xb_ld(&bar[XB_XCNT(j)]); sum += c; cnt += (c > 0u) ? 1u : 0u; mine = (j == x) ? c : mine; }
        if (sum == G) break;
        __builtin_amdgcn_s_sleep(1);
        if ((++sp & 255u) == 0u) { if (xb_ld(&bar[XB_TMO])) break; if (sp > XB_SPIN_CAP) { atomicAdd(&bar[XB_TMO], 1u); break; } }
    }
    nloc = mine > 0u ? mine : 1u; nx = cnt > 0u ? cnt : 1u;
}

__device__ __forceinline__ void xcd_barrier(const XcdBarrier& b) {
    asm volatile("s_waitcnt vmcnt(0)" ::: "memory");
    __syncthreads();
    if (threadIdx.x == 0) {
        unsigned* bar = b.bar;
        __builtin_amdgcn_s_waitcnt(0);
        unsigned nloc = b.st[0], nx = b.st[1];
        if (nloc == 0u) { xcd_barrier_complete(bar, b.x, nloc, nx); b.st[0] = nloc; b.st[1] = nx; }
        const unsigned old = xb_add(&bar[XB_XSUB(b.x)], 1u);
        const unsigned gen = old / nloc;
        if (old + 1u == (gen + 1u) * nloc) {
            __builtin_amdgcn_fence(__ATOMIC_RELEASE, "agent");
            asm volatile("s_waitcnt vmcnt(0)" ::: "memory");
            const unsigned og = xb_add(&bar[XB_TOP], 1u);
            const unsigned tg = og / nx;
            if (og + 1u == (tg + 1u) * nx) xb_add(&bar[XB_TOPGEN], 1u);
            else XB_SPIN(xb_ld(&bar[XB_TOPGEN]) == tg, bar);
            __builtin_amdgcn_fence(__ATOMIC_ACQUIRE, "agent");
            xb_add(&bar[XB_XGEN(b.x)], 1u);
            asm volatile("s_waitcnt vmcnt(0)" ::: "memory");
        } else {
            XB_SPIN(xb_ld(&bar[XB_XGEN(b.x)]) == gen, bar);
            __builtin_amdgcn_fence(__ATOMIC_ACQUIRE, "agent");
            asm volatile("s_waitcnt vmcnt(0)" ::: "memory");
        }
    }
    __syncthreads();
}

__shared__ uint4 xb_words;
DEV void seam_barrier(unsigned char* ws) {
  XcdBarrier b; b.bar = (unsigned*)(ws + O_XB); b.x = xb_xcc_id(); b.st = (volatile LAS unsigned*)&xb_words;
  xcd_barrier(b);
}

DEV void launder_all(Params& q) {
  const float** pp = (const float**)&q;
#pragma unroll
  for (int i = 0; i < 39; ++i) { const float* t = pp[i]; asm volatile("" : "+s"(t)); pp[i] = t; }
}
__global__ void __launch_bounds__(NTHR, 2) fwd_megakernel(Params p0) {
  cg::grid_group grid = cg::this_grid();
  int ph = 0;
  if (threadIdx.x == 0) xb_words = make_uint4(0u, 0u, 0u, 0u);
  __syncthreads();
#define PHASE(body) { if (ph >= p0.ph_lo && ph < p0.ph_hi) { Params q_ = p0; launder_all(q_); { const Params& p = q_; body; } \
    if (ph + 1 < p0.ph_hi) { if (ph == 0) { grid.sync(); (void)xcd_barrier_post((unsigned*)(q_.ws + O_XB), (volatile LAS unsigned*)&xb_words); } else seam_barrier(q_.ws); } } ++ph; }
  PHASE(phase_convert(p); phase_norm(p.x, p.mix_norm, (bfu*)(p.ws + O_ACT)))
  for (int l = 0; l < DEPTH; ++l) {
#define wb (p.ws + O_W + (size_t)l * W_SZ)
    PHASE(for (int rep = 0; rep < R_GEMM; ++rep) gemm_phase<0>((const bfu*)(p.ws + O_ACT), (const bfu*)(wb + W_IN), NIN, 1024, (bfu*)(p.ws + O_COLS), NIN, (float*)(p.ws + O_SIDE), nullptr, nullptr))
    PHASE(for (int rep = 0; rep < R_PREP; ++rep) phase_rwkv_prep(p, l))
    PHASE(phase_mix_scan_finish(p, l))
    PHASE(phase_rwkv_post(p, l))
    PHASE(gemm_phase<1>((const bfu*)(p.ws + O_ACT), (const bfu*)(wb + W_OUT), 1024, 1024, nullptr, 0, nullptr, l == 0 ? p.x : p.out, p.out); convert_peer_uv(p, l))
    PHASE(phase_norm(p.out, p.ffn_norm + (size_t)l * D, (bfu*)(p.ws + O_ACT)))
    PHASE(for (int rep = 0; rep < R_GEMM; ++rep) gemm_phase<2>((const bfu*)(p.ws + O_ACT), (const bfu*)(wb + W_Q), 2048, 1024, (bfu*)(p.ws + O_PQ), 2048, nullptr, nullptr, nullptr))
    PHASE(for (int rep = 0; rep < R_TOPK; ++rep) phase_peer_topk(p, l))
    PHASE(phase_peer_gather(p, l + 1 < DEPTH ? p.mix_norm + (size_t)(l + 1) * D : p.final_norm, l + 1 == DEPTH))
  }
}

extern "C" void kernel_launch(void* const* d_in, const int* in_sizes, int n_in, void* d_out, int out_size, void* d_ws, size_t ws_size,
                              hipStream_t stream) {
  static int grid_blocks = 0;
  if (!grid_blocks) {
    int dev = 0, cus = 0, per_cu = 0;
    hipGetDevice(&dev);
    hipDeviceGetAttribute(&cus, hipDeviceAttributeMultiprocessorCount, dev);
    hipOccupancyMaxActiveBlocksPerMultiprocessor(&per_cu, fwd_megakernel, NTHR, 0);
    if (per_cu > 2) per_cu = 2;
    grid_blocks = cus * per_cu;
  }
  Params p{};
  const float** pp = (const float**)&p;
  for (int i = 0; i < 37; ++i) pp[i] = (const float*)d_in[i];
  p.out = (float*)d_out; p.ws = (unsigned char*)d_ws; p.ph_lo = 0; p.ph_hi = 1000;
  void* args[] = {&p};
  hipError_t e = hipLaunchCooperativeKernel((void*)fwd_megakernel, dim3(grid_blocks), dim3(NTHR), args, 0, stream);
  if (e != hipSuccess) fprintf(stderr, "cooperative launch failed: %s (grid %d)\n", hipGetErrorString(e), grid_blocks);
}
```

```cpp
#include <hip/hip_runtime.h>
#include <hip/hip_bf16.h>
#include <hip/hip_cooperative_groups.h>
#include <cstdio>
namespace cg = cooperative_groups;

typedef unsigned short bfu;
using bf16x8 = __attribute__((ext_vector_type(8))) short;
using f32x4 = __attribute__((ext_vector_type(4))) float;

#define DEV __device__ __forceinline__

constexpr int Bsz = 4, S = 8192, T = Bsz * S, D = 1024, NIN = 2960, DEPTH = 2;
constexpr int C_SSM = 0, C_LRU = 772, C_RWKV = 1284, C_NSA = 2308;
constexpr int C_Z = 0, C_XBC = 256, C_DT = 768;
constexpr int C_LG = 772, C_LX = 1028;
constexpr int C_Q = 2308, C_KC = 2564, C_VC = 2628, C_KS = 2692, C_VS = 2756, C_KW = 2820, C_VW = 2884, C_GT = 2948;
constexpr int NCH = 128;
constexpr int NTHR = 256;
#ifndef R_GEMM
#define R_GEMM 1
#endif
#ifndef R_PREP
#define R_PREP 1
#endif
#ifndef R_SCAN
#define R_SCAN 1
#endif
#ifndef R_FIN
#define R_FIN 1
#endif
#ifndef R_TOPK
#define R_TOPK 1
#endif
#ifndef R_GATH
#define R_GATH 1
#endif
#ifndef R_CMPA
#define R_CMPA 1
#endif

constexpr size_t AL(size_t x) { return (x + 255) & ~(size_t)255; }
constexpr size_t O_ACT = 0;
constexpr size_t O_COLS = O_ACT + AL((size_t)T * 1024 * 2);
constexpr size_t O_SIDE = O_COLS + AL((size_t)T * NIN * 2);
constexpr size_t O_RIN = O_SIDE + AL((size_t)T * 16 * 4);
constexpr size_t O_RY = O_RIN + AL((size_t)16 * S * 896);
constexpr size_t O_RG = O_RY + AL((size_t)T * 256 * 4);
constexpr size_t O_SST = O_RG + AL((size_t)T * 256 * 2);
constexpr size_t O_SAT = O_SST + AL((size_t)16 * NCH * 4096 * 4);
constexpr size_t O_LA = O_SAT + AL((size_t)16 * NCH * 4);
constexpr size_t O_LH = O_LA + AL((size_t)4 * NCH * 256 * 4);
constexpr size_t O_KCMP = O_LH + AL((size_t)4 * NCH * 256 * 4);
constexpr size_t O_VCT = O_KCMP + AL((size_t)4 * 512 * 64 * 2);
constexpr size_t O_VWT = O_VCT + AL((size_t)4 * 512 * 64 * 2);
constexpr size_t O_VST = O_VWT + AL((size_t)4 * 64 * S * 2);
constexpr size_t O_OCMP = O_VST + AL((size_t)4 * 64 * S * 2);
constexpr size_t O_SEL = O_OCMP + AL((size_t)T * 256 * 2);
constexpr size_t O_SYNC = O_SEL + AL((size_t)T * 16);
constexpr size_t O_XB = O_SYNC + 256;
constexpr size_t O_W = O_XB + 16384;
constexpr size_t W_IN = 0;
constexpr size_t W_OUT = W_IN + AL((size_t)NIN * 1024 * 2);
constexpr size_t W_Q = W_OUT + AL((size_t)1024 * 1024 * 2);
constexpr size_t W_KEYS = W_Q + AL((size_t)2048 * 1024 * 2);
constexpr size_t W_C1 = W_KEYS + AL((size_t)16 * 128 * 128 * 2);
constexpr size_t W_C2 = W_C1 + AL((size_t)2 * 256 * 2048 * 2);
constexpr size_t W_LA = W_C2 + AL((size_t)2 * 64 * 256 * 2);
constexpr size_t W_LI = W_LA + AL((size_t)4 * 64 * 64 * 2);
constexpr size_t W_R2 = W_LI + AL((size_t)4 * 64 * 64 * 2);
constexpr size_t W_A2 = W_R2 + AL((size_t)256 * 64 * 2);
constexpr size_t W_G2 = W_A2 + AL((size_t)256 * 64 * 2);
constexpr size_t W_SZ = W_G2 + AL((size_t)256 * 128 * 2);
constexpr size_t O_END = O_W + 2 * W_SZ;
constexpr size_t O_PU = O_COLS;
constexpr size_t O_PV = O_PU + AL((size_t)16384 * 1024);
constexpr size_t O_PQ = O_PV + AL((size_t)16384 * 1024);
constexpr size_t O_PE = O_PQ + AL((size_t)T * 2048 * 2);
constexpr size_t O_PG = O_PE + AL((size_t)T * 128 * 4);
constexpr size_t O_PEND = O_PG + AL((size_t)T * 128 * 4);
static_assert(O_PEND <= O_RY, "peer scratch overlaps live buffers");
static_assert(O_END <= (size_t)536870912, "workspace too large");

struct Params {
  const float* x; const float* mix_norm; const float* w_in; const float* w_out;
  const float* ssm_conv_w; const float* ssm_conv_b; const float* ssm_dt_bias; const float* ssm_a_log; const float* ssm_d; const float* ssm_norm;
  const float* lru_conv_w; const float* lru_conv_b; const float* lru_wa; const float* lru_ba; const float* lru_wi; const float* lru_bi; const float* lru_lambda;
  const float* rwkv_mu; const float* rwkv_w0; const float* rwkv_w2; const float* rwkv_a0; const float* rwkv_a2; const float* rwkv_g2;
  const float* rwkv_kk; const float* rwkv_ka; const float* rwkv_rk; const float* rwkv_ln_w; const float* rwkv_ln_b;
  const float* nsa_cmp_pos; const float* nsa_cmp_w1; const float* nsa_cmp_w2;
  const float* ffn_norm; const float* peer_wq; const float* peer_keys; const float* peer_u; const float* peer_v; const float* final_norm;
  float* out; unsigned char* ws;
  int ph_lo, ph_hi;
};

DEV int tid_() { int t = threadIdx.x; asm volatile("" : "+v"(t)); return t; }
DEV int bid_() { int b = blockIdx.x; asm volatile("" : "+s"(b)); return b; }
DEV bfu f2bf(float f) { unsigned u = __float_as_uint(f); u += 0x7fffu + ((u >> 16) & 1u); return (bfu)(u >> 16); }
DEV float bf2f(bfu b) { return __uint_as_float(((unsigned)b) << 16); }
DEV unsigned pack2(float a, float b) { return (unsigned)f2bf(a) | ((unsigned)f2bf(b) << 16); }
DEV float lo2f(unsigned u) { return __uint_as_float(u << 16); }
DEV float hi2f(unsigned u) { return __uint_as_float(u & 0xffff0000u); }
DEV float sigmoidf_(float x) { return 1.f / (1.f + __expf(-x)); }
DEV float siluf_(float x) { return x / (1.f + __expf(-x)); }
DEV float softplusf_(float x) { return fmaxf(x, 0.f) + log1pf(__expf(-fabsf(x))); }
DEV float geluf_(float x) { float u = 0.7978845608028654f * (x + 0.044715f * x * x * x); return 0.5f * x * (1.f + tanhf(u)); }

template <int CTRL> DEV float dppf(float v) {
  return __int_as_float(__builtin_amdgcn_update_dpp(0, __float_as_int(v), CTRL, 0xf, 0xf, true));
}
DEV float row16_sum(float v) { v += dppf<0xB1>(v); v += dppf<0x4E>(v); v += dppf<0x141>(v); v += dppf<0x140>(v); return v; }
DEV float row16_max(float v) { v = fmaxf(v, dppf<0xB1>(v)); v = fmaxf(v, dppf<0x4E>(v)); v = fmaxf(v, dppf<0x141>(v)); v = fmaxf(v, dppf<0x140>(v)); return v; }
DEV float wave_sum(float v) { v = row16_sum(v); v += __shfl_xor(v, 16); v += __shfl_xor(v, 32); return v; }

DEV bf16x8 ld8(const bfu* p) { return *(const bf16x8*)p; }
DEV f32x4 mfma16(bf16x8 a, bf16x8 b, f32x4 c) { return __builtin_amdgcn_mfma_f32_16x16x32_bf16(a, b, c, 0, 0, 0); }

DEV void mfma16_acc(f32x4& c, bf16x8 a, bf16x8 b) { asm("v_mfma_f32_16x16x32_bf16 %0, %1, %2, %0" : "+a"(c) : "v"(a), "v"(b)); }
DEV void gld_async(bf16x8& v, const bfu* p) { asm volatile("global_load_dwordx4 %0, %1, off" : "=v"(v) : "v"(p) : "memory"); }
template <int N> DEV void gwait6(bf16x8& a0, bf16x8& a1, bf16x8& a2, bf16x8& a3, bf16x8& b0, bf16x8& b1) {
  asm volatile("s_waitcnt vmcnt(%6)" : "+v"(a0), "+v"(a1), "+v"(a2), "+v"(a3), "+v"(b0), "+v"(b1) : "n"(N) : "memory");
}
__shared__ __attribute__((aligned(16))) unsigned char smem[61440];
__shared__ int s_qitem;

DEV void transpose_tile(const float* src, bfu* dst, int R, int C, int tr, int tc) {
  float* tl = (float*)smem;
  int tid = tid_();
  __syncthreads();
  for (int i = tid; i < 4096; i += NTHR) {
    int r = i >> 6, c = i & 63;
    int gr = tr * 64 + r, gc = tc * 64 + c;
    tl[r * 65 + c] = (gr < R && gc < C) ? src[(size_t)gr * C + gc] : 0.f;
  }
  __syncthreads();
  for (int i = tid; i < 4096; i += NTHR) {
    int c = i >> 6, r = i & 63;
    int gr = tr * 64 + r, gc = tc * 64 + c;
    if (gr < R && gc < C) dst[(size_t)gc * R + gr] = f2bf(tl[r * 65 + c]);
  }
}
struct TJob { const float* src; bfu* dst; int R, C; };
DEV void phase_convert(const Params& p) {
  if (bid_() == 0) { if (tid_() < 64) ((unsigned*)(p.ws + O_SYNC))[tid_()] = 0u; for (int i = tid_(); i < 4096; i += NTHR) ((unsigned*)(p.ws + O_XB))[i] = 0u; }
  for (int l = 0; l < DEPTH; ++l) {
    unsigned char* wb = p.ws + O_W + (size_t)l * W_SZ;
    for (int j = 0; j < 20; ++j) {
      const float* src; bfu* dst; int R, C;
      if (j == 0) { src = p.w_in + (size_t)l * 1024 * NIN; dst = (bfu*)(wb + W_IN); R = 1024; C = NIN; }
      else if (j == 1) { src = p.w_out + (size_t)l * 1024 * 1024; dst = (bfu*)(wb + W_OUT); R = 1024; C = 1024; }
      else if (j == 2) { src = p.peer_wq + (size_t)l * 1024 * 2048; dst = (bfu*)(wb + W_Q); R = 1024; C = 2048; }
      else if (j < 5) { int k = j - 3; src = p.nsa_cmp_w1 + ((size_t)l * 2 + k) * 2048 * 256; dst = (bfu*)(wb + W_C1) + (size_t)k * 256 * 2048; R = 2048; C = 256; }
      else if (j < 7) { int k = j - 5; src = p.nsa_cmp_w2 + ((size_t)l * 2 + k) * 256 * 64; dst = (bfu*)(wb + W_C2) + (size_t)k * 64 * 256; R = 256; C = 64; }
      else if (j < 11) { int k = j - 7; src = p.lru_wa + ((size_t)l * 4 + k) * 4096; dst = (bfu*)(wb + W_LA) + k * 4096; R = 64; C = 64; }
      else if (j < 15) { int k = j - 11; src = p.lru_wi + ((size_t)l * 4 + k) * 4096; dst = (bfu*)(wb + W_LI) + k * 4096; R = 64; C = 64; }
      else if (j == 15) { src = p.rwkv_w2 + (size_t)l * 64 * 256; dst = (bfu*)(wb + W_R2); R = 64; C = 256; }
      else if (j == 16) { src = p.rwkv_a2 + (size_t)l * 64 * 256; dst = (bfu*)(wb + W_A2); R = 64; C = 256; }
      else if (j == 17) { src = p.rwkv_g2 + (size_t)l * 128 * 256; dst = (bfu*)(wb + W_G2); R = 128; C = 256; }
      else continue;
      int ntr = (R + 63) / 64, ntc = (C + 63) / 64;
      for (int t = bid_(); t < ntr * ntc; t += gridDim.x) transpose_tile(src, dst, R, C, t / ntc, t % ntc);
    }
    {
      const float* src = p.peer_keys + (size_t)l * 16 * 128 * 128; bfu* dst = (bfu*)(wb + W_KEYS);
      for (int i = bid_() * NTHR + tid_(); i < 16 * 128 * 128; i += gridDim.x * NTHR) dst[i] = f2bf(src[i]);
    }
  }
}
constexpr float PU_SCALE = 512.f, PV_SCALE = 128.f;
DEV unsigned pack_fp8x4(float a, float b, float c, float d, float sc) {
  a = fminf(fmaxf(a * sc, -448.f), 448.f); b = fminf(fmaxf(b * sc, -448.f), 448.f);
  c = fminf(fmaxf(c * sc, -448.f), 448.f); d = fminf(fmaxf(d * sc, -448.f), 448.f);
  int w = 0;
  w = __builtin_amdgcn_cvt_pk_fp8_f32(a, b, w, false);
  w = __builtin_amdgcn_cvt_pk_fp8_f32(c, d, w, true);
  return (unsigned)w;
}
DEV void convert_peer_uv(const Params& p, int l) {
  typedef float f4v __attribute__((ext_vector_type(4)));
  const f4v* su = (const f4v*)(p.peer_u + (size_t)l * 16384 * 1024);
  const f4v* sv = (const f4v*)(p.peer_v + (size_t)l * 16384 * 1024);
  unsigned* duv = (unsigned*)(p.ws + O_PU);
  const int n4 = 16384 * 1024 / 4;
  const int stride = gridDim.x * NTHR;
  for (int i0 = bid_() * NTHR + tid_(); i0 < n4; i0 += stride * 4) {
    f4v a[4], b[4];
#pragma unroll
    for (int k = 0; k < 4; ++k) {
      const int i = i0 + k * stride;
      if (i < n4) { a[k] = __builtin_nontemporal_load(su + i); b[k] = __builtin_nontemporal_load(sv + i); }
    }
#pragma unroll
    for (int k = 0; k < 4; ++k) {
      const int i = i0 + k * stride;
      if (i < n4) {
        const int e = i >> 8, c = i & 255;
        duv[e * 512 + c] = pack_fp8x4(a[k].x, a[k].y, a[k].z, a[k].w, PU_SCALE);
        duv[e * 512 + 256 + c] = pack_fp8x4(b[k].x, b[k].y, b[k].z, b[k].w, PV_SCALE);
      }
    }
  }
}

DEV void phase_norm(const float* h, const float* g, bfu* dst) {
  int lane = tid_() & 63, wv = tid_() >> 6;
  for (int t = bid_() * 4 + wv; t < T; t += gridDim.x * 4) {
    const float4* hp = (const float4*)(h + (size_t)t * D);
    float4 v[4]; float ss = 0.f;
#pragma unroll
    for (int i = 0; i < 4; ++i) { v[i] = hp[lane + i * 64]; ss += v[i].x * v[i].x + v[i].y * v[i].y + v[i].z * v[i].z + v[i].w * v[i].w; }
    ss = wave_sum(ss);
    float sc = rsqrtf(ss * (1.f / D) + 1e-6f);
#pragma unroll
    for (int i = 0; i < 4; ++i) {
      float4 gg = ((const float4*)g)[lane + i * 64];
      uint2 o = make_uint2(pack2(v[i].x * sc * gg.x, v[i].y * sc * gg.y), pack2(v[i].z * sc * gg.z, v[i].w * sc * gg.w));
      ((uint2*)(dst + (size_t)t * D))[lane + i * 64] = o;
    }
  }
}

template <int N> DEV void gwait4(bf16x8& a0, bf16x8& a1, bf16x8& b0, bf16x8& b1) {
  asm volatile("s_waitcnt vmcnt(%4)" : "+v"(a0), "+v"(a1), "+v"(b0), "+v"(b1) : "n"(N) : "memory");
}
template <int MODE>
DEV void gemm_phase(const bfu* __restrict__ A, const bfu* __restrict__ Bt, int N, int K,
                    bfu* __restrict__ Cb, int ldc, float* __restrict__ side, const float* __restrict__ hin, float* __restrict__ hout) {
  constexpr int STR = 32;
  constexpr int BUFE = 256 * STR;
  bfu* As = (bfu*)smem;
  bfu* Bs = As + 128 * STR;
  const int tid = tid_(), lane = tid & 63, wv = tid >> 6;
  const int wm = wv >> 1, wn = wv & 1;
  const int ntn = (N + 127) / 128, ntm = T / 128;
  const int lr = lane & 15, lq = lane >> 4;
  const int swz = (lq ^ ((0x1320 >> (((lr >> 2) & 3) * 4)) & 3)) * 8;
  const int bid = bid_();
  const bool xmap = (gridDim.x & 7) == 0;
  const int ns = (ntn >= 16) ? 2 : 1;
  const int xcd = bid & 7, nloc = xmap ? (int)(gridDim.x >> 3) : (int)gridDim.x;
  const int ntn_p = xmap ? ntn / ns : ntn, mstep = xmap ? 8 / ns : 1;
  const int xs = xmap ? xcd % ns : 0, xm = xmap ? xcd / ns : 0;
  const int ntile_x = xmap ? (ntm / mstep) * ntn_p : ntm * ntn;
  for (int u = xmap ? (bid >> 3) : bid; u < ntile_x; u += nloc) {
    const int tm = (u / ntn_p) * mstep + xm, tn = xs * ntn_p + (u % ntn_p);
    const int m0 = tm * 128, n0 = tn * 128;
    f32x4 acc[4][4];
#pragma unroll
    for (int i = 0; i < 4; ++i)
#pragma unroll
      for (int j = 0; j < 4; ++j) acc[i][j] = (f32x4){0.f, 0.f, 0.f, 0.f};
    const bfu* ap[2]; const bfu* bp[2]; int so[2];
#pragma unroll
    for (int i = 0; i < 2; ++i) {
      int c = tid + i * NTHR; int row = c >> 2, kc = c & 3;
      ap[i] = A + (size_t)(m0 + row) * K + kc * 8;
      so[i] = row * STR + ((kc ^ ((0x1320 >> (((row >> 2) & 3) * 4)) & 3)) * 8);
      int nr = n0 + row; if (nr > N - 1) nr = N - 1;
      bp[i] = Bt + (size_t)nr * K + kc * 8;
    }
    bf16x8 ra[2][2], rb[2][2];
    __syncthreads();
#pragma unroll
    for (int i = 0; i < 2; ++i) { *(bf16x8*)(As + so[i]) = ld8(ap[i]); *(bf16x8*)(Bs + so[i]) = ld8(bp[i]); }
#pragma unroll
    for (int q = 0; q < 2; ++q)
#pragma unroll
      for (int i = 0; i < 2; ++i) { gld_async(ra[q][i], ap[i] + (q + 1) * 32); gld_async(rb[q][i], bp[i] + (q + 1) * 32); }
    const int nst = K / 32;
    for (int st = 0; st < nst; st += 2) {
#pragma unroll
      for (int q = 0; q < 2; ++q) {
        const int sidx = st + q;
        const bfu* Ar = As + q * BUFE;
        const bfu* Br = Bs + q * BUFE;
        bfu* Aw = As + (q ^ 1) * BUFE;
        bfu* Bw = Bs + (q ^ 1) * BUFE;
        __syncthreads();
        bf16x8 af[4], bfr[4];
#pragma unroll
        for (int i = 0; i < 4; ++i) af[i] = *(const bf16x8*)(Ar + (wm * 64 + i * 16 + lr) * STR + swz);
#pragma unroll
        for (int j = 0; j < 4; ++j) bfr[j] = *(const bf16x8*)(Br + (wn * 64 + j * 16 + lr) * STR + swz);
        const int kn = (sidx + 3 < nst ? sidx + 3 : nst - 1) * 32;
        gwait4<4>(ra[q][0], ra[q][1], rb[q][0], rb[q][1]);
#pragma unroll
        for (int i = 0; i < 2; ++i) { *(bf16x8*)(Aw + so[i]) = ra[q][i]; *(bf16x8*)(Bw + so[i]) = rb[q][i]; }
#pragma unroll
        for (int i = 0; i < 2; ++i) { gld_async(ra[q][i], ap[i] + kn); gld_async(rb[q][i], bp[i] + kn); }
#pragma unroll
        for (int i = 0; i < 4; ++i)
#pragma unroll
          for (int j = 0; j < 4; ++j) mfma16_acc(acc[i][j], bfr[j], af[i]);
      }
    }
#pragma unroll
    for (int q = 0; q < 2; ++q) gwait4<0>(ra[q][0], ra[q][1], rb[q][0], rb[q][1]);
    asm volatile("s_nop 7\n\ts_nop 7\n\ts_nop 7" ::: "memory");
#pragma unroll
    for (int i = 0; i < 4; ++i) {
      const int row = m0 + wm * 64 + i * 16 + lr;
#pragma unroll
      for (int j = 0; j < 4; ++j) {
        const int col = n0 + wn * 64 + j * 16 + lq * 4;
        const f32x4 v = acc[i][j];
        if (MODE == 0) {
          if (col < N) {
            *(uint2*)(Cb + (size_t)row * ldc + col) = make_uint2(pack2(v[0], v[1]), pack2(v[2], v[3]));
            if (col == C_DT) *(float4*)(side + (size_t)row * 16) = make_float4(v[0], v[1], v[2], v[3]);
            if (col >= C_GT) *(float4*)(side + (size_t)row * 16 + 4 + (col - C_GT)) = make_float4(v[0], v[1], v[2], v[3]);
          }
        } else if (MODE == 1) {
          const size_t o = (size_t)row * D + col;
          const float4 h = *(const float4*)(hin + o);
          *(float4*)(hout + o) = make_float4(h.x + v[0], h.y + v[1], h.z + v[2], h.w + v[3]);
        } else {
          *(uint2*)(Cb + (size_t)row * ldc + col) = make_uint2(pack2(v[0], v[1]), pack2(v[2], v[3]));
        }
      }
    }
  }
}

template <int MODE>
DEV void ssd_item(const Params& p, int l, int item) {
  const int g = item & 1, c = (item >> 1) & 127, b = item >> 8;
  const int tid = tid_(), lane = tid & 63, wv = tid >> 6, lr = lane & 15, lq = lane >> 4;
  const bfu* COLS = (const bfu*)(p.ws + O_COLS);
  const float* SIDE = (const float*)(p.ws + O_SIDE);
  float* ST = (float*)(p.ws + O_SST);
  const int tb = b * S + c * 64;
  float* s_dt = (float*)smem;
  float* s_acs = s_dt + 128;
  bfu* XT = (bfu*)(smem + 1024);
  bfu* Bm = XT + 128 * 72;
  bfu* Cm = Bm + 64 * 72;
  bfu* Mw = Cm + 64 * 72 + wv * (16 * 72);
  __syncthreads();
  if (wv < 2) {
    int h = g * 2 + wv;
    float dtv = softplusf_(SIDE[(size_t)(tb + lane) * 16 + h] + p.ssm_dt_bias[l * 4 + h]);
    float s = -__expf(p.ssm_a_log[l * 4 + h]) * dtv;
    for (int o = 1; o < 64; o <<= 1) { float t = __shfl_up(s, o); if (lane >= o) s += t; }
    s_dt[wv * 64 + lane] = dtv; s_acs[wv * 64 + lane] = s;
  }
  __syncthreads();
  {
    const int cg8 = tid & 31, tg = tid >> 5;
    const int lc = cg8 * 8;
    const int xc = (lc < 128) ? (g * 128 + lc) : (lc < 192 ? 256 + g * 64 + (lc - 128) : 384 + g * 64 + (lc - 192));
    if (MODE == 1 || lc < 192) {
      float w[4][8], bias[8];
#pragma unroll
      for (int i = 0; i < 8; ++i) {
        bias[i] = p.ssm_conv_b[l * 512 + xc + i];
#pragma unroll
        for (int k = 0; k < 4; ++k) w[k][i] = p.ssm_conv_w[(l * 4 + k) * 512 + xc + i];
      }
      const int tl0 = tg * 8;
      float win[3][8];
      float outv[8][8];
#pragma unroll
      for (int rr = 0; rr < 11; ++rr) {
        int tl = tl0 - 3 + rr; int tpos = c * 64 + tl;
        float cur[8];
        if (tpos >= 0) {
          uint4 u = *(const uint4*)(COLS + (size_t)(b * S + tpos) * NIN + C_XBC + xc);
          cur[0] = lo2f(u.x); cur[1] = hi2f(u.x); cur[2] = lo2f(u.y); cur[3] = hi2f(u.y); cur[4] = lo2f(u.z); cur[5] = hi2f(u.z); cur[6] = lo2f(u.w); cur[7] = hi2f(u.w);
        } else {
#pragma unroll
          for (int i = 0; i < 8; ++i) cur[i] = 0.f;
        }
        if (rr >= 3) {
#pragma unroll
          for (int i = 0; i < 8; ++i) {
            float a = bias[i] + w[0][i] * win[0][i] + w[1][i] * win[1][i] + w[2][i] * win[2][i] + w[3][i] * cur[i];
            outv[rr - 3][i] = siluf_(a);
          }
        }
#pragma unroll
        for (int i = 0; i < 8; ++i) { win[0][i] = win[1][i]; win[1][i] = win[2][i]; win[2][i] = cur[i]; }
      }
      if (lc < 128) {
        const int hh = lc >> 6;
        float sc[8];
#pragma unroll
        for (int j = 0; j < 8; ++j) {
          float d = s_dt[hh * 64 + tl0 + j];
          if (MODE == 0) d *= __expf(s_acs[hh * 64 + 63] - s_acs[hh * 64 + tl0 + j]);
          sc[j] = d;
        }
#pragma unroll
        for (int i = 0; i < 8; ++i) {
          uint4 o = make_uint4(pack2(outv[0][i] * sc[0], outv[1][i] * sc[1]), pack2(outv[2][i] * sc[2], outv[3][i] * sc[3]),
                               pack2(outv[4][i] * sc[4], outv[5][i] * sc[5]), pack2(outv[6][i] * sc[6], outv[7][i] * sc[7]));
          *(uint4*)(XT + (lc + i) * 72 + tl0) = o;
        }
      } else if (lc < 192) {
        if (MODE == 0) {
#pragma unroll
          for (int i = 0; i < 8; ++i) {
            uint4 o = make_uint4(pack2(outv[0][i], outv[1][i]), pack2(outv[2][i], outv[3][i]), pack2(outv[4][i], outv[5][i]), pack2(outv[6][i], outv[7][i]));
            *(uint4*)(Bm + (lc - 128 + i) * 72 + tl0) = o;
          }
        } else {
#pragma unroll
          for (int j = 0; j < 8; ++j) {
            uint4 o = make_uint4(pack2(outv[j][0], outv[j][1]), pack2(outv[j][2], outv[j][3]), pack2(outv[j][4], outv[j][5]), pack2(outv[j][6], outv[j][7]));
            *(uint4*)(Bm + (tl0 + j) * 72 + (lc - 128)) = o;
          }
        }
      } else {
#pragma unroll
        for (int j = 0; j < 8; ++j) {
          uint4 o = make_uint4(pack2(outv[j][0], outv[j][1]), pack2(outv[j][2], outv[j][3]), pack2(outv[j][4], outv[j][5]), pack2(outv[j][6], outv[j][7]));
          *(uint4*)(Cm + (tl0 + j) * 72 + (lc - 192)) = o;
        }
      }
    }
  }
  __syncthreads();
  if (MODE == 0) {
    const int hh = wv >> 1, ph = wv & 1, h = g * 2 + hh;
    f32x4 acc[2][4];
#pragma unroll
    for (int i = 0; i < 2; ++i)
#pragma unroll
      for (int j = 0; j < 4; ++j) acc[i][j] = (f32x4){0.f, 0.f, 0.f, 0.f};
#pragma unroll
    for (int ks = 0; ks < 2; ++ks) {
      bf16x8 af[2], bfr[4];
#pragma unroll
      for (int i = 0; i < 2; ++i) af[i] = *(const bf16x8*)(XT + (hh * 64 + ph * 32 + i * 16 + lr) * 72 + ks * 32 + lq * 8);
#pragma unroll
      for (int j = 0; j < 4; ++j) bfr[j] = *(const bf16x8*)(Bm + (j * 16 + lr) * 72 + ks * 32 + lq * 8);
#pragma unroll
      for (int i = 0; i < 2; ++i)
#pragma unroll
        for (int j = 0; j < 4; ++j) acc[i][j] = mfma16(af[i], bfr[j], acc[i][j]);
    }
    float* dst = ST + ((size_t)((b * 4 + h) * NCH + c)) * 4096;
#pragma unroll
    for (int i = 0; i < 2; ++i)
#pragma unroll
      for (int j = 0; j < 4; ++j)
#pragma unroll
        for (int r = 0; r < 4; ++r) dst[(ph * 32 + i * 16 + lq * 4 + r) * 64 + j * 16 + lr] = acc[i][j][r];
    if (tid < 2) ((float*)(p.ws + O_SAT))[(b * 4 + g * 2 + tid) * NCH + c] = s_acs[tid * 64 + 63];
  } else {
    bf16x8 cf[2];
#pragma unroll
    for (int ks = 0; ks < 2; ++ks) cf[ks] = *(const bf16x8*)(Cm + (wv * 16 + lr) * 72 + ks * 32 + lq * 8);
    f32x4 G[4];
#pragma unroll
    for (int st = 0; st < 4; ++st) {
      G[st] = (f32x4){0.f, 0.f, 0.f, 0.f};
      if (st <= wv) {
#pragma unroll
        for (int ks = 0; ks < 2; ++ks) G[st] = mfma16(cf[ks], *(const bf16x8*)(Bm + (st * 16 + lr) * 72 + ks * 32 + lq * 8), G[st]);
      }
    }
    f32x4 Y[2][4];
#pragma unroll
    for (int hh = 0; hh < 2; ++hh) {
      const int h = g * 2 + hh;
      const float* Hs = ST + ((size_t)((b * 4 + h) * NCH + c)) * 4096;
      float al[4];
#pragma unroll
      for (int r = 0; r < 4; ++r) al[r] = s_acs[hh * 64 + wv * 16 + lq * 4 + r];
#pragma unroll
      for (int pt = 0; pt < 4; ++pt) {
        f32x4 y = {0.f, 0.f, 0.f, 0.f};
#pragma unroll
        for (int ks = 0; ks < 2; ++ks) {
          const float4* hp = (const float4*)(Hs + (pt * 16 + lr) * 64 + ks * 32 + lq * 8);
          float4 h0 = hp[0], h1 = hp[1];
          bf16x8 hb;
          unsigned u0 = pack2(h0.x, h0.y), u1 = pack2(h0.z, h0.w), u2 = pack2(h1.x, h1.y), u3 = pack2(h1.z, h1.w);
          hb[0] = (short)(u0 & 0xffff); hb[1] = (short)(u0 >> 16); hb[2] = (short)(u1 & 0xffff); hb[3] = (short)(u1 >> 16);
          hb[4] = (short)(u2 & 0xffff); hb[5] = (short)(u2 >> 16); hb[6] = (short)(u3 & 0xffff); hb[7] = (short)(u3 >> 16);
          y = mfma16(cf[ks], hb, y);
        }
#pragma unroll
        for (int r = 0; r < 4; ++r) y[r] *= __expf(al[r]);
        Y[hh][pt] = y;
      }
#pragma unroll
      for (int st = 0; st < 4; ++st) {
        float as = s_acs[hh * 64 + st * 16 + lr];
#pragma unroll
        for (int r = 0; r < 4; ++r) {
          int ll = wv * 16 + lq * 4 + r, ss = st * 16 + lr;
          float m = (ss <= ll) ? G[st][r] * __expf(al[r] - as) : 0.f;
          Mw[(lq * 4 + r) * 72 + st * 16 + lr] = f2bf(m);
        }
      }
      for (int ks = 0; ks <= (wv >> 1); ++ks) {
        bf16x8 ma = *(const bf16x8*)(Mw + lr * 72 + ks * 32 + lq * 8);
#pragma unroll
        for (int pt = 0; pt < 4; ++pt)
          Y[hh][pt] = mfma16(ma, *(const bf16x8*)(XT + (hh * 64 + pt * 16 + lr) * 72 + ks * 32 + lq * 8), Y[hh][pt]);
      }
    }
    float ssq[4] = {0.f, 0.f, 0.f, 0.f};
#pragma unroll
    for (int hh = 0; hh < 2; ++hh) {
      const int h = g * 2 + hh;
      const float dsk = p.ssm_d[l * 4 + h];
#pragma unroll
      for (int pt = 0; pt < 4; ++pt)
#pragma unroll
        for (int r = 0; r < 4; ++r) {
          int ll = wv * 16 + lq * 4 + r, pch = pt * 16 + lr;
          float xs = bf2f(XT[(hh * 64 + pch) * 72 + ll]) / s_dt[hh * 64 + ll];
          float z = bf2f(COLS[(size_t)(tb + ll) * NIN + C_Z + h * 64 + pch]);
          float y = (Y[hh][pt][r] + dsk * xs) * siluf_(z);
          Y[hh][pt][r] = y; ssq[r] += y * y;
        }
    }
    bfu* MIX = (bfu*)(p.ws + O_ACT);
#pragma unroll
    for (int r = 0; r < 4; ++r) {
      float sc = rsqrtf(row16_sum(ssq[r]) * (1.f / 128.f) + 1e-6f);
      int ll = wv * 16 + lq * 4 + r;
#pragma unroll
      for (int hh = 0; hh < 2; ++hh)
#pragma unroll
        for (int pt = 0; pt < 4; ++pt) {
          int ch = (g * 2 + hh) * 64 + pt * 16 + lr;
          MIX[(size_t)(tb + ll) * 1024 + ch] = f2bf(Y[hh][pt][r] * sc * p.ssm_norm[l * 256 + ch]);
        }
    }
  }
}
DEV void ssd_rec_item(const Params& p, int item) {
  const int bh = item >> 4, e = (item & 15) * 256 + tid_();
  float* ST = (float*)(p.ws + O_SST) + (size_t)bh * NCH * 4096 + e;
  const float* AT = (const float*)(p.ws + O_SAT) + bh * NCH;
  float H = 0.f;
  for (int c0 = 0; c0 < NCH; c0 += 8) {
    float s[8];
#pragma unroll
    for (int i = 0; i < 8; ++i) s[i] = ST[(size_t)(c0 + i) * 4096];
#pragma unroll
    for (int i = 0; i < 8; ++i) { ST[(size_t)(c0 + i) * 4096] = H; H = __expf(AT[c0 + i]) * H + s[i]; }
  }
}

template <int MODE>
DEV void lru_item(const Params& p, int l, int item) {
  const int hb = item & 3, c = (item >> 2) & 127, b = item >> 9;
  const int tid = tid_(), lane = tid & 63, wv = tid >> 6, lr = lane & 15, lq = lane >> 4;
  const bfu* COLS = (const bfu*)(p.ws + O_COLS);
  const int tb = b * S + c * 64;
  bfu* Xl = (bfu*)smem;
  float* Af = (float*)(smem + 9216);
  float* Uf = Af + 4096;
  __syncthreads();
  {
    const int cg8 = tid & 7, tg = tid >> 3;
    const int ch = hb * 64 + cg8 * 8;
    float w[4][8], bias[8];
#pragma unroll
    for (int i = 0; i < 8; ++i) {
      bias[i] = p.lru_conv_b[l * 256 + ch + i];
#pragma unroll
      for (int k = 0; k < 4; ++k) w[k][i] = p.lru_conv_w[(l * 4 + k) * 256 + ch + i];
    }
    float win[3][8];
#pragma unroll
    for (int rr = 0; rr < 5; ++rr) {
      int tl = tg * 2 - 3 + rr; int tpos = c * 64 + tl;
      float cur[8];
      if (tpos >= 0) {
        uint4 u = *(const uint4*)(COLS + (size_t)(b * S + tpos) * NIN + C_LX + ch);
        cur[0] = lo2f(u.x); cur[1] = hi2f(u.x); cur[2] = lo2f(u.y); cur[3] = hi2f(u.y); cur[4] = lo2f(u.z); cur[5] = hi2f(u.z); cur[6] = lo2f(u.w); cur[7] = hi2f(u.w);
      } else {
#pragma unroll
        for (int i = 0; i < 8; ++i) cur[i] = 0.f;
      }
      if (rr >= 3) {
        float o[8];
#pragma unroll
        for (int i = 0; i < 8; ++i) o[i] = bias[i] + w[0][i] * win[0][i] + w[1][i] * win[1][i] + w[2][i] * win[2][i] + w[3][i] * cur[i];
        *(uint4*)(Xl + tl * 72 + cg8 * 8) = make_uint4(pack2(o[0], o[1]), pack2(o[2], o[3]), pack2(o[4], o[5]), pack2(o[6], o[7]));
        *(float4*)(Uf + tl * 64 + cg8 * 8) = make_float4(o[0], o[1], o[2], o[3]);
        *(float4*)(Uf + tl * 64 + cg8 * 8 + 4) = make_float4(o[4], o[5], o[6], o[7]);
      }
#pragma unroll
      for (int i = 0; i < 8; ++i) { win[0][i] = win[1][i]; win[1][i] = win[2][i]; win[2][i] = cur[i]; }
    }
  }
  __syncthreads();
  {
    const bfu* waT = (const bfu*)(p.ws + O_W + (size_t)l * W_SZ + W_LA) + hb * 4096;
    const bfu* wiT = (const bfu*)(p.ws + O_W + (size_t)l * W_SZ + W_LI) + hb * 4096;
    bf16x8 xa[2];
#pragma unroll
    for (int ks = 0; ks < 2; ++ks) xa[ks] = *(const bf16x8*)(Xl + (wv * 16 + lr) * 72 + ks * 32 + lq * 8);
#pragma unroll
    for (int jt = 0; jt < 4; ++jt) {
      f32x4 R = {0.f, 0.f, 0.f, 0.f}, I = {0.f, 0.f, 0.f, 0.f};
#pragma unroll
      for (int ks = 0; ks < 2; ++ks) {
        R = mfma16(xa[ks], ld8(waT + (jt * 16 + lr) * 64 + ks * 32 + lq * 8), R);
        I = mfma16(xa[ks], ld8(wiT + (jt * 16 + lr) * 64 + ks * 32 + lq * 8), I);
      }
      const int j = jt * 16 + lr, ch = hb * 64 + j;
      const float ba = p.lru_ba[l * 256 + ch], bi = p.lru_bi[l * 256 + ch];
      const float lsl = -softplusf_(-p.lru_lambda[l * 256 + ch]);
#pragma unroll
      for (int r = 0; r < 4; ++r) {
        int ll = wv * 16 + lq * 4 + r;
        float rg = sigmoidf_(R[r] + ba), ig = sigmoidf_(I[r] + bi);
        float la = 8.f * rg * lsl;
        float a = __expf(la);
        float xb = Uf[ll * 64 + j];
        float u = sqrtf(-expm1f(2.f * la)) * ig * xb;
        Af[ll * 64 + j] = a; Uf[ll * 64 + j] = u;
      }
    }
  }
  __syncthreads();
  const size_t sidx = (size_t)(b * NCH + c) * 256 + hb * 64;
  if (wv == 0) {
    if (MODE == 0) {
      float A = 1.f, h = 0.f;
      for (int t = 0; t < 64; ++t) { float a = Af[t * 64 + lane]; h = a * h + Uf[t * 64 + lane]; A *= a; }
      ((float*)(p.ws + O_LA))[sidx + lane] = A; ((float*)(p.ws + O_LH))[sidx + lane] = h;
    } else {
      float h = ((const float*)(p.ws + O_LH))[sidx + lane];
      for (int t = 0; t < 64; ++t) { h = Af[t * 64 + lane] * h + Uf[t * 64 + lane]; Uf[t * 64 + lane] = h; }
    }
  }
  if (MODE == 1) {
    __syncthreads();
    const int ll = tid >> 2, jq = (tid & 3) * 16;
    bfu* MIX = (bfu*)(p.ws + O_ACT) + (size_t)(tb + ll) * 1024 + 256 + hb * 64 + jq;
    const bfu* gp = COLS + (size_t)(tb + ll) * NIN + C_LG + hb * 64 + jq;
    unsigned ov[8];
#pragma unroll
    for (int i = 0; i < 8; ++i) {
      unsigned gu = *(const unsigned*)(gp + i * 2);
      float y0 = Uf[ll * 64 + jq + i * 2] * geluf_(lo2f(gu)), y1 = Uf[ll * 64 + jq + i * 2 + 1] * geluf_(hi2f(gu));
      ov[i] = pack2(y0, y1);
    }
    *(uint4*)MIX = make_uint4(ov[0], ov[1], ov[2], ov[3]);
    *(uint4*)(MIX + 8) = make_uint4(ov[4], ov[5], ov[6], ov[7]);
  }
}
DEV void lru_carry_item(const Params& p, int item) {
  const int i = item * 256 + tid_();
  const int b = i >> 8, ch = i & 255;
  const float* LA = (const float*)(p.ws + O_LA) + (size_t)b * NCH * 256 + ch;
  float* LH = (float*)(p.ws + O_LH) + (size_t)b * NCH * 256 + ch;
  float H = 0.f;
  for (int c = 0; c < NCH; ++c) { float A = LA[c * 256], he = LH[c * 256]; LH[c * 256] = H; H = A * H + he; }
}
DEV void shifted8(const bfu* COLS, const float* mu, int t, int col, float* out) {
  uint4 u = *(const uint4*)(COLS + (size_t)t * NIN + C_RWKV + col);
  float c[8] = {lo2f(u.x), hi2f(u.x), lo2f(u.y), hi2f(u.y), lo2f(u.z), hi2f(u.z), lo2f(u.w), hi2f(u.w)};
  float pv[8] = {0.f, 0.f, 0.f, 0.f, 0.f, 0.f, 0.f, 0.f};
  if ((t & (S - 1)) != 0) {
    uint4 q = *(const uint4*)(COLS + (size_t)(t - 1) * NIN + C_RWKV + col);
    pv[0] = lo2f(q.x); pv[1] = hi2f(q.x); pv[2] = lo2f(q.y); pv[3] = hi2f(q.y); pv[4] = lo2f(q.z); pv[5] = hi2f(q.z); pv[6] = lo2f(q.w); pv[7] = hi2f(q.w);
  }
#pragma unroll
  for (int i = 0; i < 8; ++i) out[i] = c[i] + (pv[i] - c[i]) * mu[col + i];
}
DEV float shifted1(const bfu* COLS, const float* mu, int t, int col) {
  float c = bf2f(COLS[(size_t)t * NIN + C_RWKV + col]);
  float pv = ((t & (S - 1)) != 0) ? bf2f(COLS[(size_t)(t - 1) * NIN + C_RWKV + col]) : 0.f;
  return c + (pv - c) * mu[col];
}
DEV bf16x8 packf8(const float* v) {
  bf16x8 o;
#pragma unroll
  for (int i = 0; i < 8; ++i) o[i] = (short)f2bf(v[i]);
  return o;
}
DEV void rwkv_prep_item(const Params& p, int l, int item) {
  const int lane = tid_() & 63, wv = tid_() >> 6, lr = lane & 15, lq = lane >> 4;
  const bfu* COLS = (const bfu*)(p.ws + O_COLS);
  const float* mu = p.rwkv_mu + l * 1024;
  const int t0 = item * 64 + wv * 16;
  const unsigned char* wb = p.ws + O_W + (size_t)l * W_SZ;
  const bfu* w2T = (const bfu*)(wb + W_R2); const bfu* a2T = (const bfu*)(wb + W_A2); const bfu* g2T = (const bfu*)(wb + W_G2);
  bf16x8 wdA[2], adA[2], gdA[4];
  {
    float tmp[8];
#pragma unroll
    for (int ks = 0; ks < 2; ++ks) {
      shifted8(COLS, mu, t0 + lr, 768 + ks * 32 + lq * 8, tmp);
#pragma unroll
      for (int i = 0; i < 8; ++i) tmp[i] = tanhf(tmp[i]);
      wdA[ks] = packf8(tmp);
      shifted8(COLS, mu, t0 + lr, 832 + ks * 32 + lq * 8, tmp);
      adA[ks] = packf8(tmp);
    }
#pragma unroll
    for (int ks = 0; ks < 4; ++ks) {
      shifted8(COLS, mu, t0 + lr, 896 + ks * 32 + lq * 8, tmp);
#pragma unroll
      for (int i = 0; i < 8; ++i) tmp[i] = sigmoidf_(tmp[i]);
      gdA[ks] = packf8(tmp);
    }
  }
  const int b = t0 / S;
  bfu* RG = (bfu*)(p.ws + O_RG);
  for (int hd = 0; hd < 4; ++hd) {
    float kkv[4][4], av[4][4], k2v[4][4], rv[4][4], vv[4][4], wv_[4][4];
    float ss[4] = {0.f, 0.f, 0.f, 0.f};
#pragma unroll
    for (int q = 0; q < 4; ++q) {
      const int nt = hd * 4 + q, n = nt * 16 + lr;
      f32x4 W = {0.f, 0.f, 0.f, 0.f}, A = {0.f, 0.f, 0.f, 0.f}, G = {0.f, 0.f, 0.f, 0.f};
#pragma unroll
      for (int ks = 0; ks < 2; ++ks) {
        W = mfma16(wdA[ks], ld8(w2T + n * 64 + ks * 32 + lq * 8), W);
        A = mfma16(adA[ks], ld8(a2T + n * 64 + ks * 32 + lq * 8), A);
      }
#pragma unroll
      for (int ks = 0; ks < 4; ++ks) G = mfma16(gdA[ks], ld8(g2T + n * 128 + ks * 32 + lq * 8), G);
      const float w0 = p.rwkv_w0[l * 256 + n], a0 = p.rwkv_a0[l * 256 + n], kkw = p.rwkv_kk[l * 256 + n], kaw = p.rwkv_ka[l * 256 + n];
#pragma unroll
      for (int r = 0; r < 4; ++r) {
        const int t = t0 + lq * 4 + r;
        float wl = -softplusf_(-(w0 + W[r])) - 0.5f;
        wv_[q][r] = __expf(-__expf(wl));
        float a = sigmoidf_(a0 + A[r]);
        float r_ = shifted1(COLS, mu, t, n), k_ = shifted1(COLS, mu, t, 256 + n), v_ = shifted1(COLS, mu, t, 512 + n);
        float kk = k_ * kkw;
        kkv[q][r] = kk; ss[r] += kk * kk; av[q][r] = a;
        k2v[q][r] = k_ * (1.f + (a - 1.f) * kaw);
        rv[q][r] = r_; vv[q][r] = v_;
        RG[(size_t)t * 256 + n] = f2bf(G[r]);
      }
    }
#pragma unroll
    for (int r = 0; r < 4; ++r) {
      float nrm = fmaxf(sqrtf(row16_sum(ss[r])), 1e-12f);
      float inv = 1.f / nrm;
      const int t = t0 + lq * 4 + r;
      unsigned char* dst = p.ws + O_RIN + ((size_t)(b * 4 + hd) * S + (t & (S - 1))) * 896;
#pragma unroll
      for (int q = 0; q < 4; ++q) {
        const int j = q * 16 + lr;
        float kkn = kkv[q][r] * inv;
        ((float*)dst)[j] = wv_[q][r];
        ((bfu*)(dst + 256))[j] = f2bf(-kkn);
        ((bfu*)(dst + 384))[j] = f2bf(kkn * av[q][r]);
        ((bfu*)(dst + 512))[j] = f2bf(k2v[q][r]);
        ((bfu*)(dst + 640))[j] = f2bf(rv[q][r]);
        ((bfu*)(dst + 768))[j] = f2bf(vv[q][r]);
      }
    }
  }
}
typedef float f32x2s __attribute__((ext_vector_type(2)));
DEV void rwkv_stage_write(float* dstbuf, uint4 v, int off, bool isw) {
  if (isw) { *(uint4*)(dstbuf + off) = v; }
  else {
    *(float4*)(dstbuf + off) = make_float4(lo2f(v.x), hi2f(v.x), lo2f(v.y), hi2f(v.y));
    *(float4*)(dstbuf + off + 4) = make_float4(lo2f(v.z), hi2f(v.z), lo2f(v.w), hi2f(v.w));
  }
}
DEV void rwkv_scan_item(const Params& p, int item) {
  const int bh = item >> 2, qd = item & 3;
  const int tid = tid_(), lane = tid & 63, wv = tid >> 6, lr = lane & 15, lq = lane >> 4;
  const unsigned char* src = p.ws + O_RIN + (size_t)bh * S * 896;
  float* Y = (float*)(p.ws + O_RY) + (size_t)(bh >> 2) * S * 256 + (bh & 3) * 64;
  const int irow = qd * 16 + wv * 4 + lq;
  float* buf = (float*)smem;
  constexpr int CH = 16, CB = CH * 896, CF = CH * 384;
  int soff[4]; bool sw[4];
#pragma unroll
  for (int i = 0; i < 4; ++i) {
    int idx = tid + i * 256; int st = idx / 56, wi = idx - st * 56;
    sw[i] = wi < 16;
    soff[i] = st * 384 + (sw[i] ? wi * 4 : 64 + ((wi - 16) >> 3) * 64 + ((wi - 16) & 7) * 8);
  }
  const bool t3 = tid < 896 - 768;
  __syncthreads();
  uint4 st0, st1, st2, st3 = make_uint4(0, 0, 0, 0);
  st0 = ((const uint4*)src)[tid]; st1 = ((const uint4*)src)[tid + 256]; st2 = ((const uint4*)src)[tid + 512]; if (t3) st3 = ((const uint4*)src)[tid + 768];
  rwkv_stage_write(buf, st0, soff[0], sw[0]); rwkv_stage_write(buf, st1, soff[1], sw[1]); rwkv_stage_write(buf, st2, soff[2], sw[2]);
  if (t3) rwkv_stage_write(buf, st3, soff[3], sw[3]);
  __syncthreads();
  f32x2s s01 = {0.f, 0.f}, s23 = {0.f, 0.f};
  for (int ch = 0; ch < S / CH; ++ch) {
    if (ch + 1 < S / CH) {
      const uint4* nsrc = (const uint4*)(src + (size_t)(ch + 1) * CB);
      st0 = nsrc[tid]; st1 = nsrc[tid + 256]; st2 = nsrc[tid + 512]; if (t3) st3 = nsrc[tid + 768];
    }
    const float* cb = buf + (ch & 1) * CF;
    float ykeep = 0.f;
    float4 W = *(const float4*)(cb + lr * 4), NK = *(const float4*)(cb + 64 + lr * 4), KA = *(const float4*)(cb + 128 + lr * 4);
    float4 KK = *(const float4*)(cb + 192 + lr * 4), RR = *(const float4*)(cb + 256 + lr * 4);
    float v = cb[320 + irow];
#pragma unroll
    for (int s = 0; s < CH; ++s) {
      float4 W2, NK2, KA2, KK2, RR2; float v2;
      if (s + 1 < CH) {
        const float* nb2 = cb + (s + 1) * 384;
        W2 = *(const float4*)(nb2 + lr * 4); NK2 = *(const float4*)(nb2 + 64 + lr * 4); KA2 = *(const float4*)(nb2 + 128 + lr * 4);
        KK2 = *(const float4*)(nb2 + 192 + lr * 4); RR2 = *(const float4*)(nb2 + 256 + lr * 4); v2 = nb2[320 + irow];
      }
      f32x2s t = s01 * (f32x2s){NK.x, NK.y}; t = s23 * (f32x2s){NK.z, NK.w} + t;
      f32x2s vv = {v, v};
      f32x2s u01 = s01 * (f32x2s){W.x, W.y}; u01 = vv * (f32x2s){KK.x, KK.y} + u01;
      f32x2s u23 = s23 * (f32x2s){W.z, W.w}; u23 = vv * (f32x2s){KK.z, KK.w} + u23;
      const float sa = row16_sum(t.x + t.y);
      f32x2s sav = {sa, sa};
      s01 = sav * (f32x2s){KA.x, KA.y} + u01;
      s23 = sav * (f32x2s){KA.z, KA.w} + u23;
      f32x2s yy = s01 * (f32x2s){RR.x, RR.y}; yy = s23 * (f32x2s){RR.z, RR.w} + yy;
      const float y = row16_sum(yy.x + yy.y);
      ykeep = (lr == s) ? y : ykeep;
      if (s + 1 < CH) { W = W2; NK = NK2; KA = KA2; KK = KK2; RR = RR2; v = v2; }
      if (s == 9 && ch + 1 < S / CH) {
        float* nb = buf + ((ch + 1) & 1) * CF;
        rwkv_stage_write(nb, st0, soff[0], sw[0]); rwkv_stage_write(nb, st1, soff[1], sw[1]); rwkv_stage_write(nb, st2, soff[2], sw[2]);
        if (t3) rwkv_stage_write(nb, st3, soff[3], sw[3]);
      }
    }
    Y[(size_t)(ch * CH + lr) * 256 + irow] = ykeep;
    __syncthreads();
  }
}
DEV void rwkv_post_item(const Params& p, int l, int item) {
  const int lane = tid_() & 63, wv = tid_() >> 6;
  const float* RY = (const float*)(p.ws + O_RY);
  const bfu* RG = (const bfu*)(p.ws + O_RG);
  bfu* MIX = (bfu*)(p.ws + O_ACT);
  for (int k = 0; k < 64; ++k) {
    const int t = item * 64 + wv * 16 + (k >> 2), h = k & 3;
    const int b = t / S, tp = t & (S - 1);
    float y = RY[(size_t)t * 256 + h * 64 + lane];
    float mean = wave_sum(y) * (1.f / 64.f);
    float d = y - mean;
    float var = wave_sum(d * d) * (1.f / 64.f);
    const int ch = h * 64 + lane;
    float yn = d * rsqrtf(var + 64e-5f) * p.rwkv_ln_w[l * 256 + ch] + p.rwkv_ln_b[l * 256 + ch];
    const unsigned char* src = p.ws + O_RIN + ((size_t)(b * 4 + h) * S + tp) * 896;
    float k2 = bf2f(((const bfu*)(src + 512))[lane]), r_ = bf2f(((const bfu*)(src + 640))[lane]), v_ = bf2f(((const bfu*)(src + 768))[lane]);
    float bonus = wave_sum(r_ * k2 * p.rwkv_rk[l * 256 + ch]);
    float o = (yn + bonus * v_) * bf2f(RG[(size_t)t * 256 + ch]);
    MIX[(size_t)t * 1024 + 512 + ch] = f2bf(o);
  }
}
DEV void nsa_tr_item(const Params& p, int item) {
  const int which = item & 1, tt = (item >> 1) & 127, b = item >> 8;
  const int tid = tid_();
  const bfu* COLS = (const bfu*)(p.ws + O_COLS);
  bfu* dst = (bfu*)(p.ws + (which ? O_VWT : O_VST)) + (size_t)b * 64 * S;
  const int col0 = which ? C_VW : C_VS;
  bfu* tl = (bfu*)smem;
  __syncthreads();
  for (int i = tid; i < 64 * 32; i += NTHR) {
    int tok = i >> 5, dp = i & 31;
    unsigned u = *(const unsigned*)(COLS + (size_t)(b * S + tt * 64 + tok) * NIN + col0 + dp * 2);
    *(unsigned*)(tl + tok * 66 + dp * 2) = u;
  }
  __syncthreads();
  {
    const int d = tid >> 2, tq = (tid & 3) * 16;
    unsigned o[8];
#pragma unroll
    for (int i = 0; i < 8; ++i) o[i] = (unsigned)tl[(tq + i * 2) * 66 + d] | ((unsigned)tl[(tq + i * 2 + 1) * 66 + d] << 16);
    uint4* dp = (uint4*)(dst + (size_t)d * S + tt * 64 + tq);
    dp[0] = make_uint4(o[0], o[1], o[2], o[3]); dp[1] = make_uint4(o[4], o[5], o[6], o[7]);
  }
}
DEV void nsa_cmp_item(const Params& p, int l, int item) {
  const int mt = item & 31, b = (item >> 5) & 3, which = item >> 7;
  const int tid = tid_(), lane = tid & 63, wv = tid >> 6, lr = lane & 15, lq = lane >> 4;
  const bfu* COLS = (const bfu*)(p.ws + O_COLS);
  const unsigned char* wb = p.ws + O_W + (size_t)l * W_SZ;
  const bfu* w1T = (const bfu*)(wb + W_C1) + (size_t)which * 256 * 2048;
  const bfu* w2T = (const bfu*)(wb + W_C2) + (size_t)which * 64 * 256;
  const float* pos = p.nsa_cmp_pos + ((size_t)l * 2 + which) * 2048;
  const int col0 = which ? C_VC : C_KC;
  bfu* Hs = (bfu*)smem;
  int blk = mt * 16 + lr; if (blk > 510) blk = 510;
  const bfu* arow = COLS + (size_t)(b * S + blk * 16) * NIN + col0 + lq * 8;
  f32x4 acc[4];
#pragma unroll
  for (int j = 0; j < 4; ++j) acc[j] = (f32x4){0.f, 0.f, 0.f, 0.f};
  for (int ks = 0; ks < 64; ++ks) {
    uint4 u = *(const uint4*)(arow + (size_t)(ks >> 1) * NIN + (ks & 1) * 32);
    const float4* pp = (const float4*)(pos + ks * 32 + lq * 8);
    float4 p0 = pp[0], p1 = pp[1];
    float av[8] = {lo2f(u.x) + p0.x, hi2f(u.x) + p0.y, lo2f(u.y) + p0.z, hi2f(u.y) + p0.w, lo2f(u.z) + p1.x, hi2f(u.z) + p1.y, lo2f(u.w) + p1.z, hi2f(u.w) + p1.w};
    bf16x8 a = packf8(av);
#pragma unroll
    for (int j = 0; j < 4; ++j) acc[j] = mfma16(a, ld8(w1T + (size_t)(wv * 64 + j * 16 + lr) * 2048 + ks * 32 + lq * 8), acc[j]);
  }
  __syncthreads();
#pragma unroll
  for (int j = 0; j < 4; ++j)
#pragma unroll
    for (int r = 0; r < 4; ++r) Hs[(lq * 4 + r) * 264 + wv * 64 + j * 16 + lr] = f2bf(geluf_(acc[j][r]));
  __syncthreads();
  f32x4 o = {0.f, 0.f, 0.f, 0.f};
#pragma unroll
  for (int ks = 0; ks < 8; ++ks) o = mfma16(*(const bf16x8*)(Hs + lr * 264 + ks * 32 + lq * 8), ld8(w2T + (wv * 16 + lr) * 256 + ks * 32 + lq * 8), o);
#pragma unroll
  for (int r = 0; r < 4; ++r) {
    int bi = mt * 16 + lq * 4 + r, d = wv * 16 + lr;
    float v = (bi < 511) ? o[r] : 0.f;
    if (which == 0) ((bfu*)(p.ws + O_KCMP))[((size_t)b * 512 + bi) * 64 + d] = f2bf(v);
    else ((bfu*)(p.ws + O_VCT))[((size_t)b * 64 + d) * 512 + bi] = f2bf(v);
  }
}

struct AttnState { float m[4], l[4]; f32x4 O[4]; };
DEV void attn_init(AttnState& st) {
#pragma unroll
  for (int r = 0; r < 4; ++r) { st.m[r] = -1e30f; st.l[r] = 0.f; st.O[r] = (f32x4){0.f, 0.f, 0.f, 0.f}; }
}
struct KVF { bf16x8 k00, k01, k10, k11, v0, v1, v2, v3; };
DEV void attn_load(KVF& f, const bfu* kp0, const bfu* kp1, const bfu* vt, size_t vs16) {
  f.k00 = ld8(kp0); f.k01 = ld8(kp0 + 32); f.k10 = ld8(kp1); f.k11 = ld8(kp1 + 32);
  f.v0 = ld8(vt); f.v1 = ld8(vt + vs16); f.v2 = ld8(vt + 2 * vs16); f.v3 = ld8(vt + 3 * vs16);
}
constexpr float MREF = 12.f;
DEV void attn_compute(AttnState& st, const bf16x8* q, const KVF& f, float dist0, bool val0, float dist1, bool val1, bfu* pbuf, int lr, int lq) {
  f32x4 s0 = {0.f, 0.f, 0.f, 0.f}, s1 = {0.f, 0.f, 0.f, 0.f};
  s0 = mfma16(q[0], f.k00, s0); s0 = mfma16(q[1], f.k01, s0);
  s1 = mfma16(q[0], f.k10, s1); s1 = mfma16(q[1], f.k11, s1);
#pragma unroll
  for (int r = 0; r < 4; ++r) {
    const float slope = (r == 0) ? 0.25f : (r == 1) ? 0.0625f : (r == 2) ? 0.015625f : 0.00390625f;
    const float p0 = val0 ? __expf(s0[r] * 0.125f - slope * dist0 - MREF) : 0.f;
    const float p1 = val1 ? __expf(s1[r] * 0.125f - slope * dist1 - MREF) : 0.f;
    st.l[r] += p0 + p1;
    pbuf[(lq * 4 + r) * 40 + lr] = f2bf(p0); pbuf[(lq * 4 + r) * 40 + 16 + lr] = f2bf(p1);
  }
  bf16x8 pa = *(const bf16x8*)(pbuf + lr * 40 + lq * 8);
  st.O[0] = mfma16(pa, f.v0, st.O[0]); st.O[1] = mfma16(pa, f.v1, st.O[1]);
  st.O[2] = mfma16(pa, f.v2, st.O[2]); st.O[3] = mfma16(pa, f.v3, st.O[3]);
}
DEV float wave_maxf_u(float v) {
  v = row16_max(v);
  v = fmaxf(v, __int_as_float(__builtin_amdgcn_update_dpp(__float_as_int(-__builtin_inff()), __float_as_int(v), 0x142, 0xA, 0xF, false)));
  v = fmaxf(v, __int_as_float(__builtin_amdgcn_update_dpp(__float_as_int(-__builtin_inff()), __float_as_int(v), 0x143, 0xC, 0xF, false)));
  return __int_as_float(__builtin_amdgcn_readlane(__float_as_int(v), 63));
}
template <int CTRL> DEV int dppi(int v) { return __builtin_amdgcn_update_dpp(0, v, CTRL, 0xf, 0xf, true); }
DEV int wave_mini_u(int v) {
  v = min(v, dppi<0xB1>(v)); v = min(v, dppi<0x4E>(v)); v = min(v, dppi<0x141>(v)); v = min(v, dppi<0x140>(v));
  v = min(v, __builtin_amdgcn_update_dpp(0x7fffffff, v, 0x142, 0xA, 0xF, false));
  v = min(v, __builtin_amdgcn_update_dpp(0x7fffffff, v, 0x143, 0xC, 0xF, false));
  return __builtin_amdgcn_readlane(v, 63);
}

DEV void nsa_cmpattn_item(const Params& p, int item) {
  const int lane = tid_() & 63, wv = tid_() >> 6, lr = lane & 15, lq = lane >> 4;
  const bfu* COLS = (const bfu*)(p.ws + O_COLS);
  const int t0 = item * 16 + wv * 4;
  const int b = t0 / S, tp0 = t0 & (S - 1);
  const bfu* KC = (const bfu*)(p.ws + O_KCMP) + (size_t)b * 512 * 64;
  const bfu* VCT = (const bfu*)(p.ws + O_VCT) + (size_t)b * 64 * 512;
  bfu* pbuf = (bfu*)smem + wv * 640;
  float* ps = (float*)(smem + 5120) + wv * (4 * 516);
  bf16x8 q[2];
#pragma unroll
  for (int ks = 0; ks < 2; ++ks) q[ks] = ld8(COLS + (size_t)(t0 + (lr >> 2)) * NIN + C_Q + (lr & 3) * 64 + ks * 32 + lq * 8);
  const int pos = tp0 + lq;
  const int pmax = tp0 + 3;
  const int nvalid = (pmax >= 31) ? ((pmax - 31) >> 4) + 1 : 0;
  const int nkt = (nvalid + 31) >> 5;
  float z[4] = {0.f, 0.f, 0.f, 0.f};
  for (int kt = 0; kt < nkt; ++kt) {
    const int n0 = kt * 32 + lr, n1 = n0 + 16;
    f32x4 s0 = {0.f, 0.f, 0.f, 0.f}, s1 = {0.f, 0.f, 0.f, 0.f};
    s0 = mfma16(q[0], ld8(KC + n0 * 64 + lq * 8), s0); s0 = mfma16(q[1], ld8(KC + n0 * 64 + 32 + lq * 8), s0);
    s1 = mfma16(q[0], ld8(KC + n1 * 64 + lq * 8), s1); s1 = mfma16(q[1], ld8(KC + n1 * 64 + 32 + lq * 8), s1);
    const int d0 = pos - (16 * n0 + 31), d1 = pos - (16 * n1 + 31);
#pragma unroll
    for (int r = 0; r < 4; ++r) {
      const float slope = (r == 0) ? 0.25f : (r == 1) ? 0.0625f : (r == 2) ? 0.015625f : 0.00390625f;
      const float p0 = (d0 >= 0) ? __expf(s0[r] * 0.125f - slope * (float)d0 - MREF) : 0.f;
      const float p1 = (d1 >= 0) ? __expf(s1[r] * 0.125f - slope * (float)d1 - MREF) : 0.f;
      z[r] += p0 + p1;
    }
  }
  float iz[4];
#pragma unroll
  for (int r = 0; r < 4; ++r) iz[r] = 1.f / fmaxf(row16_sum(z[r]), 1e-30f);
  f32x4 O[4];
#pragma unroll
  for (int dt = 0; dt < 4; ++dt) O[dt] = (f32x4){0.f, 0.f, 0.f, 0.f};
  for (int kt = 0; kt < nkt; ++kt) {
    const int n0 = kt * 32 + lr, n1 = n0 + 16;
    f32x4 s0 = {0.f, 0.f, 0.f, 0.f}, s1 = {0.f, 0.f, 0.f, 0.f};
    s0 = mfma16(q[0], ld8(KC + n0 * 64 + lq * 8), s0); s0 = mfma16(q[1], ld8(KC + n0 * 64 + 32 + lq * 8), s0);
    s1 = mfma16(q[0], ld8(KC + n1 * 64 + lq * 8), s1); s1 = mfma16(q[1], ld8(KC + n1 * 64 + 32 + lq * 8), s1);
    const int d0 = pos - (16 * n0 + 31), d1 = pos - (16 * n1 + 31);
    float ps0 = 0.f, ps1 = 0.f;
#pragma unroll
    for (int r = 0; r < 4; ++r) {
      const float slope = (r == 0) ? 0.25f : (r == 1) ? 0.0625f : (r == 2) ? 0.015625f : 0.00390625f;
      float p0 = (d0 >= 0) ? __expf(s0[r] * 0.125f - slope * (float)d0 - MREF) * iz[r] : 0.f;
      float p1 = (d1 >= 0) ? __expf(s1[r] * 0.125f - slope * (float)d1 - MREF) * iz[r] : 0.f;
      ps0 += p0; ps1 += p1;
      pbuf[(lq * 4 + r) * 40 + lr] = f2bf(p0); pbuf[(lq * 4 + r) * 40 + 16 + lr] = f2bf(p1);
    }
    ps[lq * 516 + n0] = ps0; ps[lq * 516 + n1] = ps1;
    bf16x8 pa = *(const bf16x8*)(pbuf + lr * 40 + lq * 8);
#pragma unroll
    for (int dt = 0; dt < 4; ++dt) O[dt] = mfma16(pa, ld8(VCT + (size_t)(dt * 16 + lr) * 512 + kt * 32 + lq * 8), O[dt]);
  }
  bfu* OC = (bfu*)(p.ws + O_OCMP);
#pragma unroll
  for (int dt = 0; dt < 4; ++dt)
#pragma unroll
    for (int r = 0; r < 4; ++r) OC[(size_t)(t0 + lq) * 256 + r * 64 + dt * 16 + lr] = f2bf(O[dt][r]);
  const int nproc = nkt * 32;
  unsigned long long* SEL = (unsigned long long*)(p.ws + O_SEL);
  for (int tk = 0; tk < 4; ++tk) {
    const int tpos = tp0 + tk, cur = tpos >> 6;
    const float* pr = ps + tk * 516;
    float iv[2];
#pragma unroll
    for (int hh = 0; hh < 2; ++hh) {
      const int j = lane + hh * 64;
      float v = -__builtin_inff();
      if (j <= cur) {
        if (j == 0 || j == cur || j == cur - 1) v = 1e4f;
        else {
          float a = 0.f;
#pragma unroll
          for (int e = -1; e < 4; ++e) {
            int n = 4 * j + e;
            float w = (e == -1 || e == 3) ? 0.5f : 1.f;
            if (n >= 0 && n <= 510 && n < nproc) a += w * pr[n];
          }
          v = a;
        }
      }
      iv[hh] = v;
    }
    bool sel0 = false, sel1 = false;
    const int nsel = (cur + 1 < 16) ? cur + 1 : 16;
    for (int rd = 0; rd < nsel; ++rd) {
      float c0 = sel0 ? -__builtin_inff() : iv[0], c1 = sel1 ? -__builtin_inff() : iv[1];
      const float gm = wave_maxf_u(fmaxf(c0, c1));
      const int bi = wave_mini_u((c0 == gm) ? lane : ((c1 == gm) ? lane + 64 : 0x7fffffff));
      if (bi == lane) sel0 = true;
      if (bi == lane + 64) sel1 = true;
    }
    unsigned long long mlo = __ballot(sel0), mhi = __ballot(sel1);
    if (lane == 0) { SEL[(size_t)(t0 + tk) * 2] = mlo; SEL[(size_t)(t0 + tk) * 2 + 1] = mhi; }
  }
}

DEV void nsa_finish_item(const Params& p, int item) {
  const int lane = tid_() & 63, wv = tid_() >> 6, lr = lane & 15, lq = lane >> 4;
  const bfu* COLS = (const bfu*)(p.ws + O_COLS);
  const float* SIDE = (const float*)(p.ws + O_SIDE);
  const int t0 = item * 16 + wv * 4;
  const int b = t0 / S, tp0 = t0 & (S - 1);
  bfu* pbuf = (bfu*)smem + wv * 640;
  bf16x8 q[2];
#pragma unroll
  for (int ks = 0; ks < 2; ++ks) q[ks] = ld8(COLS + (size_t)(t0 + (lr >> 2)) * NIN + C_Q + (lr & 3) * 64 + ks * 32 + lq * 8);
  const int pos = tp0 + lq;
  const bfu* rowb = COLS + (size_t)b * S * NIN;
  AttnState sw; attn_init(sw);
  KVF cur, nxt;
  {
    const bfu* VT = (const bfu*)(p.ws + O_VWT) + (size_t)b * 64 * S;
    int kb = tp0 - 511; if (kb < 0) kb = 0; kb &= ~31;
    const int last = tp0 + 3;
    attn_load(cur, rowb + (size_t)(kb + lr) * NIN + C_KW + lq * 8, rowb + (size_t)(kb + 16 + lr) * NIN + C_KW + lq * 8, VT + (size_t)lr * S + kb + lq * 8, (size_t)16 * S);
    for (; kb <= last; kb += 32) {
      const bool more = kb + 32 <= last;
      const int kn = kb + 32;
      if (more) attn_load(nxt, rowb + (size_t)(kn + lr) * NIN + C_KW + lq * 8, rowb + (size_t)(kn + 16 + lr) * NIN + C_KW + lq * 8, VT + (size_t)lr * S + kn + lq * 8, (size_t)16 * S);
      const int d0 = pos - (kb + lr), d1 = d0 - 16;
      attn_compute(sw, q, cur, (float)d0, d0 >= 0 && d0 < 512, (float)d1, d1 >= 0 && d1 < 512, pbuf, lr, lq);
      if (more) cur = nxt;
    }
  }
  AttnState ss; attn_init(ss);
  {
    const bfu* VT = (const bfu*)(p.ws + O_VST) + (size_t)b * 64 * S;
    const unsigned long long* SEL = (const unsigned long long*)(p.ws + O_SEL);
    const unsigned long long mylo = SEL[(size_t)(t0 + lq) * 2], myhi = SEL[(size_t)(t0 + lq) * 2 + 1];
    unsigned long long ulo = 0, uhi = 0;
#pragma unroll
    for (int k = 0; k < 4; ++k) { ulo |= SEL[(size_t)(t0 + k) * 2]; uhi |= SEL[(size_t)(t0 + k) * 2 + 1]; }
    unsigned ul0 = __builtin_amdgcn_readfirstlane((unsigned)ulo), ul1 = __builtin_amdgcn_readfirstlane((unsigned)(ulo >> 32));
    unsigned uh0 = __builtin_amdgcn_readfirstlane((unsigned)uhi), uh1 = __builtin_amdgcn_readfirstlane((unsigned)(uhi >> 32));
    int j = -1, hb = 1;
    auto adv = [&]() -> bool {
      if (hb == 0) { hb = 1; return true; }
      hb = 0;
      if (ul0) { j = __builtin_ctz(ul0); ul0 &= ul0 - 1; return true; }
      if (ul1) { j = 32 + __builtin_ctz(ul1); ul1 &= ul1 - 1; return true; }
      if (uh0) { j = 64 + __builtin_ctz(uh0); uh0 &= uh0 - 1; return true; }
      if (uh1) { j = 96 + __builtin_ctz(uh1); uh1 &= uh1 - 1; return true; }
      return false;
    };
    bool ok = adv();
    if (ok) { const int kb = j * 64 + hb * 32; attn_load(cur, rowb + (size_t)(kb + lr) * NIN + C_KS + lq * 8, rowb + (size_t)(kb + 16 + lr) * NIN + C_KS + lq * 8, VT + (size_t)lr * S + kb + lq * 8, (size_t)16 * S); }
    while (ok) {
      const int cj = j, kb = j * 64 + hb * 32;
      const bool nk = adv();
      if (nk) { const int kn = j * 64 + hb * 32; attn_load(nxt, rowb + (size_t)(kn + lr) * NIN + C_KS + lq * 8, rowb + (size_t)(kn + 16 + lr) * NIN + C_KS + lq * 8, VT + (size_t)lr * S + kn + lq * 8, (size_t)16 * S); }
      const bool has = (((cj < 64) ? (mylo >> cj) : (myhi >> (cj - 64))) & 1ull) != 0;
      const int d0 = pos - (kb + lr), d1 = d0 - 16;
      attn_compute(ss, q, cur, (float)d0, has && d0 >= 0, (float)d1, has && d1 >= 0, pbuf, lr, lq);
      if (nk) cur = nxt;
      ok = nk;
    }
  }
  const bfu* OC = (const bfu*)(p.ws + O_OCMP);
  bfu* MIX = (bfu*)(p.ws + O_ACT);
  const int t = t0 + lq;
#pragma unroll
  for (int r = 0; r < 4; ++r) {
    const float g0 = sigmoidf_(SIDE[(size_t)t * 16 + 4 + r * 3]), g1 = sigmoidf_(SIDE[(size_t)t * 16 + 5 + r * 3]), g2 = sigmoidf_(SIDE[(size_t)t * 16 + 6 + r * 3]);
    const float is = g1 / fmaxf(row16_sum(ss.l[r]), 1e-30f), iw = g2 / fmaxf(row16_sum(sw.l[r]), 1e-30f);
#pragma unroll
    for (int dt = 0; dt < 4; ++dt) {
      const int ch = r * 64 + dt * 16 + lr;
      float o = g0 * bf2f(OC[(size_t)t * 256 + ch]) + is * ss.O[dt][r] + iw * sw.O[dt][r];
      MIX[(size_t)t * 1024 + 768 + ch] = f2bf(o);
    }
  }
}

DEV void phase_rwkv_prep(const Params& p, int l) {
  for (int it = bid_(); it < 512; it += gridDim.x) rwkv_prep_item(p, l, it);
}
DEV void sub_arrive(unsigned* bar) {
  asm volatile("s_waitcnt vmcnt(0)" ::: "memory");
  __syncthreads();
  if (tid_() == 0) { __threadfence(); atomicAdd(bar, 1u); }
}
DEV void sub_wait(unsigned* bar, unsigned target) {
  if (tid_() == 0) { while (__hip_atomic_load(bar, __ATOMIC_RELAXED, __HIP_MEMORY_SCOPE_AGENT) < target) __builtin_amdgcn_s_sleep(2); __threadfence(); }
  __syncthreads();
}
DEV void phase_mix_scan_finish(const Params& p, int l) {
  unsigned* barA = (unsigned*)(p.ws + O_SYNC) + l * 4;
  unsigned* barB = barA + 1;
  unsigned* que = barA + 2;
  const unsigned nothers = gridDim.x - 64;
  if (bid_() < 64) {
    __builtin_amdgcn_s_setprio(3);
    for (int rep = 0; rep < R_SCAN; ++rep) rwkv_scan_item(p, bid_());
    __builtin_amdgcn_s_setprio(0);
  } else {
    constexpr int P0 = 1024, P1 = P0 + 2048, P2 = P1 + 1024, P3 = P2 + 256;
    for (int it = bid_() - 64; it < P3; it += gridDim.x - 64) {
      if (it < P0) ssd_item<0>(p, l, it);
      else if (it < P1) lru_item<0>(p, l, it - P0);
      else if (it < P2) nsa_tr_item(p, it - P1);
      else nsa_cmp_item(p, l, it - P2);
    }
    sub_arrive(barA);
    sub_wait(barA, nothers);
    constexpr int N0 = 2048, N1 = N0 + 256, N2 = N1 + 4;
    for (int it = bid_() - 64; it < N2; it += gridDim.x - 64) {
      if (it < N0) { for (int rep = 0; rep < R_CMPA; ++rep) { __syncthreads(); nsa_cmpattn_item(p, it); } }
      else if (it < N1) ssd_rec_item(p, it - N0);
      else lru_carry_item(p, it - N1);
    }
    sub_arrive(barB);
  }
  sub_wait(barB, nothers);
  constexpr int M0 = 2048, M1 = M0 + 1024, M2 = M1 + 2048;
  for (;;) {
    __syncthreads();
    if (tid_() == 0) s_qitem = (int)atomicAdd(que, 1u);
    __syncthreads();
    const int it = s_qitem;
    if (it >= M2) break;
    for (int rep = 0; rep < R_FIN; ++rep) {
    if (it < M0) { __syncthreads(); nsa_finish_item(p, it); }
    else if (it < M1) ssd_item<1>(p, l, it - M0);
    else lru_item<1>(p, l, it - M1);
    }
  }
}
DEV void phase_rwkv_post(const Params& p, int l) {
  for (int it = bid_(); it < 512; it += gridDim.x) rwkv_post_item(p, l, it);
}

template <int CTRL> DEV int dppi_(int v) { return __builtin_amdgcn_update_dpp(0, v, CTRL, 0xf, 0xf, true); }
DEV int row16_mini(int v) { v = min(v, dppi_<0xB1>(v)); v = min(v, dppi_<0x4E>(v)); v = min(v, dppi_<0x141>(v)); v = min(v, dppi_<0x140>(v)); return v; }
DEV void phase_peer_topk(const Params& p, int l) {
  const bfu* Q = (const bfu*)(p.ws + O_PQ);
  const bfu* keys = (const bfu*)(p.ws + O_W + (size_t)l * W_SZ + W_KEYS);
  int* PE = (int*)(p.ws + O_PE); float* PG = (float*)(p.ws + O_PG);
  const int lane = tid_() & 63, wv = tid_() >> 6, lr = lane & 15, lq = lane >> 4;
  float* ps = (float*)smem + wv * 1024;
  int* pi = (int*)ps + 512;
  const float NINF = -__builtin_inff();
  int ca[4], cb[4]; bool cok[4];
#pragma unroll
  for (int sl = 0; sl < 4; ++sl) {
    int k = sl * 16 + lr, a = 0; bool ok = false;
    for (int aa = 0; aa < 16; ++aa) { int cnt = 16 / (aa + 1); if (!ok) { if (k < cnt) { ok = true; a = aa; } else k -= cnt; } }
    ca[sl] = a; cb[sl] = ok ? k : 0; cok[sl] = ok;
  }
  for (int item = bid_(); item < (T / 64) * 8; item += gridDim.x) {
    const int tt = item >> 3, hd = item & 7;
    const int t0 = tt * 64 + wv * 16;
    for (int c = 0; c < 2; ++c) {
      bf16x8 qa[4];
#pragma unroll
      for (int ks = 0; ks < 4; ++ks) qa[ks] = ld8(Q + (size_t)(t0 + lr) * 2048 + hd * 256 + c * 128 + ks * 32 + lq * 8);
      const bfu* kb = keys + (size_t)(hd * 2 + c) * 128 * 128;
      float v[4][8];
#pragma unroll
      for (int nt = 0; nt < 8; ++nt) {
        f32x4 a = {0.f, 0.f, 0.f, 0.f};
#pragma unroll
        for (int ks = 0; ks < 4; ++ks) a = mfma16(qa[ks], ld8(kb + (size_t)(nt * 16 + lr) * 128 + ks * 32 + lq * 8), a);
#pragma unroll
        for (int r = 0; r < 4; ++r) v[r][nt] = a[r];
      }
      float mys[4] = {0.f, 0.f, 0.f, 0.f}; int myi[4] = {0, 0, 0, 0};
      for (int rd = 0; rd < 16; ++rd) {
#pragma unroll
        for (int r = 0; r < 4; ++r) {
          float lm = fmaxf(fmaxf(fmaxf(v[r][0], v[r][1]), fmaxf(v[r][2], v[r][3])), fmaxf(fmaxf(v[r][4], v[r][5]), fmaxf(v[r][6], v[r][7])));
          const float gm = row16_max(lm);
          int cand = 0x7fffffff;
#pragma unroll
          for (int nt = 7; nt >= 0; --nt) cand = (v[r][nt] == gm) ? nt * 16 + lr : cand;
          const int bi = row16_mini(cand);
#pragma unroll
          for (int nt = 0; nt < 8; ++nt) v[r][nt] = (bi == nt * 16 + lr) ? NINF : v[r][nt];
          if (lr == rd) { mys[r] = gm; myi[r] = bi; }
        }
      }
#pragma unroll
      for (int r = 0; r < 4; ++r) { ps[c * 256 + (lq * 4 + r) * 16 + lr] = mys[r]; pi[c * 256 + (lq * 4 + r) * 16 + lr] = myi[r]; }
    }
    float cv[4][4];
#pragma unroll
    for (int r = 0; r < 4; ++r)
#pragma unroll
      for (int sl = 0; sl < 4; ++sl) {
        float sv = ps[(lq * 4 + r) * 16 + ca[sl]] + ps[256 + (lq * 4 + r) * 16 + cb[sl]];
        cv[r][sl] = cok[sl] ? sv : NINF;
      }
    float tops[4] = {0.f, 0.f, 0.f, 0.f}; int topf[4] = {0, 0, 0, 0};
    for (int rd = 0; rd < 16; ++rd) {
#pragma unroll
      for (int r = 0; r < 4; ++r) {
        const float gm = row16_max(fmaxf(fmaxf(cv[r][0], cv[r][1]), fmaxf(cv[r][2], cv[r][3])));
        int cand = 0x7fffffff;
#pragma unroll
        for (int sl = 0; sl < 4; ++sl) { int fl = ca[sl] * 16 + cb[sl]; cand = (cv[r][sl] == gm && fl < cand) ? fl : cand; }
        const int bi = row16_mini(cand);
#pragma unroll
        for (int sl = 0; sl < 4; ++sl) cv[r][sl] = (bi == ca[sl] * 16 + cb[sl]) ? NINF : cv[r][sl];
        if (lr == rd) { tops[r] = gm; topf[r] = bi; }
      }
    }
#pragma unroll
    for (int r = 0; r < 4; ++r) {
      const int row = lq * 4 + r;
      const float mx = row16_max(tops[r]);
      const float e = __expf(tops[r] - mx);
      const float den = row16_sum(e);
      const int a = topf[r] >> 4, bb = topf[r] & 15;
      const size_t o = (size_t)(t0 + row) * 128 + hd * 16 + lr;
      PE[o] = pi[row * 16 + a] * 128 + pi[256 + row * 16 + bb];
      PG[o] = e / den;
    }
  }
}

typedef float f32x2 __attribute__((ext_vector_type(2)));
DEV float wave_total(float v) {
  v = row16_sum(v);
  v += __int_as_float(__builtin_amdgcn_update_dpp(0, __float_as_int(v), 0x142, 0xA, 0xF, false));
  v += __int_as_float(__builtin_amdgcn_update_dpp(0, __float_as_int(v), 0x143, 0xC, 0xF, false));
  return __int_as_float(__builtin_amdgcn_readlane(__float_as_int(v), 63));
}
DEV float dot_fp8(uint4 u, const f32x2* x) {
  f32x2 acc = __builtin_amdgcn_cvt_pk_f32_fp8((int)u.x, false) * x[0];
  acc = __builtin_amdgcn_cvt_pk_f32_fp8((int)u.x, true) * x[1] + acc;
  acc = __builtin_amdgcn_cvt_pk_f32_fp8((int)u.y, false) * x[2] + acc;
  acc = __builtin_amdgcn_cvt_pk_f32_fp8((int)u.y, true) * x[3] + acc;
  acc = __builtin_amdgcn_cvt_pk_f32_fp8((int)u.z, false) * x[4] + acc;
  acc = __builtin_amdgcn_cvt_pk_f32_fp8((int)u.z, true) * x[5] + acc;
  acc = __builtin_amdgcn_cvt_pk_f32_fp8((int)u.w, false) * x[6] + acc;
  acc = __builtin_amdgcn_cvt_pk_f32_fp8((int)u.w, true) * x[7] + acc;
  return acc.x + acc.y;
}
DEV void axpy_fp8(uint4 v, float c, f32x2* y) {
  f32x2 cc = {c, c};
  y[0] = __builtin_amdgcn_cvt_pk_f32_fp8((int)v.x, false) * cc + y[0];
  y[1] = __builtin_amdgcn_cvt_pk_f32_fp8((int)v.x, true) * cc + y[1];
  y[2] = __builtin_amdgcn_cvt_pk_f32_fp8((int)v.y, false) * cc + y[2];
  y[3] = __builtin_amdgcn_cvt_pk_f32_fp8((int)v.y, true) * cc + y[3];
  y[4] = __builtin_amdgcn_cvt_pk_f32_fp8((int)v.z, false) * cc + y[4];
  y[5] = __builtin_amdgcn_cvt_pk_f32_fp8((int)v.z, true) * cc + y[5];
  y[6] = __builtin_amdgcn_cvt_pk_f32_fp8((int)v.w, false) * cc + y[6];
  y[7] = __builtin_amdgcn_cvt_pk_f32_fp8((int)v.w, true) * cc + y[7];
}
struct PBatch { uint4 u[4], v[4]; };
DEV void peer_load(PBatch& pb, const unsigned char* PU, const unsigned char* PV, int me0, int me1, int e, int lane) {
#pragma unroll
  for (int k = 0; k < 4; ++k) {
    int ee = e + k;
    int idx = __builtin_amdgcn_readlane((ee < 64) ? me0 : me1, ee & 63);
    pb.u[k] = *(const uint4*)(PU + (size_t)idx * 2048 + lane * 16);
    pb.v[k] = *(const uint4*)(PU + (size_t)idx * 2048 + 1024 + lane * 16);
  }
}
DEV void peer_compute(const PBatch& pb, const f32x2* x, f32x2* y, float mg0, float mg1, int e) {
  float d[4];
#pragma unroll
  for (int k = 0; k < 4; ++k) d[k] = dot_fp8(pb.u[k], x);
#pragma unroll
  for (int k = 0; k < 4; ++k) {
    int ee = e + k;
    float g = __int_as_float(__builtin_amdgcn_readlane(__float_as_int((ee < 64) ? mg0 : mg1), ee & 63));
    float act = wave_total(d[k]) * (1.f / PU_SCALE);
    axpy_fp8(pb.v[k], g * geluf_(act), y);
  }
}
DEV void phase_peer_gather(const Params& p, const float* gnext, bool last) {
  const bfu* XN = (const bfu*)(p.ws + O_ACT);
  const unsigned char* PU = p.ws + O_PU; const unsigned char* PV = p.ws + O_PV;
  const int* PE = (const int*)(p.ws + O_PE); const float* PG = (const float*)(p.ws + O_PG);
  const int lane = tid_() & 63, wv = tid_() >> 6;
  for (int t = bid_() * 4 + wv; t < T; t += gridDim.x * 4) {
    f32x2 x[8], y[8];
    {
      uint4 a = *(const uint4*)(XN + (size_t)t * D + lane * 16);
      uint4 b = *(const uint4*)(XN + (size_t)t * D + lane * 16 + 8);
      x[0] = (f32x2){lo2f(a.x), hi2f(a.x)}; x[1] = (f32x2){lo2f(a.y), hi2f(a.y)}; x[2] = (f32x2){lo2f(a.z), hi2f(a.z)}; x[3] = (f32x2){lo2f(a.w), hi2f(a.w)};
      x[4] = (f32x2){lo2f(b.x), hi2f(b.x)}; x[5] = (f32x2){lo2f(b.y), hi2f(b.y)}; x[6] = (f32x2){lo2f(b.z), hi2f(b.z)}; x[7] = (f32x2){lo2f(b.w), hi2f(b.w)};
    }
#pragma unroll
    for (int i = 0; i < 8; ++i) y[i] = (f32x2){0.f, 0.f};
    const int me0 = PE[(size_t)t * 128 + lane], me1 = PE[(size_t)t * 128 + 64 + lane];
    const float mg0 = PG[(size_t)t * 128 + lane], mg1 = PG[(size_t)t * 128 + 64 + lane];
    PBatch A, B;
    for (int rep = 0; rep < R_GATH; ++rep) {
#pragma unroll
    for (int i = 0; i < 8; ++i) y[i] = (f32x2){0.f, 0.f};
    peer_load(A, PU, PV, me0, me1, 0, lane);
    for (int e = 0; e < 128; e += 8) {
      peer_load(B, PU, PV, me0, me1, e + 4, lane);
      peer_compute(A, x, y, mg0, mg1, e);
      if (e + 8 < 128) peer_load(A, PU, PV, me0, me1, e + 8, lane);
      peer_compute(B, x, y, mg0, mg1, e + 4);
    }
    }
    float* hp = p.out + (size_t)t * D + lane * 16;
    float4 h0 = *(const float4*)(hp), h1 = *(const float4*)(hp + 4), h2 = *(const float4*)(hp + 8), h3 = *(const float4*)(hp + 12);
    float hv[16] = {h0.x, h0.y, h0.z, h0.w, h1.x, h1.y, h1.z, h1.w, h2.x, h2.y, h2.z, h2.w, h3.x, h3.y, h3.z, h3.w};
    float ss = 0.f;
#pragma unroll
    for (int i = 0; i < 8; ++i) {
      hv[i * 2] += y[i].x * (1.f / PV_SCALE); hv[i * 2 + 1] += y[i].y * (1.f / PV_SCALE);
      ss += hv[i * 2] * hv[i * 2] + hv[i * 2 + 1] * hv[i * 2 + 1];
    }
    ss = wave_total(ss);
    const float scl = rsqrtf(ss * (1.f / D) + 1e-6f);
    float gv[16];
    {
      const float* gp = gnext + lane * 16;
      float4 g0 = *(const float4*)(gp), g1 = *(const float4*)(gp + 4), g2 = *(const float4*)(gp + 8), g3 = *(const float4*)(gp + 12);
      float gt[16] = {g0.x, g0.y, g0.z, g0.w, g1.x, g1.y, g1.z, g1.w, g2.x, g2.y, g2.z, g2.w, g3.x, g3.y, g3.z, g3.w};
#pragma unroll
      for (int i = 0; i < 16; ++i) gv[i] = hv[i] * scl * gt[i];
    }
    if (last) {
      *(float4*)(hp) = make_float4(gv[0], gv[1], gv[2], gv[3]); *(float4*)(hp + 4) = make_float4(gv[4], gv[5], gv[6], gv[7]);
      *(float4*)(hp + 8) = make_float4(gv[8], gv[9], gv[10], gv[11]); *(float4*)(hp + 12) = make_float4(gv[12], gv[13], gv[14], gv[15]);
    } else {
      *(float4*)(hp) = make_float4(hv[0], hv[1], hv[2], hv[3]); *(float4*)(hp + 4) = make_float4(hv[4], hv[5], hv[6], hv[7]);
      *(float4*)(hp + 8) = make_float4(hv[8], hv[9], hv[10], hv[11]); *(float4*)(hp + 12) = make_float4(hv[12], hv[13], hv[14], hv[15]);
      bfu* up = (bfu*)(p.ws + O_ACT) + (size_t)t * D + lane * 16;
      *(uint4*)(up) = make_uint4(pack2(gv[0], gv[1]), pack2(gv[2], gv[3]), pack2(gv[4], gv[5]), pack2(gv[6], gv[7]));
      *(uint4*)(up + 8) = make_uint4(pack2(gv[8], gv[9]), pack2(gv[10], gv[11]), pack2(gv[12], gv[13]), pack2(gv[14], gv[15]));
    }
  }
}

#include <cstdint>
#define XB_TMO      128
#define XB_XCNT(j)  (256  + 64 * (j))
#define XB_XSUB(j)  (1280 + 64 * (j))
#define XB_XGEN(j)  (2304 + 64 * (j))
#define XB_TOP      3328
#define XB_TOPGEN   3392
#define XCD_BAR_WORDS 3456
#define XB_SPIN_CAP (1u << 18)
#define LAS __attribute__((address_space(3)))

__device__ __forceinline__ unsigned xb_ld(unsigned* p)              { return __hip_atomic_load(p, __ATOMIC_RELAXED, __HIP_MEMORY_SCOPE_AGENT); }
__device__ __forceinline__ unsigned xb_add(unsigned* p, unsigned v) { return __hip_atomic_fetch_add(p, v, __ATOMIC_RELAXED, __HIP_MEMORY_SCOPE_AGENT); }
__device__ __forceinline__ unsigned xb_xcc_id() { return (unsigned)__builtin_amdgcn_s_getreg((3 << 11) | 20) & 0xFu; }
#define XB_SPIN(cond, bar) do { unsigned _sp = 0; while (cond) { __builtin_amdgcn_s_sleep(1); \
    if ((++_sp & 255u) == 0u) { if (xb_ld(&(bar)[XB_TMO])) break; if (_sp > XB_SPIN_CAP) { atomicAdd(&(bar)[XB_TMO], 1u); break; } } } } while (0)

struct XcdBarrier {
    unsigned* bar; unsigned x;
    volatile LAS unsigned* st;
};

__device__ __forceinline__ XcdBarrier xcd_barrier_post(unsigned* bar, volatile LAS unsigned* st) {
    XcdBarrier b; b.bar = bar; b.x = xb_xcc_id(); b.st = st;
    if (threadIdx.x == 0) (void)xb_add(&bar[XB_XCNT(b.x)], 1u);
    return b;
}
__device__ __forceinline__ void xcd_barrier_complete(unsigned* bar, unsigned x, unsigned& nloc, unsigned& nx) {
    const unsigned G = gridDim.x * gridDim.y * gridDim.z;
    unsigned sum, cnt, mine, sp = 0u;
    for (;;) {
        sum = 0u; cnt = 0u; mine = 0u;
#pragma unroll
        for (unsigned j = 0; j < 16; ++j) { const unsigned c = xb_ld(&bar[XB_XCNT(j)]); sum += c; cnt += (c > 0u) ? 1u : 0u; mine = (j == x) ? c : mine; }
        if (sum == G) break;
        __builtin_amdgcn_s_sleep(1);
        if ((++sp & 255u) == 0u) { if (xb_ld(&bar[XB_TMO])) break; if (sp > XB_SPIN_CAP) { atomicAdd(&bar[XB_TMO], 1u); break; } }
    }
    nloc = mine > 0u ? mine : 1u; nx = cnt > 0u ? cnt : 1u;
}

__device__ __forceinline__ void xcd_barrier(const XcdBarrier& b) {
    asm volatile("s_waitcnt vmcnt(0)" ::: "memory");
    __syncthreads();
    if (threadIdx.x == 0) {
        unsigned* bar = b.bar;
        __builtin_amdgcn_s_waitcnt(0);
        unsigned nloc = b.st[0], nx = b.st[1];
        if (nloc == 0u) { xcd_barrier_complete(bar, b.x, nloc, nx); b.st[0] = nloc; b.st[1] = nx; }
        const unsigned old = xb_add(&bar[XB_XSUB(b.x)], 1u);
        const unsigned gen = old / nloc;
        if (old + 1u == (gen + 1u) * nloc) {
            __builtin_amdgcn_fence(__ATOMIC_RELEASE, "agent");
            asm volatile("s_waitcnt vmcnt(0)" ::: "memory");
            const unsigned og = xb_add(&bar[XB_TOP], 1u);
            const unsigned tg = og / nx;
            if (og + 1u == (tg + 1u) * nx) xb_add(&bar[XB_TOPGEN], 1u);
            else XB_SPIN(xb_ld(&bar[XB_TOPGEN]) == tg, bar);
            __builtin_amdgcn_fence(__ATOMIC_ACQUIRE, "agent");
            xb_add(&bar[XB_XGEN(b.x)], 1u);
            asm volatile("s_waitcnt vmcnt(0)" ::: "memory");
        } else {
            XB_SPIN(xb_ld(&bar[XB_XGEN(b.x)]) == gen, bar);
            __builtin_amdgcn_fence(__ATOMIC_ACQUIRE, "agent");
            asm volatile("s_waitcnt vmcnt(0)" ::: "memory");
        }
    }
    __syncthreads();
}

__shared__ uint4 xb_words;
DEV void seam_barrier(unsigned char* ws) {
  XcdBarrier b; b.bar = (unsigned*)(ws + O_XB); b.x = xb_xcc_id(); b.st = (volatile LAS unsigned*)&xb_words;
  xcd_barrier(b);
}

DEV void launder_all(Params& q) {
  const float** pp = (const float**)&q;
#pragma unroll
  for (int i = 0; i < 39; ++i) { const float* t = pp[i]; asm volatile("" : "+s"(t)); pp[i] = t; }
}
__global__ void __launch_bounds__(NTHR, 2) fwd_megakernel(Params p0) {
  cg::grid_group grid = cg::this_grid();
  int ph = 0;
  if (threadIdx.x == 0) xb_words = make_uint4(0u, 0u, 0u, 0u);
  __syncthreads();
#define PHASE(body) { if (ph >= p0.ph_lo && ph < p0.ph_hi) { Params q_ = p0; launder_all(q_); { const Params& p = q_; body; } \
    if (ph + 1 < p0.ph_hi) { if (ph == 0) { grid.sync(); (void)xcd_barrier_post((unsigned*)(q_.ws + O_XB), (volatile LAS unsigned*)&xb_words); } else seam_barrier(q_.ws); } } ++ph; }
  PHASE(phase_convert(p); phase_norm(p.x, p.mix_norm, (bfu*)(p.ws + O_ACT)))
  for (int l = 0; l < DEPTH; ++l) {
#define wb (p.ws + O_W + (size_t)l * W_SZ)
    PHASE(for (int rep = 0; rep < R_GEMM; ++rep) gemm_phase<0>((const bfu*)(p.ws + O_ACT), (const bfu*)(wb + W_IN), NIN, 1024, (bfu*)(p.ws + O_COLS), NIN, (float*)(p.ws + O_SIDE), nullptr, nullptr))
    PHASE(for (int rep = 0; rep < R_PREP; ++rep) phase_rwkv_prep(p, l))
    PHASE(phase_mix_scan_finish(p, l))
    PHASE(phase_rwkv_post(p, l))
    PHASE(gemm_phase<1>((const bfu*)(p.ws + O_ACT), (const bfu*)(wb + W_OUT), 1024, 1024, nullptr, 0, nullptr, l == 0 ? p.x : p.out, p.out); convert_peer_uv(p, l))
    PHASE(phase_norm(p.out, p.ffn_norm + (size_t)l * D, (bfu*)(p.ws + O_ACT)))
    PHASE(for (int rep = 0; rep < R_GEMM; ++rep) gemm_phase<2>((const bfu*)(p.ws + O_ACT), (const bfu*)(wb + W_Q), 2048, 1024, (bfu*)(p.ws + O_PQ), 2048, nullptr, nullptr, nullptr))
    PHASE(for (int rep = 0; rep < R_TOPK; ++rep) phase_peer_topk(p, l))
    PHASE(phase_peer_gather(p, l + 1 < DEPTH ? p.mix_norm + (size_t)(l + 1) * D : p.final_norm, l + 1 == DEPTH))
  }
}

extern "C" void kernel_launch(void* const* d_in, const int* in_sizes, int n_in, void* d_out, int out_size, void* d_ws, size_t ws_size,
                              hipStream_t stream) {
  static int grid_blocks = 0;
  if (!grid_blocks) {
    int dev = 0, cus = 0, per_cu = 0;
    hipGetDevice(&dev);
    hipDeviceGetAttribute(&cus, hipDeviceAttributeMultiprocessorCount, dev);
    hipOccupancyMaxActiveBlocksPerMultiprocessor(&per_cu, fwd_megakernel, NTHR, 0);
    if (per_cu > 2) per_cu = 2;
    grid_blocks = cus * per_cu;
  }
  Params p{};
  const float** pp = (const float**)&p;
  for (int i = 0; i < 37; ++i) pp[i] = (const float*)d_in[i];
  p.out = (float*)d_out; p.ws = (unsigned char*)d_ws; p.ph_lo = 0; p.ph_hi = 1000;
  void* args[] = {&p};
  hipError_t e = hipLaunchCooperativeKernel((void*)fwd_megakernel, dim3(grid_blocks), dim3(NTHR), args, 0, stream);
  if (e != hipSuccess) fprintf(stderr, "cooperative launch failed: %s (grid %d)\n", hipGetErrorString(e), grid_blocks);
}
```
